# Optimizing an MI355X kernel written in HIP

```python
import jax, jax.numpy as jnp
from jax import lax
import numpy as np

D_MODEL = 4096
BATCH = 4
SEQ = 2048
DEPTH = 2

MIX_WIDTH = D_MODEL
EPS = 1e-6
Q_BLOCK = 128
GLA_HEADS = 4
GLA_DK = D_MODEL // 16
GLA_DV = D_MODEL // 8
GLA_QK = GLA_HEADS * GLA_DK
GLA_V = GLA_HEADS * GLA_DV
GLA_GATE_RANK = 16
GLA_GATE_TAU = 16.0
GLA_CHUNK = 64
FOX_HEAD_DIM = 128
FOX_W = MIX_WIDTH // 2
FOX_HEADS = FOX_W // FOX_HEAD_DIM
RG_WIDTH = MIX_WIDTH // 2
RG_BLOCK = 256
RG_BLOCKS = RG_WIDTH // RG_BLOCK
RG_CONV = 4
RG_C = 8.0
SB_HEAD_DIM = 128
SB_W = MIX_WIDTH // 2
SB_HEADS = SB_W // SB_HEAD_DIM
D_FF = -(-8 * D_MODEL // (3 * 256)) * 256
N_EVEN = (DEPTH + 1) // 2
N_ODD = DEPTH // 2
AB_SIZES = (GLA_QK, GLA_QK, GLA_V, GLA_V, GLA_GATE_RANK, FOX_W, FOX_W, FOX_W, FOX_HEADS)
CD_SIZES = (RG_WIDTH, RG_WIDTH, SB_W, SB_W, SB_W)
AB_IN = sum(AB_SIZES)
CD_IN = sum(CD_SIZES)
AB_OUT = GLA_V + FOX_W
CD_OUT = RG_WIDTH + SB_W

kernel_name = 'hybrid_gla_fox_rglru_stickbreaking_block'


def rmsnorm(x, g):
    xf = x.astype(jnp.float32)
    y = xf * lax.rsqrt(jnp.mean(xf * xf, axis=-1, keepdims=True) + EPS)
    return (y * g.astype(jnp.float32)).astype(x.dtype)


def split_cols(t, sizes):
    idx = [int(v) for v in np.cumsum(sizes)[:-1]]
    return jnp.split(t, idx, axis=-1)


def gla_chunked(q, k, v, log_a):
    B, S, H, K = q.shape
    V = v.shape[-1]
    n = S // GLA_CHUNK

    def to_chunks(t):
        return t.reshape(B, n, GLA_CHUNK, H, t.shape[-1]).transpose(1, 0, 3, 2, 4).astype(jnp.float32)

    qc, kc, vc, ac = to_chunks(q), to_chunks(k), to_chunks(v), to_chunks(log_a)
    bc = jnp.cumsum(ac, axis=-2)
    causal = jnp.tril(jnp.ones((GLA_CHUNK, GLA_CHUNK), bool))

    def step(state, inp):
        qi, ki, vi, bi = inp
        inter = jnp.einsum('bhtk,bhkv->bhtv', qi * jnp.exp(bi), state)
        diff = bi[:, :, :, None, :] - bi[:, :, None, :, :]
        decay = jnp.exp(jnp.where(causal[:, :, None], diff, -jnp.inf))
        scores = jnp.einsum('bhtk,bhsk,bhtsk->bhts', qi, ki, decay)
        intra = jnp.einsum('bhts,bhsv->bhtv', scores, vi)
        b_last = bi[:, :, -1:, :]
        k_dec = ki * jnp.exp(b_last - bi)
        state = jnp.exp(b_last[:, :, 0, :])[..., None] * state + jnp.einsum('bhsk,bhsv->bhkv', k_dec, vi)
        return state, inter + intra

    state0 = jnp.zeros((B, H, K, V), jnp.float32)
    _, out = lax.scan(step, state0, (qc, kc, vc, bc))
    return out.transpose(1, 0, 3, 2, 4).reshape(B, S, H, V)


def forgetting_attention(q, k, v, log_f):
    B, S, H, Dh = q.shape
    n = S // Q_BLOCK
    c = jnp.cumsum(log_f.astype(jnp.float32), axis=1).transpose(0, 2, 1)
    qb = q.reshape(B, n, Q_BLOCK, H, Dh).transpose(1, 0, 2, 3, 4)
    cb = c.reshape(B, H, n, Q_BLOCK).transpose(2, 0, 1, 3)
    pos_k = jnp.arange(S)
    scale = Dh ** -0.5

    def block(args):
        qi, ci, i = args
        pos_q = i * Q_BLOCK + jnp.arange(Q_BLOCK)
        logits = (jnp.einsum('bqhd,bkhd->bhqk', qi, k).astype(jnp.float32) * scale
                  + ci[:, :, :, None] - c[:, :, None, :])
        logits = jnp.where(pos_k[None, :] <= pos_q[:, None], logits, -jnp.inf)
        p = jax.nn.softmax(logits, axis=-1)
        return jnp.einsum('bhqk,bkhd->bqhd', p.astype(v.dtype), v)

    out = lax.map(block, (qb, cb, jnp.arange(n)))
    return out.transpose(1, 0, 2, 3, 4).reshape(B, S, H, Dh)


def stick_breaking_attention(q, k, v):
    B, S, H, Dh = q.shape
    n = S // Q_BLOCK
    qb = q.reshape(B, n, Q_BLOCK, H, Dh).transpose(1, 0, 2, 3, 4)
    pos_k = jnp.arange(S)
    scale = Dh ** -0.5

    def block(args):
        qi, i = args
        pos_q = i * Q_BLOCK + jnp.arange(Q_BLOCK)
        mask = (pos_k[None, :] < pos_q[:, None])[None, None]
        z = jnp.einsum('bqhd,bkhd->bhqk', qi, k).astype(jnp.float32) * scale
        log_beta = jax.nn.log_sigmoid(z)
        log_1m = jnp.where(mask, jax.nn.log_sigmoid(-z), 0.0)
        suffix = lax.cumsum(log_1m, axis=3, reverse=True) - log_1m
        a = jnp.where(mask, jnp.exp(log_beta + suffix), 0.0)
        return jnp.einsum('bhqk,bkhd->bqhd', a.astype(v.dtype), v)

    out = lax.map(block, (qb, jnp.arange(n)))
    return out.transpose(1, 0, 2, 3, 4).reshape(B, S, H, Dh)


def rg_lru_branch(xb, conv_w, conv_b, w_x, b_x, w_a, b_a, lam):
    B, S, W = xb.shape
    xc = lax.conv_general_dilated(xb, conv_w[:, None, :].astype(xb.dtype), window_strides=(1,),
                                  padding=[(RG_CONV - 1, 0)], dimension_numbers=('NWC', 'WIO', 'NWC'),
                                  feature_group_count=W) + conv_b
    xg = xc.reshape(B, S, RG_BLOCKS, RG_BLOCK)
    gate_x = jax.nn.sigmoid(jnp.einsum('bsgi,gij->bsgj', xg, w_x).reshape(B, S, W) + b_x)
    gate_a = jax.nn.sigmoid(jnp.einsum('bsgi,gij->bsgj', xg, w_a).reshape(B, S, W) + b_a)
    log_a = -RG_C * gate_a.astype(jnp.float32) * jax.nn.softplus(-lam.astype(jnp.float32))
    a = jnp.exp(log_a)
    u = jnp.sqrt(-jnp.expm1(2.0 * log_a)) * (gate_x * xc).astype(jnp.float32)

    def combine(left, right):
        a_l, b_l = left
        a_r, b_r = right
        return a_l * a_r, a_r * b_l + b_r

    _, h = lax.associative_scan(combine, (a, u), axis=1)
    return h.astype(xb.dtype)


def even_mixer(u, w_in, gla_w_gate_up, gla_b_gate, gla_norm, fox_b_f, w_out):
    B, S, _ = u.shape
    proj = u @ w_in
    gq, gk, gv, gg, glr, fq, fk, fv, ff = split_cols(proj, AB_SIZES)
    gq = gq.reshape(B, S, GLA_HEADS, GLA_DK) * (GLA_DK ** -0.5)
    gk = gk.reshape(B, S, GLA_HEADS, GLA_DK)
    gv = gv.reshape(B, S, GLA_HEADS, GLA_DV)
    log_alpha = jax.nn.log_sigmoid((glr @ gla_w_gate_up + gla_b_gate).astype(jnp.float32)) / GLA_GATE_TAU
    log_alpha = log_alpha.reshape(B, S, GLA_HEADS, GLA_DK)
    o_gla = gla_chunked(gq, gk, gv, log_alpha).astype(u.dtype)
    o_gla = rmsnorm(o_gla, gla_norm) * jax.nn.silu(gg.reshape(B, S, GLA_HEADS, GLA_DV))
    o_gla = o_gla.reshape(B, S, GLA_V)
    fq = fq.reshape(B, S, FOX_HEADS, FOX_HEAD_DIM)
    fk = fk.reshape(B, S, FOX_HEADS, FOX_HEAD_DIM)
    fv = fv.reshape(B, S, FOX_HEADS, FOX_HEAD_DIM)
    log_f = jax.nn.log_sigmoid((ff + fox_b_f).astype(jnp.float32))
    o_fox = forgetting_attention(fq, fk, fv, log_f).reshape(B, S, FOX_W)
    return jnp.concatenate([o_gla, o_fox], axis=-1) @ w_out


def odd_mixer(u, w_in, conv_w, conv_b, w_x, b_x, w_a, b_a, lam, w_out):
    B, S, _ = u.shape
    proj = u @ w_in
    ry, rx, sq, sk, sv = split_cols(proj, CD_SIZES)
    o_rg = rg_lru_branch(rx, conv_w, conv_b, w_x, b_x, w_a, b_a, lam) * jax.nn.gelu(ry)
    sq = sq.reshape(B, S, SB_HEADS, SB_HEAD_DIM)
    sk = sk.reshape(B, S, SB_HEADS, SB_HEAD_DIM)
    sv = sv.reshape(B, S, SB_HEADS, SB_HEAD_DIM)
    o_sb = stick_breaking_attention(sq, sk, sv).reshape(B, S, SB_W)
    return jnp.concatenate([o_rg, o_sb], axis=-1) @ w_out


def swiglu(u, w_gate, w_up, w_down):
    return (jax.nn.silu(u @ w_gate) * (u @ w_up)) @ w_down


def setup_inputs(seed: int = 0) -> dict:
    key = jax.random.key(seed)
    ks = jax.random.split(key, 24)
    f32 = jnp.float32

    def nrm(k, shape, fan_in):
        return jax.random.normal(k, shape, f32) * (fan_in ** -0.5)

    def gain(k, shape):
        return 1.0 + 0.02 * jax.random.normal(k, shape, f32)

    def small(k, shape):
        return 0.01 * jax.random.normal(k, shape, f32)

    u = jax.random.uniform(ks[21], (N_ODD, RG_WIDTH), f32, minval=0.9, maxval=0.999)
    p = u ** (1.0 / RG_C)
    rg_lambda = jnp.log(p) - jnp.log1p(-p)
    return {
        'x': jax.random.normal(ks[0], (BATCH, SEQ, D_MODEL), f32),
        'norm_mix': gain(ks[1], (DEPTH, D_MODEL)),
        'norm_ffn': gain(ks[2], (DEPTH, D_MODEL)),
        'ffn_w_gate': nrm(ks[3], (DEPTH, D_MODEL, D_FF), D_MODEL),
        'ffn_w_up': nrm(ks[4], (DEPTH, D_MODEL, D_FF), D_MODEL),
        'ffn_w_down': nrm(ks[5], (DEPTH, D_FF, D_MODEL), D_FF),
        'ab_w_in': nrm(ks[6], (N_EVEN, D_MODEL, AB_IN), D_MODEL),
        'gla_w_gate_up': nrm(ks[7], (N_EVEN, GLA_GATE_RANK, GLA_QK), GLA_GATE_RANK),
        'gla_b_gate': small(ks[8], (N_EVEN, GLA_QK)),
        'gla_norm': gain(ks[9], (N_EVEN, GLA_DV)),
        'fox_b_f': 3.0 + 0.5 * jax.random.normal(ks[10], (N_EVEN, FOX_HEADS), f32),
        'ab_w_out': nrm(ks[11], (N_EVEN, AB_OUT, D_MODEL), AB_OUT),
        'cd_w_in': nrm(ks[12], (N_ODD, D_MODEL, CD_IN), D_MODEL),
        'rg_conv_w': nrm(ks[13], (N_ODD, RG_CONV, RG_WIDTH), RG_CONV),
        'rg_conv_b': small(ks[14], (N_ODD, RG_WIDTH)),
        'rg_w_x': nrm(ks[15], (N_ODD, RG_BLOCKS, RG_BLOCK, RG_BLOCK), RG_BLOCK),
        'rg_b_x': small(ks[16], (N_ODD, RG_WIDTH)),
        'rg_w_a': nrm(ks[17], (N_ODD, RG_BLOCKS, RG_BLOCK, RG_BLOCK), RG_BLOCK),
        'rg_b_a': small(ks[18], (N_ODD, RG_WIDTH)),
        'rg_lambda': rg_lambda,
        'cd_w_out': nrm(ks[19], (N_ODD, CD_OUT, D_MODEL), CD_OUT),
        'final_norm': gain(ks[20], (D_MODEL,)),
    }


def reference(x, norm_mix, norm_ffn, ffn_w_gate, ffn_w_up, ffn_w_down, ab_w_in, gla_w_gate_up,
              gla_b_gate, gla_norm, fox_b_f, ab_w_out, cd_w_in, rg_conv_w, rg_conv_b, rg_w_x,
              rg_b_x, rg_w_a, rg_b_a, rg_lambda, cd_w_out, final_norm):
    h = x
    for layer in range(DEPTH):
        i = layer // 2
        u = rmsnorm(h, norm_mix[layer])
        if layer % 2 == 0:
            h = h + even_mixer(u, ab_w_in[i], gla_w_gate_up[i], gla_b_gate[i], gla_norm[i],
                               fox_b_f[i], ab_w_out[i])
        else:
            h = h + odd_mixer(u, cd_w_in[i], rg_conv_w[i], rg_conv_b[i], rg_w_x[i], rg_b_x[i],
                              rg_w_a[i], rg_b_a[i], rg_lambda[i], cd_w_out[i])
        u = rmsnorm(h, norm_ffn[layer])
        h = h + swiglu(u, ffn_w_gate[layer], ffn_w_up[layer], ffn_w_down[layer])
    return rmsnorm(h, final_norm)
```

```cpp
#include <hip/hip_runtime.h>
#include <cstdio>
#include <cstdint>

#define LAS __attribute__((address_space(3)))
#define GAS __attribute__((address_space(1)))
typedef unsigned short bf16_t;
typedef short bf16x8 __attribute__((ext_vector_type(8)));
typedef short s16x4 __attribute__((ext_vector_type(4)));
typedef float f32x4 __attribute__((ext_vector_type(4)));
typedef float f32x2 __attribute__((ext_vector_type(2)));
typedef float f32x16 __attribute__((ext_vector_type(16)));
typedef unsigned u32x4 __attribute__((ext_vector_type(4)));
typedef unsigned u32x2 __attribute__((ext_vector_type(2)));

constexpr int DM = 4096, NB = 4, SEQ = 2048, MTOK = NB * SEQ;
constexpr int DFF = 11008;
constexpr int AB_MAIN = 12288;
constexpr int AB_IN = 12320, CD_IN = 10240;
constexpr int PJ_GQ = 0, PJ_GK = 1024, PJ_GV = 2048, PJ_GG = 4096, PJ_FQ = 6144, PJ_FK = 8192, PJ_FV = 10240;
constexpr int PJ_RY = 0, PJ_RX = 2048, PJ_SQ = 4096, PJ_SK = 6144, PJ_SV = 8192;
constexpr float EPS = 1e-6f;

__device__ __forceinline__ unsigned cvt_pk_bf16(float lo, float hi) { unsigned r; asm volatile("v_cvt_pk_bf16_f32 %0, %1, %2" : "=v"(r) : "v"(lo), "v"(hi)); return r; }
__device__ __forceinline__ float bf2f(bf16_t v) { return __uint_as_float(((unsigned)v) << 16); }
__device__ __forceinline__ float bflo(unsigned w) { return __uint_as_float(w << 16); }
__device__ __forceinline__ float bfhi(unsigned w) { return __uint_as_float(w & 0xffff0000u); }
__device__ __forceinline__ bf16_t f2bf(float f) { return (bf16_t)(cvt_pk_bf16(f, 0.f) & 0xffffu); }
__device__ __forceinline__ int crow(int r, int hi) { return (r & 3) + 8 * (r >> 2) + 4 * hi; }
__device__ __forceinline__ bf16x8 pack8(float a0, float a1, float a2, float a3, float a4, float a5, float a6, float a7) {
    u32x4 w = {cvt_pk_bf16(a0, a1), cvt_pk_bf16(a2, a3), cvt_pk_bf16(a4, a5), cvt_pk_bf16(a6, a7)}; return __builtin_bit_cast(bf16x8, w); }
__device__ __forceinline__ float wave_sum(float v) {
#pragma unroll
    for (int o = 1; o < 64; o <<= 1) v += __shfl_xor(v, o);
    return v; }
__device__ __forceinline__ float log_sigmoid_acc(float x) { return fminf(x, 0.f) - log1pf(expf(-fabsf(x))); }
#define LDS_WAIT() asm volatile("s_waitcnt lgkmcnt(0)" ::: "memory")
#define VM_WAIT() asm volatile("s_waitcnt vmcnt(0)" ::: "memory")
#define MFMA32(a, b, c) __builtin_amdgcn_mfma_f32_32x32x16_bf16((a), (b), (c), 0, 0, 0)
typedef LAS const char* lds_cptr;
__device__ __forceinline__ s16x4 vtr(lds_cptr p) { return __builtin_bit_cast(s16x4, __builtin_amdgcn_ds_read_tr16_b64_v4i16((LAS s16x4*)p)); }
__device__ __forceinline__ bf16x8 cat4(s16x4 lo, s16x4 hi) { bf16x8 r; r[0] = lo[0]; r[1] = lo[1]; r[2] = lo[2]; r[3] = lo[3]; r[4] = hi[0]; r[5] = hi[1]; r[6] = hi[2]; r[7] = hi[3]; return r; }

namespace pg8 {
#define PG8_LAS __attribute__((address_space(3)))
typedef unsigned short bf16_t;
typedef short bf16x8 __attribute__((ext_vector_type(8)));
typedef float f32x4 __attribute__((ext_vector_type(4)));
typedef unsigned u32x4 __attribute__((ext_vector_type(4)));
constexpr int BM = 256, BK = 64, HALF = 128, HTB = HALF * BK * 2  , STAGE_BYTES = 8 * HTB, NXCD = 8, WGM = 8;

__host__ __device__ __forceinline__ int lds_byte(int r, int c) { const int st = (r >> 4) * 2 + (c >> 5), rr = r & 15, cc = c & 31, ob = rr * 64 + cc * 2; return st * 1024 + (ob ^ (((ob >> 9) & 1) << 5)); }
__host__ __device__ __forceinline__ void stage_rc(int b, int& R, int& C) { const int st = b / 1024, sb = b % 1024, swz = sb ^ (((sb >> 9) & 1) << 5); R = (st >> 1) * 16 + swz / 64; C = (st & 1) * 32 + (swz % 64) / 2; }
__host__ __device__ __forceinline__ int perm32(int rho) { const int n = rho >> 4, i = rho & 15; return 8 * (i >> 2) + 4 * n + (i & 3); }

struct Unit { int pm, pn; };
struct Gemm { const bf16_t* A; const bf16_t* Bt; int M, N, K; };

struct StaticOrder {
    int nM, nN, nwg, G, c;
    __host__ __device__ void init(int M, int N, int G_, int c_) { nM = M / BM; nN = N / BM; nwg = nM * nN; G = G_; c = c_; }
    __host__ __device__ bool next(int i, Unit& u) const {
        const long L = (long)i * G + c; if (L >= nwg) return false;
        int wgid = (int)L; { const int q = nwg / NXCD, r = nwg % NXCD, xcd = wgid % NXCD, off = wgid / NXCD; wgid = (xcd < r ? xcd * (q + 1) : r * (q + 1) + (xcd - r) * q) + off; }
        const int nig = WGM * nN, gid = wgid / nig, fm = gid * WGM, gsz = (nM - fm) < WGM ? (nM - fm) : WGM;
        u.pm = fm + ((wgid % nig) % gsz); u.pn = (wgid % nig) / gsz; return true;
    }
    __device__ __forceinline__ void a_ready(const Unit&) const {}
    __device__ __forceinline__ void done(const Unit&) const {}
};
__device__ __forceinline__ unsigned cvt_pk_bf16(float lo, float hi) { unsigned r; asm volatile("v_cvt_pk_bf16_f32 %0, %1, %2" : "=v"(r) : "v"(lo), "v"(hi)); return r; }

struct EpiBf16 {
    static constexpr bool PERM = true, AFTER_DRAIN = false;
    bf16_t* O; int ldc;
    __device__ __forceinline__ void operator()(const f32x4 (&acc)[2][2][4][2], const Unit& u, int wr, int wc, int fr, int fq) const {
        const int row0 = u.pm * BM + wr * 64 + fr, col0 = u.pn * BM + wc * 32 + 8 * fq;
#pragma unroll
        for (int ai = 0; ai < 2; ++ai)
#pragma unroll
            for (int m = 0; m < 4; ++m) { bf16_t* rowp = O + (size_t)(row0 + ai * HALF + m * 16) * ldc + col0;
#pragma unroll
                for (int bj = 0; bj < 2; ++bj) { const f32x4 v0 = acc[ai][bj][m][0], v1 = acc[ai][bj][m][1];
                    u32x4 w; w.x = cvt_pk_bf16(v0[0], v0[1]); w.y = cvt_pk_bf16(v0[2], v0[3]); w.z = cvt_pk_bf16(v1[0], v1[1]); w.w = cvt_pk_bf16(v1[2], v1[3]);
                    *(u32x4*)(rowp + bj * HALF) = w; } }
    }
};
struct EpiRes {
    static constexpr bool PERM = false, AFTER_DRAIN = false;
    const float* base; float* out; int ldc;
    __device__ __forceinline__ void operator()(const f32x4 (&acc)[2][2][4][2], const Unit& u, int wr, int wc, int fr, int fq) const {
        const int row0 = u.pm * BM + wr * 64 + fr, col0 = u.pn * BM + wc * 32 + 4 * fq;
#pragma unroll
        for (int ai = 0; ai < 2; ++ai)
#pragma unroll
            for (int m = 0; m < 4; ++m) { const size_t off = (size_t)(row0 + ai * HALF + m * 16) * ldc + col0;
#pragma unroll
                for (int bj = 0; bj < 2; ++bj)
#pragma unroll
                    for (int n = 0; n < 2; ++n) { const f32x4 bs = *(const f32x4*)(base + off + bj * HALF + n * 16); *(f32x4*)(out + off + bj * HALF + n * 16) = bs + acc[ai][bj][m][n]; }
                asm volatile("" ::: "memory"); }
    }
};
struct EpiSwiGLU {
    static constexpr bool PERM = true, AFTER_DRAIN = false;
    bf16_t* O; int ldc;
    __device__ __forceinline__ void operator()(const f32x4 (&acc)[2][2][4][2], const Unit& u, int wr, int wc, int fr, int fq) const {
        const int row0 = u.pm * BM + wr * 64 + fr, col0 = u.pn * HALF + wc * 32 + 8 * fq;
#pragma unroll
        for (int ai = 0; ai < 2; ++ai)
#pragma unroll
            for (int m = 0; m < 4; ++m) { bf16_t* rowp = O + (size_t)(row0 + ai * HALF + m * 16) * ldc + col0; float a[8];
#pragma unroll
                for (int n = 0; n < 2; ++n)
#pragma unroll
                    for (int i = 0; i < 4; ++i) { const float g = acc[ai][0][m][n][i], up = acc[ai][1][m][n][i]; a[4 * n + i] = g * up * __builtin_amdgcn_rcpf(1.0f + __expf(-g)); }
                u32x4 w; w.x = cvt_pk_bf16(a[0], a[1]); w.y = cvt_pk_bf16(a[2], a[3]); w.z = cvt_pk_bf16(a[4], a[5]); w.w = cvt_pk_bf16(a[6], a[7]);
                *(u32x4*)rowp = w; }
    }
};

template <class Epi, class Sched, bool ALIGN_EPI = false, bool SP2 = false>
__device__ __forceinline__ void gemm_phase(PG8_LAS unsigned char* lds, const Gemm g, const Sched& S, const Epi& E) {
    const int tid = threadIdx.x, wid = __builtin_amdgcn_readfirstlane(tid >> 6), lane = tid & 63, wr = wid >> 2, wc = wid & 3, fr = lane & 15, fq = lane >> 4;
    const int K = g.K, nt = K / BK;
    unsigned voffA[2], voffB[2];
#pragma unroll
    for (int i = 0; i < 2; ++i) { int R, C; stage_rc(tid * 16 + i * 8192, R, C); const int Rb = Epi::PERM ? ((R & ~31) + perm32(R & 31)) : R;
        voffA[i] = (unsigned)(R * K + C) * 2u; voffB[i] = (unsigned)(Rb * K + C) * 2u; }
    const size_t kstep = (size_t)(BK * 2);
    const size_t hstep = (size_t)HALF * K * 2;
    const size_t tstep = 2 * hstep;
    const unsigned ldsw = (unsigned)wid * 1024u;
    const int aoff = lds_byte(wr * 64 + fr, fq * 8), boff = lds_byte(wc * 32 + fr, fq * 8);
#define PG8_SA(b, h) (((b) * 2 + (h)) * HTB)
#define PG8_SB(b, h) ((4 + (b) * 2 + (h)) * HTB)
#define PG8_STAGE(bufoff, gbase, voff) do { _Pragma("unroll") for (int _i = 0; _i < 2; ++_i) \
        __builtin_amdgcn_global_load_lds((const unsigned*)((const char*)(gbase) + (voff)[_i]), (PG8_LAS unsigned*)(lds + (bufoff) + ldsw + _i * 8192), 16, 0, 0); } while (0)
#define PG8_LDA(dst, b, h) do { _Pragma("unroll") for (int m = 0; m < 4; ++m) _Pragma("unroll") for (int k = 0; k < 2; ++k) dst[m][k] = *(const PG8_LAS bf16x8*)(lds + PG8_SA(b, h) + aoff + m * 2048 + k * 1024); } while (0)
#define PG8_LDB(dst, b, h) do { _Pragma("unroll") for (int n = 0; n < 2; ++n) _Pragma("unroll") for (int k = 0; k < 2; ++k) dst[n][k] = *(const PG8_LAS bf16x8*)(lds + PG8_SB(b, h) + boff + n * 2048 + k * 1024); } while (0)
#define PG8_MMA(ai, bj, At, Bt) do { __builtin_amdgcn_s_setprio(1); _Pragma("unroll") for (int m = 0; m < 4; ++m) _Pragma("unroll") for (int n = 0; n < 2; ++n) _Pragma("unroll") for (int k = 0; k < 2; ++k) \
        acc[ai][bj][m][n] = __builtin_amdgcn_mfma_f32_16x16x32_bf16(Bt[n][k], At[m][k], acc[ai][bj][m][n], 0, 0, 0); __builtin_amdgcn_s_setprio(0); } while (0)
#define PG8_WAIT_V(n) asm volatile("s_waitcnt vmcnt(" #n ")" ::: "memory")
#define PG8_WAIT_L(n) asm volatile("s_waitcnt lgkmcnt(" #n ")" ::: "memory")
#define PG8_BAR __builtin_amdgcn_s_barrier()
#define PG8_SCHED __builtin_amdgcn_sched_barrier(0)
    Unit cur, nxt; int ui = 0;
    if (!S.next(0, cur)) return;
    f32x4 acc[2][2][4][2];
#pragma unroll
    for (int a = 0; a < 2; ++a)
#pragma unroll
        for (int b = 0; b < 2; ++b)
#pragma unroll
            for (int m = 0; m < 4; ++m)
#pragma unroll
                for (int n = 0; n < 2; ++n) acc[a][b][m][n] = (f32x4){0.f, 0.f, 0.f, 0.f};
    bf16x8 At[4][2], B0[2][2], B1[2][2];
    const char* cA = (const char*)g.A + (size_t)cur.pm * tstep; const char* cB = (const char*)g.Bt + (size_t)cur.pn * tstep;
    S.a_ready(cur);
    if constexpr (SP2) {
        PG8_STAGE(PG8_SB(0, 0), cB, voffB); PG8_STAGE(PG8_SB(0, 1), cB + hstep, voffB); PG8_STAGE(PG8_SA(0, 0), cA, voffA); PG8_STAGE(PG8_SA(0, 1), cA + hstep, voffA);
        if (wr == 1) PG8_BAR;
        PG8_WAIT_V(2); PG8_BAR;
        PG8_STAGE(PG8_SB(1, 0), cB + kstep, voffB); PG8_STAGE(PG8_SA(1, 0), cA + kstep, voffA); PG8_STAGE(PG8_SB(1, 1), cB + hstep + kstep, voffB);
        PG8_WAIT_V(6); PG8_BAR;
    } else {
        PG8_STAGE(PG8_SB(0, 0), cB, voffB); PG8_STAGE(PG8_SA(0, 0), cA, voffA); PG8_STAGE(PG8_SB(0, 1), cB + hstep, voffB); PG8_STAGE(PG8_SA(0, 1), cA + hstep, voffA);
        if (wr == 1) PG8_BAR;
        PG8_WAIT_V(4); PG8_BAR;
        PG8_STAGE(PG8_SB(1, 0), cB + kstep, voffB); PG8_STAGE(PG8_SA(1, 0), cA + kstep, voffA); PG8_STAGE(PG8_SB(1, 1), cB + hstep + kstep, voffB);
        PG8_WAIT_V(6); PG8_BAR;
    }
    for (;;) {
        const bool has_next = S.next(ui + 1, nxt);
        const char* nA = has_next ? (const char*)g.A + (size_t)nxt.pm * tstep : cA; const char* nB = has_next ? (const char*)g.Bt + (size_t)nxt.pn * tstep : cB;
        for (int t = 0; t < nt; t += 2) {
            const bool last = (t == nt - 2);
            const char* a1 = cA + (size_t)(t + 1) * kstep;
            const char* a2 = last ? nA : cA + (size_t)(t + 2) * kstep; const char* b2 = last ? nB : cB + (size_t)(t + 2) * kstep;
            const char* a3 = a2 + kstep; const char* b3 = b2 + kstep;
            if (last && has_next) S.a_ready(nxt);
            if constexpr (SP2) {
            PG8_LDB(B0, 0, 0); PG8_LDB(B1, 0, 1); PG8_SCHED; PG8_LDA(At, 0, 0); PG8_STAGE(PG8_SA(1, 1), a1 + hstep, voffA);
            PG8_WAIT_V(8); PG8_WAIT_L(0); PG8_BAR; PG8_MMA(0, 0, At, B0); PG8_MMA(0, 1, At, B1); PG8_BAR; PG8_SCHED;
            PG8_LDA(At, 0, 1); PG8_STAGE(PG8_SB(0, 0), b2, voffB); PG8_STAGE(PG8_SB(0, 1), b2 + hstep, voffB); PG8_STAGE(PG8_SA(0, 0), a2, voffA);
            PG8_WAIT_V(8); PG8_WAIT_L(0); PG8_BAR; PG8_MMA(1, 0, At, B0); PG8_MMA(1, 1, At, B1); PG8_BAR; PG8_SCHED;
            PG8_LDB(B0, 1, 0); PG8_LDB(B1, 1, 1); PG8_SCHED; PG8_LDA(At, 1, 0); PG8_STAGE(PG8_SA(0, 1), a2 + hstep, voffA);
            PG8_WAIT_V(8); PG8_WAIT_L(0); PG8_BAR; PG8_MMA(0, 0, At, B0); PG8_MMA(0, 1, At, B1); PG8_BAR; PG8_SCHED;
            PG8_LDA(At, 1, 1); PG8_STAGE(PG8_SB(1, 0), b3, voffB); PG8_STAGE(PG8_SB(1, 1), b3 + hstep, voffB); PG8_STAGE(PG8_SA(1, 0), a3, voffA);
            PG8_WAIT_V(8); PG8_WAIT_L(0); PG8_BAR; PG8_MMA(1, 0, At, B0); PG8_MMA(1, 1, At, B1); PG8_BAR; PG8_SCHED;
            } else {
            PG8_LDB(B0, 0, 0); PG8_SCHED; PG8_LDA(At, 0, 0); PG8_STAGE(PG8_SA(1, 1), a1 + hstep, voffA);
            PG8_WAIT_L(8); PG8_BAR; PG8_WAIT_L(0); PG8_MMA(0, 0, At, B0); PG8_BAR; PG8_SCHED;
            PG8_LDB(B1, 0, 1); PG8_STAGE(PG8_SB(0, 0), b2, voffB);
            PG8_BAR; PG8_WAIT_L(0); PG8_MMA(0, 1, At, B1); PG8_BAR;
            PG8_LDA(At, 0, 1); PG8_STAGE(PG8_SA(0, 0), a2, voffA);
            PG8_BAR; PG8_WAIT_L(0); PG8_MMA(1, 0, At, B0); PG8_BAR; PG8_SCHED;
            PG8_STAGE(PG8_SB(0, 1), b2 + hstep, voffB);
            PG8_WAIT_V(6); PG8_BAR; PG8_MMA(1, 1, At, B1); PG8_BAR;
            PG8_LDB(B0, 1, 0); PG8_SCHED; PG8_LDA(At, 1, 0); PG8_STAGE(PG8_SA(0, 1), a2 + hstep, voffA);
            PG8_WAIT_L(8); PG8_BAR; PG8_WAIT_L(0); PG8_MMA(0, 0, At, B0); PG8_BAR; PG8_SCHED;
            PG8_LDB(B1, 1, 1); PG8_STAGE(PG8_SB(1, 0), b3, voffB);
            PG8_BAR; PG8_WAIT_L(0); PG8_MMA(0, 1, At, B1); PG8_BAR;
            PG8_LDA(At, 1, 1); PG8_STAGE(PG8_SA(1, 0), a3, voffA);
            PG8_BAR; PG8_WAIT_L(0); PG8_MMA(1, 0, At, B0); PG8_BAR; PG8_SCHED;
            PG8_STAGE(PG8_SB(1, 1), b3 + hstep, voffB);
            PG8_WAIT_V(6); PG8_BAR; PG8_MMA(1, 1, At, B1); PG8_BAR;
            }
        }
        if constexpr (ALIGN_EPI) { if (wr == 0) PG8_BAR; }
        if constexpr (!Epi::AFTER_DRAIN) { E(acc, cur, wr, wc, fr, fq); S.done(cur); }
        if (!has_next) break;
#pragma unroll
        for (int a = 0; a < 2; ++a)
#pragma unroll
            for (int b = 0; b < 2; ++b)
#pragma unroll
                for (int m = 0; m < 4; ++m)
#pragma unroll
                    for (int n = 0; n < 2; ++n) acc[a][b][m][n] = (f32x4){0.f, 0.f, 0.f, 0.f};
        cur = nxt; cA = nA; cB = nB; ++ui;
        if constexpr (ALIGN_EPI) { if (wr == 1) PG8_BAR; }
    }
    PG8_WAIT_V(0);
    if constexpr (!ALIGN_EPI) { if (wr == 0) PG8_BAR; }
    PG8_BAR;
    if constexpr (Epi::AFTER_DRAIN) { E.fused(acc, cur, wr, wc, fr, fq, lds, wid, lane); S.done(cur); }
#undef PG8_SA
#undef PG8_SB
#undef PG8_STAGE
#undef PG8_LDA
#undef PG8_LDB
#undef PG8_MMA
#undef PG8_WAIT_V
#undef PG8_WAIT_L
#undef PG8_BAR
#undef PG8_SCHED
}
}
#define XB_TMO      128
#define XB_XCNT(j)  (256  + 64 * (j))
#define XB_XSUB(j)  (1280 + 64 * (j))
#define XB_XGEN(j)  (2304 + 64 * (j))
#define XB_TOP      3328
#define XB_TOPGEN   3392
#define XCD_BAR_WORDS 3456
#define XB_SPIN_CAP (1u << 18)

__device__ __forceinline__ unsigned xb_ld(unsigned* p)              { return __hip_atomic_load(p, __ATOMIC_RELAXED, __HIP_MEMORY_SCOPE_AGENT); }
__device__ __forceinline__ unsigned xb_add(unsigned* p, unsigned v) { return __hip_atomic_fetch_add(p, v, __ATOMIC_RELAXED, __HIP_MEMORY_SCOPE_AGENT); }
__device__ __forceinline__ unsigned xb_xcc_id() { return (unsigned)__builtin_amdgcn_s_getreg((3 << 11) | 20) & 0xFu; }
#define XB_SPIN(cond, bar) do { unsigned _sp = 0; while (cond) { __builtin_amdgcn_s_sleep(1); \
    if ((++_sp & 255u) == 0u) { if (xb_ld(&(bar)[XB_TMO])) break; if (_sp > XB_SPIN_CAP) { atomicAdd(&(bar)[XB_TMO], 1u); break; } } } } while (0)

struct XcdBarrier {
    unsigned* bar; unsigned x;
    volatile LAS unsigned* st;
};

__device__ __forceinline__ XcdBarrier xcd_barrier_post(unsigned* bar, volatile LAS unsigned* st) {
    XcdBarrier b; b.bar = bar; b.x = xb_xcc_id(); b.st = st;
    if (threadIdx.x == 0) (void)xb_add(&bar[XB_XCNT(b.x)], 1u);
    return b;
}
__device__ __forceinline__ void xcd_barrier_complete(unsigned* bar, unsigned x, unsigned& nloc, unsigned& nx) {
    const unsigned G = gridDim.x * gridDim.y * gridDim.z;
    unsigned sum, cnt, mine, sp = 0u;
    for (;;) {
        sum = 0u; cnt = 0u; mine = 0u;
#pragma unroll
        for (unsigned j = 0; j < 16; ++j) { const unsigned c = xb_ld(&bar[XB_XCNT(j)]); sum += c; cnt += (c > 0u) ? 1u : 0u; mine = (j == x) ? c : mine; }
        if (sum == G) break;
        __builtin_amdgcn_s_sleep(1);
        if ((++sp & 255u) == 0u) { if (xb_ld(&bar[XB_TMO])) break; if (sp > XB_SPIN_CAP) { atomicAdd(&bar[XB_TMO], 1u); break; } }
    }
    nloc = mine > 0u ? mine : 1u; nx = cnt > 0u ? cnt : 1u;
}

__device__ __forceinline__ void xcd_barrier(const XcdBarrier& b) {
    asm volatile("s_waitcnt vmcnt(0)" ::: "memory");
    __syncthreads();
    if (threadIdx.x == 0) {
        unsigned* bar = b.bar;
        __builtin_amdgcn_s_waitcnt(0);
        unsigned nloc = b.st[0], nx = b.st[1];
        if (nloc == 0u) { xcd_barrier_complete(bar, b.x, nloc, nx); b.st[0] = nloc; b.st[1] = nx; }
        const unsigned old = xb_add(&bar[XB_XSUB(b.x)], 1u);
        const unsigned gen = old / nloc;
        if (old + 1u == (gen + 1u) * nloc) {
            __builtin_amdgcn_fence(__ATOMIC_RELEASE, "agent");
            asm volatile("s_waitcnt vmcnt(0)" ::: "memory");
            const unsigned og = xb_add(&bar[XB_TOP], 1u);
            const unsigned tg = og / nx;
            if (og + 1u == (tg + 1u) * nx) xb_add(&bar[XB_TOPGEN], 1u);
            else XB_SPIN(xb_ld(&bar[XB_TOPGEN]) == tg, bar);
            __builtin_amdgcn_fence(__ATOMIC_ACQUIRE, "agent");
            xb_add(&bar[XB_XGEN(b.x)], 1u);
            asm volatile("s_waitcnt vmcnt(0)" ::: "memory");
        } else {
            XB_SPIN(xb_ld(&bar[XB_XGEN(b.x)]) == gen, bar);
            __builtin_amdgcn_fence(__ATOMIC_ACQUIRE, "agent");
            asm volatile("s_waitcnt vmcnt(0)" ::: "memory");
        }
    }
    __syncthreads();
}
constexpr size_t MiB = 1u << 20;
constexpr size_t WS_CTL = 0, CTL_ZERO_BYTES = 1 * MiB;
constexpr size_t WS_WAB_IN = 1 * MiB, WS_WAB_OUT = 97 * MiB, WS_WGU0 = 129 * MiB, WS_WDN0 = 301 * MiB, WS_WCD_IN = 387 * MiB, WS_WCD_OUT = 467 * MiB, WS_WGU1 = 499 * MiB, WS_WDN1 = 671 * MiB;
constexpr size_t WS_WSMALL = 757 * MiB, WS_WRG = 758 * MiB;
constexpr size_t WS_U = 760 * MiB, WS_PROJ = 824 * MiB, WS_O = 1016 * MiB, WS_H = 1080 * MiB;
constexpr size_t WS_ACT = WS_PROJ;
constexpr size_t WS_SMALL32 = 1208 * MiB, WS_CF = 1209 * MiB, WS_QT = 1210 * MiB, WS_KDT = 1226 * MiB, WS_PM = 1242 * MiB, WS_GDEC = 1246 * MiB, WS_ORAW = 1247 * MiB, WS_SSQ = 1311 * MiB;
constexpr size_t WS_END = 1313 * MiB;
constexpr int CW_BAR = 4096;

constexpr int RING_BYTES = 131072;
constexpr int LDSCTL_OFF = RING_BYTES, MISC_OFF = LDSCTL_OFF + 320;
constexpr int LDS_BYTES = 147456;
constexpr int NWAVES = 8, NTHR = 512;

struct Params {
    const float *x, *norm_mix, *norm_ffn, *ffn_w_gate, *ffn_w_up, *ffn_w_down, *ab_w_in, *gla_w_gate_up, *gla_b_gate, *gla_norm, *fox_b_f, *ab_w_out,
                *cd_w_in, *rg_conv_w, *rg_conv_b, *rg_w_x, *rg_b_x, *rg_w_a, *rg_b_a, *rg_lambda, *cd_w_out, *final_norm;
    float* out; unsigned char* ws; int ph_lo, ph_hi;
};

__device__ __forceinline__ void tr_item(const float* W, int ldn, int K, int n_src0, bf16_t* WT, int row_dst0, LAS float* scr, int kb, int lane) {
    const int k0 = 64 * kb;
#pragma unroll 8
    for (int i = 0; i < 32; ++i) { const int kk = 2 * i + (lane >> 5); scr[kk * 33 + (lane & 31)] = W[(size_t)(k0 + kk) * ldn + n_src0 + (lane & 31)]; }
    LDS_WAIT(); asm volatile("" ::: "memory");
    const int c = lane & 7;
#pragma unroll
    for (int j = 0; j < 4; ++j) { const int n = (lane >> 3) + 8 * j; const LAS float* s = scr + (8 * c) * 33 + n;
        u32x4 o; o.x = cvt_pk_bf16(s[0 * 33], s[1 * 33]); o.y = cvt_pk_bf16(s[2 * 33], s[3 * 33]); o.z = cvt_pk_bf16(s[4 * 33], s[5 * 33]); o.w = cvt_pk_bf16(s[6 * 33], s[7 * 33]);
        *(u32x4*)(WT + (size_t)(row_dst0 + n) * K + k0 + 8 * c) = o; }
    LDS_WAIT(); asm volatile("" ::: "memory");
}
#define TR_JOB(W_, ldn_, K_, nsrc0_, ncols_, WT_, rdst0_) { constexpr int nnb_ = (ncols_) / 32, nit_ = ((K_) / 64) * nnb_; \
    if (r < nit_) { const int kb_ = r / nnb_, nb_ = r % nnb_; tr_item((W_), (ldn_), (K_), (nsrc0_) + 32 * nb_, (WT_), (rdst0_) + 32 * nb_, scr, kb_, lane); continue; } r -= nit_; }
#define TR_JOB_GU(W_, WT_, off_) { constexpr int nnb_ = DFF / 32, nit_ = (DM / 64) * nnb_; \
    if (r < nit_) { const int kb_ = r / nnb_, nb_ = r % nnb_, c0_ = 32 * nb_; tr_item((W_), DFF, DM, c0_, (WT_), 256 * (c0_ / 128) + (c0_ % 128) + (off_), scr, kb_, lane); continue; } r -= nit_; }

__device__ __forceinline__ void rms_row_bf16(const float* xrow, const float* g, bf16_t* orow, int lane) {
    const f32x4* xr = (const f32x4*)xrow + lane; const f32x4* gr = (const f32x4*)g + lane;
    f32x4 v[16]; float s = 0.f;
#pragma unroll
    for (int j = 0; j < 16; ++j) { v[j] = xr[64 * j]; s += (v[j].x * v[j].x + v[j].y * v[j].y) + (v[j].z * v[j].z + v[j].w * v[j].w); }
    const float rstd = 1.0f / sqrtf(wave_sum(s) * (1.0f / DM) + EPS);
    u32x2* o8 = (u32x2*)orow + lane;
#pragma unroll
    for (int j = 0; j < 16; ++j) { const f32x4 gg = gr[64 * j]; u32x2 w; w.x = cvt_pk_bf16(v[j].x * rstd * gg.x, v[j].y * rstd * gg.y); w.y = cvt_pk_bf16(v[j].z * rstd * gg.z, v[j].w * rstd * gg.w); o8[64 * j] = w; }
}
__device__ __forceinline__ void rms_row_f32(const float* xrow, const float* g, float* orow, int lane) {
    const f32x4* xr = (const f32x4*)xrow + lane; const f32x4* gr = (const f32x4*)g + lane;
    f32x4 v[16]; float s = 0.f;
#pragma unroll
    for (int j = 0; j < 16; ++j) { v[j] = xr[64 * j]; s += (v[j].x * v[j].x + v[j].y * v[j].y) + (v[j].z * v[j].z + v[j].w * v[j].w); }
    const float rstd = 1.0f / sqrtf(wave_sum(s) * (1.0f / DM) + EPS);
    f32x4* o = (f32x4*)orow + lane;
#pragma unroll
    for (int j = 0; j < 16; ++j) { const f32x4 gg = gr[64 * j]; o[64 * j] = v[j] * rstd * gg; }
}
__device__ __forceinline__ void phase_rms_bf16(const float* src, const float* g, bf16_t* dst, int gw, int ngw, int lane) {
    for (int m = gw; m < MTOK; m += ngw) rms_row_bf16(src + (size_t)m * DM, g, dst + (size_t)m * DM, lane);
}

__device__ __forceinline__ void phase_p0(const Params& p, LAS unsigned char* lds, int gw, int ngw, int wave, int lane) {
    unsigned char* ws = p.ws;
    LAS float* scr = (LAS float*)(lds + wave * 8704);
    bf16_t* WAB_IN = (bf16_t*)(ws + WS_WAB_IN); bf16_t* WAB_OUT = (bf16_t*)(ws + WS_WAB_OUT); bf16_t* WGU0 = (bf16_t*)(ws + WS_WGU0); bf16_t* WDN0 = (bf16_t*)(ws + WS_WDN0);
    bf16_t* WCD_IN = (bf16_t*)(ws + WS_WCD_IN); bf16_t* WCD_OUT = (bf16_t*)(ws + WS_WCD_OUT); bf16_t* WGU1 = (bf16_t*)(ws + WS_WGU1); bf16_t* WDN1 = (bf16_t*)(ws + WS_WDN1);
    bf16_t* WRG = (bf16_t*)(ws + WS_WRG);
    constexpr int I_AB = (DM / 64) * (6144 / 32), I_SQ = (DM / 64) * (DM / 32), I_CD = (DM / 64) * (CD_IN / 32), I_GU = (DM / 64) * (DFF / 32), I_DN = (DFF / 64) * (DM / 32), I_RG = 16 * (256 / 64) * (256 / 32);
    constexpr int NITEMS = 2 * I_AB + 2 * I_SQ + I_CD + 4 * I_GU + 2 * I_DN + I_RG;
    for (int it = gw; it < NITEMS; it += ngw) {
        int r = it;
        TR_JOB(p.ab_w_in, AB_IN, DM, 0, 6144, WAB_IN, 0)
        TR_JOB(p.ab_w_in, AB_IN, DM, 6160, 6144, WAB_IN, 6144)
        TR_JOB(p.ab_w_out, DM, DM, 0, DM, WAB_OUT, 0)
        TR_JOB_GU(p.ffn_w_gate, WGU0, 0)
        TR_JOB_GU(p.ffn_w_up, WGU0, 128)
        TR_JOB(p.ffn_w_down, DM, DFF, 0, DM, WDN0, 0)
        TR_JOB(p.cd_w_in, CD_IN, DM, 0, CD_IN, WCD_IN, 0)
        TR_JOB(p.cd_w_out, DM, DM, 0, DM, WCD_OUT, 0)
        TR_JOB_GU(p.ffn_w_gate + (size_t)DM * DFF, WGU1, 0)
        TR_JOB_GU(p.ffn_w_up + (size_t)DM * DFF, WGU1, 128)
        TR_JOB(p.ffn_w_down + (size_t)DFF * DM, DM, DFF, 0, DM, WDN1, 0)
        {
            const int mat = r / 32, rr = r % 32, kb_ = rr / 8, nb_ = rr % 8;
            const float* W = (mat < 8 ? p.rg_w_x : p.rg_w_a) + (size_t)(mat & 7) * 65536;
            tr_item(W, 256, 256, 32 * nb_, WRG + (size_t)mat * 65536, 32 * nb_, scr, kb_, lane);
        }
    }
    { bf16_t* WS_ = (bf16_t*)(ws + WS_WSMALL);
      for (int i = gw * 64 + lane; i < 32 * DM; i += ngw * 64) { const int c = i & 31, k = i >> 5; const int sc = c < 16 ? 6144 + c : 12304 + (c - 16);
          WS_[(size_t)c * DM + k] = f2bf(p.ab_w_in[(size_t)k * AB_IN + sc]); } }
    phase_rms_bf16(p.x, p.norm_mix, (bf16_t*)(ws + WS_U), gw, ngw, lane);
}

__device__ __forceinline__ void phase_small32(const Params& p, LAS unsigned char* lds, int wave, int lane) {
    const bf16_t* U = (const bf16_t*)(p.ws + WS_U); const bf16_t* WS_ = (const bf16_t*)(p.ws + WS_WSMALL); float* S32 = (float*)(p.ws + WS_SMALL32);
    LAS float* red = (LAS float*)lds;
    const int h = lane >> 5, c = lane & 31;
    for (int unit = blockIdx.x; unit < MTOK / 32; unit += gridDim.x) {
        const int row0 = unit * 32, kbase = wave * 512;
        f32x16 acc; for (int i = 0; i < 16; ++i) acc[i] = 0.f;
        const bf16_t* ap = U + (size_t)(row0 + c) * DM + kbase + 8 * h; const bf16_t* bp = WS_ + (size_t)c * DM + kbase + 8 * h;
#pragma unroll 8
        for (int s = 0; s < 32; ++s) { const bf16x8 a = *(const bf16x8*)(ap + 16 * s), b = *(const bf16x8*)(bp + 16 * s); acc = MFMA32(a, b, acc); }
#pragma unroll
        for (int r = 0; r < 16; ++r) red[(wave * 32 + crow(r, h)) * 33 + c] = acc[r];
        __syncthreads();
        for (int i = threadIdx.x; i < 1024; i += NTHR) { const int t = i >> 5, cc = i & 31; float s = 0.f;
#pragma unroll
            for (int w = 0; w < 8; ++w) s += red[(w * 32 + t) * 33 + cc];
            S32[(size_t)(row0 + t) * 32 + cc] = s; }
        __syncthreads();
    }
}

__device__ __forceinline__ void phase_fox_cumsum(const Params& p, int gw, int ngw, int lane) {
    const float* S32 = (const float*)(p.ws + WS_SMALL32); float* CF = (float*)(p.ws + WS_CF);
    for (int u = gw; u < NB * 16; u += ngw) { const int b = u >> 4, hd = u & 15; const float bias = p.fox_b_f[hd];
        float v[32]; float run = 0.f;
#pragma unroll
        for (int i = 0; i < 32; ++i) { const int t = 32 * lane + i; run += log_sigmoid_acc(S32[(size_t)(b * SEQ + t) * 32 + 16 + hd] + bias); v[i] = run; }
        float incl = run;
#pragma unroll
        for (int o = 1; o < 64; o <<= 1) { const float t = __shfl_up(incl, o); if (lane >= o) incl += t; }
        const float off = incl - run;
#pragma unroll
        for (int i = 0; i < 32; ++i) CF[(size_t)u * SEQ + 32 * lane + i] = v[i] + off;
    }
}

constexpr int GP_PITCH = 528;
__device__ __forceinline__ void phase_gla_pre(const Params& p, LAS unsigned char* lds, int wave, int lane) {
    const unsigned char* ws = p.ws;
    const bf16_t* PROJ = (const bf16_t*)(ws + WS_PROJ); const float* S32 = (const float*)(ws + WS_SMALL32);
    bf16_t* QT = (bf16_t*)(ws + WS_QT); bf16_t* KDT = (bf16_t*)(ws + WS_KDT); bf16_t* PM = (bf16_t*)(ws + WS_PM); float* GDEC = (float*)(ws + WS_GDEC);
    LAS float* G = (LAS float*)lds;
    LAS float* TOT = (LAS float*)(lds + 4096);
    LAS unsigned char* QTl = lds + 8192;
    LAS unsigned char* KTl = lds + 8192 + 64 * GP_PITCH;
    const int tid = threadIdx.x, k = tid & 255, th = tid >> 8, h = lane >> 5;
    for (int unit = blockIdx.x; unit < NB * 4 * 32; unit += gridDim.x) {
        const int b = unit >> 7, hd = (unit >> 5) & 3, c = unit & 31, R0 = b * SEQ + 64 * c;
        for (int i = tid; i < 1024; i += NTHR) G[i] = S32[(size_t)(R0 + (i >> 4)) * 32 + (i & 15)];
        float w[16];
#pragma unroll
        for (int r = 0; r < 16; ++r) w[r] = p.gla_w_gate_up[r * 1024 + hd * 256 + k];
        const float bias = p.gla_b_gate[hd * 256 + k];
        __syncthreads();
        float bc[32]; float run = 0.f;
#pragma unroll
        for (int tt = 0; tt < 32; ++tt) { const LAS f32x4* g4 = (const LAS f32x4*)(G + (32 * th + tt) * 16); float xx = bias;
#pragma unroll
            for (int q4 = 0; q4 < 4; ++q4) { const f32x4 gv = g4[q4]; xx += gv.x * w[4 * q4] + gv.y * w[4 * q4 + 1] + gv.z * w[4 * q4 + 2] + gv.w * w[4 * q4 + 3]; }
            run += log_sigmoid_acc(xx) * (1.0f / 16.0f); bc[tt] = run; }
        TOT[th * 256 + k] = run;
        __syncthreads();
        const float t0 = TOT[k], t1 = TOT[256 + k], blast = t0 + t1, boff = th ? t0 : 0.f;
        if (th == 0) GDEC[(size_t)unit * 256 + k] = expf(blast);
        const bf16_t* qp = PROJ + (size_t)(R0 + 32 * th) * AB_MAIN + PJ_GQ + hd * 256 + k; const bf16_t* kp = PROJ + (size_t)(R0 + 32 * th) * AB_MAIN + PJ_GK + hd * 256 + k;
        bf16_t* qto = QT + (size_t)(R0 + 32 * th) * 1024 + hd * 256 + k;
        bf16_t* kdo = KDT + ((size_t)unit * 256 + k) * 64 + 32 * th;
#pragma unroll
        for (int t8 = 0; t8 < 4; ++t8) { float kd[8];
#pragma unroll
            for (int i = 0; i < 8; ++i) { const int tt = 8 * t8 + i; const float bb = bc[tt] + boff;
                const float qv = bf2f(qp[(size_t)tt * AB_MAIN]), kv = bf2f(kp[(size_t)tt * AB_MAIN]);
                const float qt = qv * 0.0625f * expf(bb), kt = kv * expf(-bb); kd[i] = kv * expf(blast - bb);
                const bf16_t qb = f2bf(qt);
                *(LAS bf16_t*)(QTl + (32 * th + tt) * GP_PITCH + 2 * k) = qb; *(LAS bf16_t*)(KTl + (32 * th + tt) * GP_PITCH + 2 * k) = f2bf(kt);
                qto[(size_t)tt * 1024] = qb; }
            u32x4 o; o.x = cvt_pk_bf16(kd[0], kd[1]); o.y = cvt_pk_bf16(kd[2], kd[3]); o.z = cvt_pk_bf16(kd[4], kd[5]); o.w = cvt_pk_bf16(kd[6], kd[7]);
            *(u32x4*)(kdo + 8 * t8) = o; }
        __syncthreads();
        if (wave < 4) { const int ti = wave & 1, si = wave >> 1;
            f32x16 acc; for (int i = 0; i < 16; ++i) acc[i] = 0.f;
            const LAS unsigned char* ap = QTl + (32 * ti + (lane & 31)) * GP_PITCH + 16 * h; const LAS unsigned char* bp = KTl + (32 * si + (lane & 31)) * GP_PITCH + 16 * h;
#pragma unroll
            for (int s = 0; s < 16; ++s) { const bf16x8 a = *(const LAS bf16x8*)(ap + 32 * s), bb = *(const LAS bf16x8*)(bp + 32 * s); acc = MFMA32(a, bb, acc); }
            const int sc = 32 * si + (lane & 31);
#pragma unroll
            for (int r = 0; r < 16; ++r) { const int t = 32 * ti + crow(r, h); PM[(size_t)unit * 4096 + t * 64 + sc] = f2bf(sc <= t ? acc[r] : 0.f); }
        }
        __syncthreads();
    }
}

constexpr int VT_PITCH = 144;
__device__ __forceinline__ void phase_gla_seq(const Params& p, LAS unsigned char* lds, int wave, int lane) {
    const unsigned char* ws = p.ws;
    const bf16_t* PROJ = (const bf16_t*)(ws + WS_PROJ); const bf16_t* QT = (const bf16_t*)(ws + WS_QT); const bf16_t* KDT = (const bf16_t*)(ws + WS_KDT); const bf16_t* PM = (const bf16_t*)(ws + WS_PM);
    const float* GDEC = (const float*)(ws + WS_GDEC); float* ORAW = (float*)(p.ws + WS_ORAW); float* SSQ = (float*)(p.ws + WS_SSQ);
    LAS float* RED = (LAS float*)lds;
    LAS unsigned char* VT = lds + 65536;
    const int tid = threadIdx.x, h = lane >> 5, l31 = lane & 31;
    for (int unit = blockIdx.x; unit < NB * 4 * 16; unit += gridDim.x) {
        const int b = unit >> 6, hd = (unit >> 4) & 3, vs = unit & 15, v0 = 32 * vs;
        f32x16 S; for (int i = 0; i < 16; ++i) S[i] = 0.f;
        for (int c = 0; c < 32; ++c) {
            const int R0 = b * SEQ + 64 * c, cu = (b * 4 + hd) * 32 + c;
            LAS unsigned char* vt = VT + (c & 1) * (32 * VT_PITCH);
            { const int s = tid >> 3, v4 = (tid & 7) * 4; const u32x2 raw = *(const u32x2*)(PROJ + (size_t)(R0 + s) * AB_MAIN + PJ_GV + hd * 512 + v0 + v4);
              *(LAS bf16_t*)(vt + (v4 + 0) * VT_PITCH + 2 * s) = (bf16_t)(raw.x & 0xffffu); *(LAS bf16_t*)(vt + (v4 + 1) * VT_PITCH + 2 * s) = (bf16_t)(raw.x >> 16);
              *(LAS bf16_t*)(vt + (v4 + 2) * VT_PITCH + 2 * s) = (bf16_t)(raw.y & 0xffffu); *(LAS bf16_t*)(vt + (v4 + 3) * VT_PITCH + 2 * s) = (bf16_t)(raw.y >> 16); }
            bf16x8 qa[2][2];
#pragma unroll
            for (int ti = 0; ti < 2; ++ti)
#pragma unroll
                for (int s2 = 0; s2 < 2; ++s2) { const bf16_t* q = QT + (size_t)(R0 + 32 * ti + l31) * 1024 + hd * 256 + 32 * wave + 16 * s2 + 4 * h;
                    const s16x4 lo = *(const s16x4*)q, hi = *(const s16x4*)(q + 8); qa[ti][s2] = cat4(lo, hi); }
            bf16x8 kda[4];
#pragma unroll
            for (int ss = 0; ss < 4; ++ss) kda[ss] = *(const bf16x8*)(KDT + ((size_t)cu * 256 + 32 * wave + l31) * 64 + 16 * ss + 8 * h);
            const int tip = wave & 1, ssp = wave >> 1;
            const bf16x8 pa = *(const bf16x8*)(PM + (size_t)cu * 4096 + (32 * tip + l31) * 64 + 16 * ssp + 8 * h);
            f32x4 gd[4];
#pragma unroll
            for (int g = 0; g < 4; ++g) gd[g] = *(const f32x4*)(GDEC + (size_t)cu * 256 + 32 * wave + 8 * g + 4 * h);
            __syncthreads();
            f32x16 oacc[2];
#pragma unroll
            for (int ti = 0; ti < 2; ++ti) for (int i = 0; i < 16; ++i) oacc[ti][i] = 0.f;
            const bf16x8 sb0 = pack8(S[0], S[1], S[2], S[3], S[4], S[5], S[6], S[7]), sb1 = pack8(S[8], S[9], S[10], S[11], S[12], S[13], S[14], S[15]);
#pragma unroll
            for (int ti = 0; ti < 2; ++ti) { oacc[ti] = MFMA32(qa[ti][0], sb0, oacc[ti]); oacc[ti] = MFMA32(qa[ti][1], sb1, oacc[ti]); }
            bf16x8 vb[4];
#pragma unroll
            for (int ss = 0; ss < 4; ++ss) vb[ss] = *(const LAS bf16x8*)(vt + l31 * VT_PITCH + 32 * ss + 16 * h);
            { const bf16x8 vbp = ssp == 0 ? vb[0] : ssp == 1 ? vb[1] : ssp == 2 ? vb[2] : vb[3];
              if (tip == 0) oacc[0] = MFMA32(pa, vbp, oacc[0]); else oacc[1] = MFMA32(pa, vbp, oacc[1]); }
#pragma unroll
            for (int r = 0; r < 16; ++r) S[r] *= gd[r >> 2][r & 3];
#pragma unroll
            for (int ss = 0; ss < 4; ++ss) S = MFMA32(kda[ss], vb[ss], S);
#pragma unroll
            for (int ti = 0; ti < 2; ++ti)
#pragma unroll
                for (int r = 0; r < 16; ++r) RED[(wave * 64 + 32 * ti + crow(r, h)) * 32 + l31] = oacc[ti][r];
            __syncthreads();
            { const int t = tid >> 3, v4 = (tid & 7) * 4; f32x4 o = {0.f, 0.f, 0.f, 0.f};
#pragma unroll
              for (int w = 0; w < 8; ++w) o += *(const LAS f32x4*)(RED + (w * 64 + t) * 32 + v4);
              *(f32x4*)(ORAW + (size_t)(R0 + t) * 2048 + hd * 512 + v0 + v4) = o;
              float q = (o.x * o.x + o.y * o.y) + (o.z * o.z + o.w * o.w);
              q += __shfl_xor(q, 1); q += __shfl_xor(q, 2); q += __shfl_xor(q, 4);
              if ((tid & 7) == 0) SSQ[(size_t)(R0 + t) * 64 + hd * 16 + vs] = q; }
        }
        __syncthreads();
    }
}

__device__ __forceinline__ void phase_gla_post(const Params& p, int gw, int ngw, int lane) {
    const bf16_t* PROJ = (const bf16_t*)(p.ws + WS_PROJ); const float* ORAW = (const float*)(p.ws + WS_ORAW); const float* SSQ = (const float*)(p.ws + WS_SSQ); bf16_t* O = (bf16_t*)(p.ws + WS_O);
    const f32x4 gn0 = *(const f32x4*)(p.gla_norm + 8 * lane), gn1 = *(const f32x4*)(p.gla_norm + 8 * lane + 4);
    for (int u = gw; u < MTOK * 4; u += ngw) { const int row = u >> 2, hd = u & 3;
        float ss = 0.f;
#pragma unroll
        for (int i = 0; i < 4; ++i) { const f32x4 s4 = *(const f32x4*)(SSQ + (size_t)row * 64 + hd * 16 + 4 * i); ss += (s4.x + s4.y) + (s4.z + s4.w); }
        const float rstd = 1.0f / sqrtf(ss * (1.0f / 512.0f) + EPS);
        const f32x4 o0 = *(const f32x4*)(ORAW + (size_t)row * 2048 + hd * 512 + 8 * lane), o1 = *(const f32x4*)(ORAW + (size_t)row * 2048 + hd * 512 + 8 * lane + 4);
        const u32x4 gr = *(const u32x4*)(PROJ + (size_t)row * AB_MAIN + PJ_GG + hd * 512 + 8 * lane);
        float g[8] = {bflo(gr.x), bfhi(gr.x), bflo(gr.y), bfhi(gr.y), bflo(gr.z), bfhi(gr.z), bflo(gr.w), bfhi(gr.w)};
        float o[8] = {o0.x * gn0.x, o0.y * gn0.y, o0.z * gn0.z, o0.w * gn0.w, o1.x * gn1.x, o1.y * gn1.y, o1.z * gn1.z, o1.w * gn1.w};
#pragma unroll
        for (int i = 0; i < 8; ++i) o[i] = o[i] * rstd * g[i] / (1.0f + __expf(-g[i]));
        u32x4 w; w.x = cvt_pk_bf16(o[0], o[1]); w.y = cvt_pk_bf16(o[2], o[3]); w.z = cvt_pk_bf16(o[4], o[5]); w.w = cvt_pk_bf16(o[6], o[7]);
        *(u32x4*)(O + (size_t)row * DM + hd * 512 + 8 * lane) = w; }
}

constexpr int AK_PITCH = 272, AV_PITCH = 320;
constexpr int AK_BYTES = 64 * AK_PITCH, AV_BYTES = 64 * AV_PITCH;
constexpr int A_KOFF = 0, A_VOFF = 2 * AK_BYTES, A_COFF = A_VOFF + 2 * AV_BYTES;
constexpr float ATT_SCALE = 0.08838834764831845f;
constexpr float LOG2E = 1.4426950408889634f;

struct AttnIO { const bf16_t* Q; const bf16_t* K; const bf16_t* V; int ld; bf16_t* O; int ldo; };

__device__ __forceinline__ void attn_stage_load(const AttnIO& io, size_t rowbase, int hd, int key0, u32x4 (&kr)[2], u32x4 (&vr)[2], int tid) {
#pragma unroll
    for (int i = 0; i < 2; ++i) { const int idx = tid + NTHR * i, r = idx >> 4, ch = idx & 15; const size_t off = (rowbase + key0 + r) * (size_t)io.ld + hd * 128 + ch * 8;
        kr[i] = *(const u32x4*)(io.K + off); vr[i] = *(const u32x4*)(io.V + off); }
}
__device__ __forceinline__ void attn_stage_store(LAS unsigned char* lds, int buf, const u32x4 (&kr)[2], const u32x4 (&vr)[2], int tid) {
#pragma unroll
    for (int i = 0; i < 2; ++i) { const int idx = tid + NTHR * i, r = idx >> 4, ch = idx & 15;
        *(LAS u32x4*)(lds + A_KOFF + buf * AK_BYTES + r * AK_PITCH + ch * 16) = kr[i]; *(LAS u32x4*)(lds + A_VOFF + buf * AV_BYTES + r * AV_PITCH + ch * 16) = vr[i]; }
}
__device__ __forceinline__ void attn_qk(LAS unsigned char* lds, int buf, const bf16x8 (&qf)[8], f32x16& s0, f32x16& s1, int lane) {
    const LAS unsigned char* kp = lds + A_KOFF + buf * AK_BYTES + (lane & 31) * AK_PITCH + (lane >> 5) * 16;
    for (int i = 0; i < 16; ++i) { s0[i] = 0.f; s1[i] = 0.f; }
#pragma unroll
    for (int s = 0; s < 8; ++s) { const bf16x8 a0 = *(const LAS bf16x8*)(kp + 32 * s), a1 = *(const LAS bf16x8*)(kp + 32 * AK_PITCH + 32 * s);
        s0 = MFMA32(a0, qf[s], s0); s1 = MFMA32(a1, qf[s], s1); }
}
__device__ __forceinline__ void attn_pv(LAS unsigned char* lds, int buf, const f32x16& p0, const f32x16& p1, f32x16 (&o)[4], int lane) {
    const lds_cptr vp = (lds_cptr)(lds + A_VOFF + buf * AV_BYTES + (4 * (lane >> 5) + ((lane & 15) >> 2)) * AV_PITCH + (((lane >> 4) & 1) * 16 + (lane & 3) * 4) * 2);
    const bf16x8 pf00 = pack8(p0[0], p0[1], p0[2], p0[3], p0[4], p0[5], p0[6], p0[7]), pf01 = pack8(p0[8], p0[9], p0[10], p0[11], p0[12], p0[13], p0[14], p0[15]);
    const bf16x8 pf10 = pack8(p1[0], p1[1], p1[2], p1[3], p1[4], p1[5], p1[6], p1[7]), pf11 = pack8(p1[8], p1[9], p1[10], p1[11], p1[12], p1[13], p1[14], p1[15]);
#pragma unroll
    for (int dt = 0; dt < 4; ++dt) {
        const bf16x8 a00 = cat4(vtr(vp + (0) * AV_PITCH + dt * 64), vtr(vp + (8) * AV_PITCH + dt * 64));
        const bf16x8 a01 = cat4(vtr(vp + (16) * AV_PITCH + dt * 64), vtr(vp + (24) * AV_PITCH + dt * 64));
        const bf16x8 a10 = cat4(vtr(vp + (32) * AV_PITCH + dt * 64), vtr(vp + (40) * AV_PITCH + dt * 64));
        const bf16x8 a11 = cat4(vtr(vp + (48) * AV_PITCH + dt * 64), vtr(vp + (56) * AV_PITCH + dt * 64));
        o[dt] = MFMA32(a00, pf00, o[dt]); o[dt] = MFMA32(a01, pf01, o[dt]); o[dt] = MFMA32(a10, pf10, o[dt]); o[dt] = MFMA32(a11, pf11, o[dt]);
    }
}
__device__ __forceinline__ void attn_store_o(const AttnIO& io, size_t row, int hd, const f32x16 (&o)[4], float scl, int lane) {
    bf16_t* op = io.O + row * (size_t)io.ldo + hd * 128 + 4 * (lane >> 5);
#pragma unroll
    for (int dt = 0; dt < 4; ++dt)
#pragma unroll
        for (int g = 0; g < 4; ++g) { u32x2 w; w.x = cvt_pk_bf16(o[dt][4 * g] * scl, o[dt][4 * g + 1] * scl); w.y = cvt_pk_bf16(o[dt][4 * g + 2] * scl, o[dt][4 * g + 3] * scl);
            *(u32x2*)(op + 32 * dt + 8 * g) = w; }
}

__device__ __forceinline__ void fox_unit(const AttnIO& io, const float* CF, LAS unsigned char* lds, int b, int hd, int qb, int wave, int lane) {
    const int tid = threadIdx.x, h = lane >> 5, l31 = lane & 31;
    const size_t rowbase = (size_t)b * SEQ; const int qpos = 256 * qb + 32 * wave + l31;
    const float* cf = CF + (size_t)(b * 16 + hd) * SEQ;
    bf16x8 qf[8];
#pragma unroll
    for (int s = 0; s < 8; ++s) qf[s] = *(const bf16x8*)(io.Q + (rowbase + qpos) * (size_t)io.ld + hd * 128 + 16 * s + 8 * h);
    const float cq = cf[qpos] * LOG2E;
    f32x16 o[4];
#pragma unroll
    for (int dt = 0; dt < 4; ++dt) for (int i = 0; i < 16; ++i) o[dt][i] = 0.f;
    float m = -1e30f, l = 0.f;
    const int ntiles = 4 * qb + 4;
    u32x4 kr[2], vr[2];
    LAS float* cks = (LAS float*)(lds + A_COFF);
    attn_stage_load(io, rowbase, hd, 0, kr, vr, tid);
    attn_stage_store(lds, 0, kr, vr, tid);
    if (tid < 64) cks[tid] = cf[tid] * LOG2E;
    __syncthreads();
    for (int j = 0; j < ntiles; ++j) {
        const int buf = j & 1; const bool more = j + 1 < ntiles;
        float cnext = 0.f;
        if (more) { attn_stage_load(io, rowbase, hd, 64 * (j + 1), kr, vr, tid); if (tid < 64) cnext = cf[64 * (j + 1) + tid] * LOG2E; }
        if (64 * j <= 256 * qb + 32 * wave + 31) {
            f32x16 s0, s1; attn_qk(lds, buf, qf, s0, s1, lane);
            const LAS float* ck = cks + buf * 64;
            float mx = -__builtin_inff();
#pragma unroll
            for (int g = 0; g < 4; ++g) { const f32x4 c0 = *(const LAS f32x4*)(ck + 8 * g + 4 * h), c1 = *(const LAS f32x4*)(ck + 32 + 8 * g + 4 * h);
#pragma unroll
                for (int i = 0; i < 4; ++i) { const int r = 4 * g + i, key = 64 * j + 8 * g + 4 * h + i;
                    float y0 = s0[r] * (ATT_SCALE * LOG2E) + (cq - c0[i]), y1 = s1[r] * (ATT_SCALE * LOG2E) + (cq - c1[i]);
                    y0 = key <= qpos ? y0 : -__builtin_inff(); y1 = key + 32 <= qpos ? y1 : -__builtin_inff();
                    s0[r] = y0; s1[r] = y1; mx = fmaxf(mx, fmaxf(y0, y1)); } }
            mx = fmaxf(mx, __shfl_xor(mx, 32));
            const float mn = fmaxf(m, mx), alpha = __builtin_amdgcn_exp2f(m - mn); m = mn;
            float ps = 0.f;
#pragma unroll
            for (int r = 0; r < 16; ++r) { s0[r] = __builtin_amdgcn_exp2f(s0[r] - mn); s1[r] = __builtin_amdgcn_exp2f(s1[r] - mn); ps += s0[r] + s1[r]; }
            l = l * alpha + ps;
#pragma unroll
            for (int dt = 0; dt < 4; ++dt) for (int i = 0; i < 16; ++i) o[dt][i] *= alpha;
            attn_pv(lds, buf, s0, s1, o, lane);
        }
        if (more) { attn_stage_store(lds, buf ^ 1, kr, vr, tid); if (tid < 64) cks[(buf ^ 1) * 64 + tid] = cnext; }
        __syncthreads();
    }
    l += __shfl_xor(l, 32);
    attn_store_o(io, rowbase + qpos, hd, o, 1.0f / l, lane);
}

__device__ __forceinline__ void sb_subtile(f32x16& s, int keybase, int qpos, int h, float& R) {
    float lb[16], l1[16];
#pragma unroll
    for (int r = 0; r < 16; ++r) { const float z = s[r] * ATT_SCALE; const int key = keybase + crow(r, h);
        const float lp = __logf(1.0f + __expf(-fabsf(z)));
        lb[r] = fminf(z, 0.f) - lp; l1[r] = key < qpos ? lb[r] - z : 0.f; }
    float T[4], Tp[4];
#pragma unroll
    for (int g = 0; g < 4; ++g) { T[g] = (l1[4 * g] + l1[4 * g + 1]) + (l1[4 * g + 2] + l1[4 * g + 3]); Tp[g] = __shfl_xor(T[g], 32); }
    float run = R;
#pragma unroll
    for (int g = 3; g >= 0; --g) {
        const float off = h ? run : run + Tp[g];
        const float sf2 = l1[4 * g + 3], sf1 = sf2 + l1[4 * g + 2], sf0 = sf1 + l1[4 * g + 1];
        const float e3 = lb[4 * g + 3] + off, e2 = lb[4 * g + 2] + off + sf2, e1 = lb[4 * g + 1] + off + sf1, e0 = lb[4 * g] + off + sf0;
        const int key = keybase + 8 * g + 4 * h;
        s[4 * g + 3] = key + 3 < qpos ? __builtin_amdgcn_exp2f(e3 * LOG2E) : 0.f; s[4 * g + 2] = key + 2 < qpos ? __builtin_amdgcn_exp2f(e2 * LOG2E) : 0.f;
        s[4 * g + 1] = key + 1 < qpos ? __builtin_amdgcn_exp2f(e1 * LOG2E) : 0.f; s[4 * g] = key < qpos ? __builtin_amdgcn_exp2f(e0 * LOG2E) : 0.f;
        run += T[g] + Tp[g];
    }
    R = run;
}
__device__ __forceinline__ void sb_unit(const AttnIO& io, LAS unsigned char* lds, int b, int hd, int qb, int wave, int lane) {
    const int tid = threadIdx.x, h = lane >> 5, l31 = lane & 31;
    const size_t rowbase = (size_t)b * SEQ; const int qpos = 256 * qb + 32 * wave + l31;
    bf16x8 qf[8];
#pragma unroll
    for (int s = 0; s < 8; ++s) qf[s] = *(const bf16x8*)(io.Q + (rowbase + qpos) * (size_t)io.ld + hd * 128 + 16 * s + 8 * h);
    f32x16 o[4];
#pragma unroll
    for (int dt = 0; dt < 4; ++dt) for (int i = 0; i < 16; ++i) o[dt][i] = 0.f;
    float R = 0.f;
    const int ntiles = 4 * qb + 4;
    u32x4 kr[2], vr[2];
    attn_stage_load(io, rowbase, hd, 64 * (ntiles - 1), kr, vr, tid);
    attn_stage_store(lds, 0, kr, vr, tid);
    __syncthreads();
    for (int jj = 0; jj < ntiles; ++jj) {
        const int j = ntiles - 1 - jj, buf = jj & 1; const bool more = jj + 1 < ntiles;
        if (more) attn_stage_load(io, rowbase, hd, 64 * (j - 1), kr, vr, tid);
        if (64 * j < 256 * qb + 32 * wave + 31) {
            f32x16 s0, s1; attn_qk(lds, buf, qf, s0, s1, lane);
            sb_subtile(s1, 64 * j + 32, qpos, h, R);
            sb_subtile(s0, 64 * j, qpos, h, R);
            attn_pv(lds, buf, s0, s1, o, lane);
        }
        if (more) attn_stage_store(lds, buf ^ 1, kr, vr, tid);
        __syncthreads();
    }
    attn_store_o(io, rowbase + qpos, hd, o, 1.0f, lane);
}

constexpr int RG_XPITCH = 528;
constexpr int RG_XC = 0, RG_GX = 128 * RG_XPITCH, RG_GA = RG_GX + 128 * 32 * 4, RG_HB = RG_GA + 128 * 32 * 4;
__device__ __forceinline__ float gelu_tanh(float x) { const float u = 0.7978845608028654f * (x + 0.044715f * x * x * x); const float e = __expf(2.0f * u); const float th = 1.0f - 2.0f / (e + 1.0f); return 0.5f * x * (1.0f + th); }
__device__ __forceinline__ void phase_rg(const Params& p, LAS unsigned char* lds, int wave, int lane) {
    const unsigned char* ws = p.ws;
    const bf16_t* PROJ = (const bf16_t*)(ws + WS_PROJ); const bf16_t* WRG = (const bf16_t*)(ws + WS_WRG); bf16_t* O = (bf16_t*)(p.ws + WS_O);
    const int tid = threadIdx.x, h = lane >> 5, l31 = lane & 31;
    LAS float* GX = (LAS float*)(lds + RG_GX); LAS float* GA = (LAS float*)(lds + RG_GA); LAS float* HB = (LAS float*)(lds + RG_HB);
    for (int unit = blockIdx.x; unit < NB * 8 * 8; unit += gridDim.x) {
        const int b = unit >> 6, g = (unit >> 3) & 7, js = unit & 7, cb = 256 * g, c0 = cb + 32 * js;
        const int gate = wave >> 2, ti = wave & 3;
        bf16x8 wf[16];
        { const bf16_t* wp = WRG + ((size_t)(gate * 8 + g) * 256 + 32 * js + l31) * 256 + 8 * h;
#pragma unroll
          for (int s = 0; s < 16; ++s) wf[s] = *(const bf16x8*)(wp + 16 * s); }
        const float gbias = (gate ? p.rg_b_a : p.rg_b_x)[c0 + l31];
        const int ci = tid & 255, th = tid >> 8;
        const float cw0 = p.rg_conv_w[0 * 2048 + cb + ci], cw1 = p.rg_conv_w[1 * 2048 + cb + ci], cw2 = p.rg_conv_w[2 * 2048 + cb + ci], cw3 = p.rg_conv_w[3 * 2048 + cb + ci], cbias = p.rg_conv_b[cb + ci];
        const float lam = p.rg_lambda[c0 + l31]; const float spl = fmaxf(-lam, 0.f) + log1pf(expf(-fabsf(lam)));
        float hstate = 0.f;
        for (int tt = 0; tt < SEQ / 128; ++tt) {
            const int T0 = 128 * tt; const size_t R0 = (size_t)b * SEQ + T0;
            { const int t0 = 64 * th; const bf16_t* rx = PROJ + (R0 + t0) * CD_IN + PJ_RX + cb + ci;
              float x0 = 0.f, x1 = 0.f, x2 = 0.f;
              if (T0 + t0 >= 3) { x0 = bf2f(rx[-3 * (ptrdiff_t)CD_IN]); x1 = bf2f(rx[-2 * (ptrdiff_t)CD_IN]); x2 = bf2f(rx[-1 * (ptrdiff_t)CD_IN]); }
#pragma unroll 8
              for (int t = 0; t < 64; ++t) { const float x3 = bf2f(rx[(size_t)t * CD_IN]); const float xc = cbias + cw0 * x0 + cw1 * x1 + cw2 * x2 + cw3 * x3;
                  *(LAS bf16_t*)(lds + RG_XC + (t0 + t) * RG_XPITCH + 2 * ci) = f2bf(xc); x0 = x1; x1 = x2; x2 = x3; } }
            __syncthreads();
            { f32x16 acc; for (int i = 0; i < 16; ++i) acc[i] = 0.f;
              const LAS unsigned char* ap = lds + RG_XC + (32 * ti + l31) * RG_XPITCH + 16 * h;
#pragma unroll
              for (int s = 0; s < 16; ++s) { const bf16x8 a = *(const LAS bf16x8*)(ap + 32 * s); acc = MFMA32(a, wf[s], acc); }
              LAS float* gout = gate ? GA : GX;
#pragma unroll
              for (int r = 0; r < 16; ++r) { const float v = acc[r] + gbias; gout[(32 * ti + crow(r, h)) * 32 + l31] = 1.0f / (1.0f + __expf(-v)); } }
            __syncthreads();
            { const int jj = tid & 31, tq = tid >> 5;
              const float lamj = p.rg_lambda[c0 + jj]; const float splj = fmaxf(-lamj, 0.f) + log1pf(expf(-fabsf(lamj)));
#pragma unroll
              for (int i = 0; i < 8; ++i) { const int t = tq * 8 + i; const float ga = GA[t * 32 + jj], gx = GX[t * 32 + jj];
                  const float la = -8.0f * ga * splj; const float a = expf(la); const float mult = sqrtf(-expm1f(2.0f * la));
                  const float xc = bf2f(*(const LAS bf16_t*)(lds + RG_XC + t * RG_XPITCH + 2 * (32 * js + jj)));
                  GA[t * 32 + jj] = a; GX[t * 32 + jj] = mult * gx * xc; } }
            __syncthreads();
            if (wave == 0 && lane < 32) {
#pragma unroll 8
                for (int t = 0; t < 128; ++t) { hstate = GA[t * 32 + lane] * hstate + GX[t * 32 + lane]; HB[t * 32 + lane] = hstate; } }
            __syncthreads();
            { const int jj = tid & 31, tq = tid >> 5;
#pragma unroll
              for (int i = 0; i < 8; ++i) { const int t = tq * 8 + i; const float ry = bf2f(PROJ[(R0 + t) * CD_IN + PJ_RY + c0 + jj]);
                  O[(R0 + t) * DM + c0 + jj] = f2bf(HB[t * 32 + jj] * gelu_tanh(ry)); } }
        }
        (void)spl; (void)lam;
        __syncthreads();
    }
}

#ifndef MK_N_LAUNCHES
#define MK_N_LAUNCHES 1
#endif
constexpr int N_PHASES = 19;
struct Args { Params p; int li, pad; };

__device__ __forceinline__ void attn_phase_fox(const Params& p, LAS unsigned char* lds, int wave, int lane) {
    const bf16_t* PROJ = (const bf16_t*)(p.ws + WS_PROJ);
    const AttnIO io{PROJ + PJ_FQ, PROJ + PJ_FK, PROJ + PJ_FV, AB_MAIN, (bf16_t*)(p.ws + WS_O) + 2048, DM};
    const float* CF = (const float*)(p.ws + WS_CF);
    for (int pr = blockIdx.x; pr < 256; pr += gridDim.x) { const int b = pr >> 6, hd = (pr >> 2) & 15, x = pr & 3;
        fox_unit(io, CF, lds, b, hd, 7 - x, wave, lane);
        fox_unit(io, CF, lds, b, hd, x, wave, lane); }
}
__device__ __forceinline__ void attn_phase_sb(const Params& p, LAS unsigned char* lds, int wave, int lane) {
    const bf16_t* PROJ = (const bf16_t*)(p.ws + WS_PROJ);
    const AttnIO io{PROJ + PJ_SQ, PROJ + PJ_SK, PROJ + PJ_SV, CD_IN, (bf16_t*)(p.ws + WS_O) + 2048, DM};
    for (int pr = blockIdx.x; pr < 256; pr += gridDim.x) { const int b = pr >> 6, hd = (pr >> 2) & 15, x = pr & 3;
        sb_unit(io, lds, b, hd, 7 - x, wave, lane);
        sb_unit(io, lds, b, hd, x, wave, lane); }
}

template <int layer>
__device__ __forceinline__ void layer_phases(const Params& p, LAS unsigned char* lds, const XcdBarrier& bar, int lo, int hi, int G, int gw, int ngw, int wave, int lane) {
    unsigned char* ws = p.ws;
    bf16_t* U = (bf16_t*)(ws + WS_U); bf16_t* PROJ = (bf16_t*)(ws + WS_PROJ); bf16_t* O = (bf16_t*)(ws + WS_O); float* H = (float*)(ws + WS_H); bf16_t* ACT = (bf16_t*)(ws + WS_ACT);
#define IN(k) (lo <= (k) && (k) < hi)
#define SEAM(k) do { if ((k) + 1 < hi) xcd_barrier(bar); } while (0)
        constexpr int kb = 1 + 9 * layer;
        if (IN(kb)) {
            if (layer == 0) {
                pg8::Gemm g{U, (const bf16_t*)(ws + WS_WAB_IN), MTOK, AB_MAIN, DM}; pg8::StaticOrder S; S.init(MTOK, AB_MAIN, G, (int)blockIdx.x);
                pg8::EpiBf16 E{PROJ, AB_MAIN};
                pg8::gemm_phase<pg8::EpiBf16, pg8::StaticOrder, true, true>(lds, g, S, E);
                __syncthreads();
                phase_small32(p, lds, wave, lane);
            } else {
                pg8::Gemm g{U, (const bf16_t*)(ws + WS_WCD_IN), MTOK, CD_IN, DM}; pg8::StaticOrder S; S.init(MTOK, CD_IN, G, (int)blockIdx.x);
                pg8::EpiBf16 E{PROJ, CD_IN};
                pg8::gemm_phase<pg8::EpiBf16, pg8::StaticOrder, true, true>(lds, g, S, E);
            }
            SEAM(kb);
        }
        if (layer == 0 && IN(kb + 1)) { phase_fox_cumsum(p, gw, ngw, lane); phase_gla_pre(p, lds, wave, lane); SEAM(kb + 1); }
        if (IN(kb + 2)) {
            if (layer == 0) { phase_gla_seq(p, lds, wave, lane); __syncthreads(); attn_phase_fox(p, lds, wave, lane); }
            else { phase_rg(p, lds, wave, lane); __syncthreads(); attn_phase_sb(p, lds, wave, lane); }
            SEAM(kb + 2);
        }
        if (layer == 0 && IN(kb + 3)) { phase_gla_post(p, gw, ngw, lane); SEAM(kb + 3); }
        if (IN(kb + 4)) {
            pg8::Gemm g{O, (const bf16_t*)(ws + (layer ? WS_WCD_OUT : WS_WAB_OUT)), MTOK, DM, DM}; pg8::StaticOrder S; S.init(MTOK, DM, G, (int)blockIdx.x);
            pg8::EpiRes E{layer ? (const float*)H : p.x, H, DM};
            pg8::gemm_phase<pg8::EpiRes, pg8::StaticOrder, true, true>(lds, g, S, E);
            SEAM(kb + 4);
        }
        if (IN(kb + 5)) { phase_rms_bf16(H, p.norm_ffn + layer * DM, U, gw, ngw, lane); SEAM(kb + 5); }
        if (IN(kb + 6)) {
            pg8::Gemm g{U, (const bf16_t*)(ws + (layer ? WS_WGU1 : WS_WGU0)), MTOK, 2 * DFF, DM}; pg8::StaticOrder S; S.init(MTOK, 2 * DFF, G, (int)blockIdx.x);
            pg8::EpiSwiGLU E{ACT, DFF};
            pg8::gemm_phase<pg8::EpiSwiGLU, pg8::StaticOrder, true, true>(lds, g, S, E);
            SEAM(kb + 6);
        }
        if (IN(kb + 7)) {
            pg8::Gemm g{ACT, (const bf16_t*)(ws + (layer ? WS_WDN1 : WS_WDN0)), MTOK, DM, DFF}; pg8::StaticOrder S; S.init(MTOK, DM, G, (int)blockIdx.x);
            pg8::EpiRes E{H, H, DM};
            pg8::gemm_phase<pg8::EpiRes, pg8::StaticOrder, true, true>(lds, g, S, E);
            SEAM(kb + 7);
        }
        if (IN(kb + 8)) {
            if (layer == 0) { phase_rms_bf16(H, p.norm_mix + DM, U, gw, ngw, lane); SEAM(kb + 8); }
            else { for (int m = gw; m < MTOK; m += ngw) rms_row_f32(H + (size_t)m * DM, p.final_norm, p.out + (size_t)m * DM, lane); }
        }
#undef IN
#undef SEAM
}

__global__ void __launch_bounds__(NTHR, 2) hybrid_fwd(Args args) {
    extern __shared__ __attribute__((aligned(16))) unsigned char lds_raw[];
    LAS unsigned char* lds = (LAS unsigned char*)lds_raw;
    const Params& p = args.p;
    const int tid = threadIdx.x, lane = tid & 63, wave = __builtin_amdgcn_readfirstlane(tid >> 6);
    const int G = gridDim.x, gw = blockIdx.x * NWAVES + wave, ngw = G * NWAVES;
    for (int u = tid; u < (LDS_BYTES - LDSCTL_OFF) / 4; u += NTHR) ((LAS unsigned*)(lds + LDSCTL_OFF))[u] = 0u;
    __syncthreads();
    unsigned* ctl = (unsigned*)(p.ws + WS_CTL);
    XcdBarrier bar = xcd_barrier_post(ctl + CW_BAR + args.li * XCD_BAR_WORDS, (volatile LAS unsigned*)(lds + MISC_OFF) + 8);
    const int lo = p.ph_lo, hi = p.ph_hi;
#define IN(k) (lo <= (k) && (k) < hi)
#define SEAM(k) do { if ((k) + 1 < hi) xcd_barrier(bar); } while (0)
    if (IN(0)) { phase_p0(p, lds, gw, ngw, wave, lane); __syncthreads(); SEAM(0); }

    layer_phases<0>(p, lds, bar, lo, hi, G, gw, ngw, wave, lane);
    layer_phases<1>(p, lds, bar, lo, hi, G, gw, ngw, wave, lane);
#undef IN
#undef SEAM
}

extern "C" void kernel_launch(void* const* d_in, const int* in_sizes, int n_in, void* d_out, int out_size, void* d_ws, size_t ws_size, hipStream_t stream) {
    static int grid = 0;
    if (grid == 0) {
        if (n_in != 22 || in_sizes[0] != MTOK * DM || out_size != MTOK * DM || ws_size < WS_END) {
            fprintf(stderr, "kernel_launch: unexpected problem (n_in %d, in0 %d, out %d, ws %zu, need %zu); nothing launched\n", n_in, n_in > 0 ? in_sizes[0] : -1, out_size, ws_size, (size_t)WS_END); grid = -1; return; }
        int dev = 0, cus = 0, per_cu = 0;
        if (hipGetDevice(&dev) != hipSuccess || hipDeviceGetAttribute(&cus, hipDeviceAttributeMultiprocessorCount, dev) != hipSuccess) { fprintf(stderr, "kernel_launch: device query failed\n"); grid = -1; return; }
        if (hipFuncSetAttribute((const void*)hybrid_fwd, hipFuncAttributeMaxDynamicSharedMemorySize, LDS_BYTES) != hipSuccess) { fprintf(stderr, "kernel_launch: hipFuncSetAttribute failed\n"); grid = -1; return; }
        if (hipOccupancyMaxActiveBlocksPerMultiprocessor(&per_cu, (const void*)hybrid_fwd, NTHR, LDS_BYTES) != hipSuccess || per_cu < 1) {
            fprintf(stderr, "kernel_launch: occupancy query reports %d workgroups per CU; nothing launched\n", per_cu); (void)hipGetLastError(); grid = -1; return; }
        grid = cus;
    }
    if (grid < 0) return;
    if (hipMemsetAsync((char*)d_ws + WS_CTL, 0, CTL_ZERO_BYTES, stream) != hipSuccess) { fprintf(stderr, "kernel_launch: memset failed\n"); return; }
    Args a{};
    const float** pp = (const float**)&a.p;
    for (int i = 0; i < 22; ++i) pp[i] = (const float*)d_in[i];
    a.p.out = (float*)d_out; a.p.ws = (unsigned char*)d_ws;
#if MK_N_LAUNCHES == 1
    a.p.ph_lo = 0; a.p.ph_hi = N_PHASES; a.li = 0; a.pad = 0;
    hipLaunchKernelGGL(hybrid_fwd, dim3(grid), dim3(NTHR), LDS_BYTES, stream, a);
    { const hipError_t le = hipPeekAtLastError(); if (le != hipSuccess) fprintf(stderr, "kernel_launch: launch failed: %s\n", hipGetErrorName(le)); }
#else
    for (int k = 0; k < N_PHASES; ++k) { a.p.ph_lo = k; a.p.ph_hi = k + 1; a.li = k; a.pad = 0;
        hipLaunchKernelGGL(hybrid_fwd, dim3(grid), dim3(NTHR), LDS_BYTES, stream, a);
        const hipError_t le = hipPeekAtLastError(); if (le != hipSuccess) { fprintf(stderr, "kernel_launch: launch %d failed: %s\n", k, hipGetErrorName(le)); break; } }
#endif
}
```

```cpp
#include <hip/hip_runtime.h>
#include <cstdio>
#include <cstdint>

#define LAS __attribute__((address_space(3)))
#define GAS __attribute__((address_space(1)))
typedef unsigned short bf16_t;
typedef short bf16x8 __attribute__((ext_vector_type(8)));
typedef short s16x4 __attribute__((ext_vector_type(4)));
typedef float f32x4 __attribute__((ext_vector_type(4)));
typedef float f32x2 __attribute__((ext_vector_type(2)));
typedef float f32x16 __attribute__((ext_vector_type(16)));
typedef unsigned u32x4 __attribute__((ext_vector_type(4)));
typedef unsigned u32x2 __attribute__((ext_vector_type(2)));

constexpr int DM = 4096, NB = 4, SEQ = 2048, MTOK = NB * SEQ;
constexpr int DFF = 11008;
constexpr int AB_MAIN = 12288;
constexpr int AB_IN = 12320, CD_IN = 10240;
constexpr int PJ_GQ = 0, PJ_GK = 1024, PJ_GV = 2048, PJ_GG = 4096, PJ_FQ = 6144, PJ_FK = 8192, PJ_FV = 10240;
constexpr int PJ_RY = 0, PJ_RX = 2048, PJ_SQ = 4096, PJ_SK = 6144, PJ_SV = 8192;
constexpr float EPS = 1e-6f;

__device__ __forceinline__ unsigned cvt_pk_bf16(float lo, float hi) { unsigned r; asm volatile("v_cvt_pk_bf16_f32 %0, %1, %2" : "=v"(r) : "v"(lo), "v"(hi)); return r; }
__device__ __forceinline__ float bf2f(bf16_t v) { return __uint_as_float(((unsigned)v) << 16); }
__device__ __forceinline__ float bflo(unsigned w) { return __uint_as_float(w << 16); }
__device__ __forceinline__ float bfhi(unsigned w) { return __uint_as_float(w & 0xffff0000u); }
__device__ __forceinline__ bf16_t f2bf(float f) { return (bf16_t)(cvt_pk_bf16(f, 0.f) & 0xffffu); }
__device__ __forceinline__ int crow(int r, int hi) { return (r & 3) + 8 * (r >> 2) + 4 * hi; }
__device__ __forceinline__ bf16x8 pack8(float a0, float a1, float a2, float a3, float a4, float a5, float a6, float a7) {
    u32x4 w = {cvt_pk_bf16(a0, a1), cvt_pk_bf16(a2, a3), cvt_pk_bf16(a4, a5), cvt_pk_bf16(a6, a7)}; return __builtin_bit_cast(bf16x8, w); }
__device__ __forceinline__ float wave_sum(float v) {
#pragma unroll
    for (int o = 1; o < 64; o <<= 1) v += __shfl_xor(v, o);
    return v; }
__device__ __forceinline__ float log_sigmoid_acc(float x) { return fminf(x, 0.f) - log1pf(expf(-fabsf(x))); }
#define LDS_WAIT() asm volatile("s_waitcnt lgkmcnt(0)" ::: "memory")
#define VM_WAIT() asm volatile("s_waitcnt vmcnt(0)" ::: "memory")
#define MFMA32(a, b, c) __builtin_amdgcn_mfma_f32_32x32x16_bf16((a), (b), (c), 0, 0, 0)
typedef LAS const char* lds_cptr;
__device__ __forceinline__ s16x4 vtr(lds_cptr p) { return __builtin_bit_cast(s16x4, __builtin_amdgcn_ds_read_tr16_b64_v4i16((LAS s16x4*)p)); }
__device__ __forceinline__ bf16x8 cat4(s16x4 lo, s16x4 hi) { bf16x8 r; r[0] = lo[0]; r[1] = lo[1]; r[2] = lo[2]; r[3] = lo[3]; r[4] = hi[0]; r[5] = hi[1]; r[6] = hi[2]; r[7] = hi[3]; return r; }

namespace pg8 {
#define PG8_LAS __attribute__((address_space(3)))
typedef unsigned short bf16_t;
typedef short bf16x8 __attribute__((ext_vector_type(8)));
typedef float f32x4 __attribute__((ext_vector_type(4)));
typedef unsigned u32x4 __attribute__((ext_vector_type(4)));
constexpr int BM = 256, BK = 64, HALF = 128, HTB = HALF * BK * 2  , STAGE_BYTES = 8 * HTB, NXCD = 8, WGM = 8;

__host__ __device__ __forceinline__ int lds_byte(int r, int c) { const int st = (r >> 4) * 2 + (c >> 5), rr = r & 15, cc = c & 31, ob = rr * 64 + cc * 2; return st * 1024 + (ob ^ (((ob >> 9) & 1) << 5)); }
__host__ __device__ __forceinline__ void stage_rc(int b, int& R, int& C) { const int st = b / 1024, sb = b % 1024, swz = sb ^ (((sb >> 9) & 1) << 5); R = (st >> 1) * 16 + swz / 64; C = (st & 1) * 32 + (swz % 64) / 2; }
__host__ __device__ __forceinline__ int perm32(int rho) { const int n = rho >> 4, i = rho & 15; return 8 * (i >> 2) + 4 * n + (i & 3); }

struct Unit { int pm, pn; };
struct Gemm { const bf16_t* A; const bf16_t* Bt; int M, N, K; };

struct StaticOrder {
    int nM, nN, nwg, G, c;
    __host__ __device__ void init(int M, int N, int G_, int c_) { nM = M / BM; nN = N / BM; nwg = nM * nN; G = G_; c = c_; }
    __host__ __device__ bool next(int i, Unit& u) const {
        const long L = (long)i * G + c; if (L >= nwg) return false;
        int wgid = (int)L; { const int q = nwg / NXCD, r = nwg % NXCD, xcd = wgid % NXCD, off = wgid / NXCD; wgid = (xcd < r ? xcd * (q + 1) : r * (q + 1) + (xcd - r) * q) + off; }
        const int nig = WGM * nN, gid = wgid / nig, fm = gid * WGM, gsz = (nM - fm) < WGM ? (nM - fm) : WGM;
        u.pm = fm + ((wgid % nig) % gsz); u.pn = (wgid % nig) / gsz; return true;
    }
    __device__ __forceinline__ void a_ready(const Unit&) const {}
    __device__ __forceinline__ void done(const Unit&) const {}
};
__device__ __forceinline__ unsigned cvt_pk_bf16(float lo, float hi) { unsigned r; asm volatile("v_cvt_pk_bf16_f32 %0, %1, %2" : "=v"(r) : "v"(lo), "v"(hi)); return r; }
constexpr float RMS_EPS = 1e-6f, RMS_INV_D = 1.0f / 4096.0f;

template <bool SCALE> struct EpiBf16 {
    static constexpr bool PERM = true, AFTER_DRAIN = false;
    bf16_t* O; int ldc; const float* ssq;
    __device__ __forceinline__ void operator()(const f32x4 (&acc)[2][2][4][2], const Unit& u, int wr, int wc, int fr, int fq) const {
        const int row0 = u.pm * BM + wr * 64 + fr, col0 = u.pn * BM + wc * 32 + 8 * fq;
#pragma unroll
        for (int ai = 0; ai < 2; ++ai)
#pragma unroll
            for (int m = 0; m < 4; ++m) { const int row = row0 + ai * HALF + m * 16; bf16_t* rowp = O + (size_t)row * ldc + col0;
                float rs = 1.0f; if (SCALE) rs = __builtin_amdgcn_rsqf(ssq[row] * RMS_INV_D + RMS_EPS);
#pragma unroll
                for (int bj = 0; bj < 2; ++bj) { const f32x4 v0 = acc[ai][bj][m][0] * rs, v1 = acc[ai][bj][m][1] * rs;
                    u32x4 w; w.x = cvt_pk_bf16(v0[0], v0[1]); w.y = cvt_pk_bf16(v0[2], v0[3]); w.z = cvt_pk_bf16(v1[0], v1[1]); w.w = cvt_pk_bf16(v1[2], v1[3]);
                    *(u32x4*)(rowp + bj * HALF) = w; } }
    }
};
struct EpiRes {
    static constexpr bool PERM = false, AFTER_DRAIN = false;
    const float* base; float* out; int ldc; bf16_t* hb; float* ssq;
    __device__ __forceinline__ void operator()(const f32x4 (&acc)[2][2][4][2], const Unit& u, int wr, int wc, int fr, int fq) const {
        const int row0 = u.pm * BM + wr * 64 + fr, col0 = u.pn * BM + wc * 32 + 4 * fq;
#pragma unroll
        for (int ai = 0; ai < 2; ++ai)
#pragma unroll
            for (int m = 0; m < 4; ++m) { const int row = row0 + ai * HALF + m * 16; const size_t off = (size_t)row * ldc + col0; float q = 0.f;
#pragma unroll
                for (int bj = 0; bj < 2; ++bj)
#pragma unroll
                    for (int n = 0; n < 2; ++n) { const f32x4 bs = *(const f32x4*)(base + off + bj * HALF + n * 16); const f32x4 v = bs + acc[ai][bj][m][n]; *(f32x4*)(out + off + bj * HALF + n * 16) = v;
                        q += (v[0] * v[0] + v[1] * v[1]) + (v[2] * v[2] + v[3] * v[3]);
                        if (hb) { u32x2 w; w.x = cvt_pk_bf16(v[0], v[1]); w.y = cvt_pk_bf16(v[2], v[3]); *(u32x2*)(hb + off + bj * HALF + n * 16) = w; } }
                q += __shfl_xor(q, 16); q += __shfl_xor(q, 32);
                if (fq == 0) atomicAdd(ssq + row, q);
                asm volatile("" ::: "memory"); }
    }
};
struct EpiSwiGLU {
    static constexpr bool PERM = true, AFTER_DRAIN = false;
    bf16_t* O; int ldc; const float* ssq;
    __device__ __forceinline__ void operator()(const f32x4 (&acc)[2][2][4][2], const Unit& u, int wr, int wc, int fr, int fq) const {
        const int row0 = u.pm * BM + wr * 64 + fr, col0 = u.pn * HALF + wc * 32 + 8 * fq;
#pragma unroll
        for (int ai = 0; ai < 2; ++ai)
#pragma unroll
            for (int m = 0; m < 4; ++m) { const int row = row0 + ai * HALF + m * 16; bf16_t* rowp = O + (size_t)row * ldc + col0; float a[8];
                const float rs = __builtin_amdgcn_rsqf(ssq[row] * RMS_INV_D + RMS_EPS);
#pragma unroll
                for (int n = 0; n < 2; ++n)
#pragma unroll
                    for (int i = 0; i < 4; ++i) { const float g = acc[ai][0][m][n][i] * rs, up = acc[ai][1][m][n][i] * rs; a[4 * n + i] = g * up * __builtin_amdgcn_rcpf(1.0f + __expf(-g)); }
                u32x4 w; w.x = cvt_pk_bf16(a[0], a[1]); w.y = cvt_pk_bf16(a[2], a[3]); w.z = cvt_pk_bf16(a[4], a[5]); w.w = cvt_pk_bf16(a[6], a[7]);
                *(u32x4*)rowp = w; }
    }
};

template <class Epi, class Sched, bool ALIGN_EPI = false, bool SP2 = false>
__device__ __forceinline__ void gemm_phase(PG8_LAS unsigned char* lds, const Gemm g, const Sched& S, const Epi& E) {
    const int tid = threadIdx.x, wid = __builtin_amdgcn_readfirstlane(tid >> 6), lane = tid & 63, wr = wid >> 2, wc = wid & 3, fr = lane & 15, fq = lane >> 4;
    const int K = g.K, nt = K / BK;
    unsigned voffA[2], voffB[2];
#pragma unroll
    for (int i = 0; i < 2; ++i) { int R, C; stage_rc(tid * 16 + i * 8192, R, C); const int Rb = Epi::PERM ? ((R & ~31) + perm32(R & 31)) : R;
        voffA[i] = (unsigned)(R * K + C) * 2u; voffB[i] = (unsigned)(Rb * K + C) * 2u; }
    const size_t kstep = (size_t)(BK * 2);
    const size_t hstep = (size_t)HALF * K * 2;
    const size_t tstep = 2 * hstep;
    const unsigned ldsw = (unsigned)wid * 1024u;
    const int aoff = lds_byte(wr * 64 + fr, fq * 8), boff = lds_byte(wc * 32 + fr, fq * 8);
#define PG8_SA(b, h) (((b) * 2 + (h)) * HTB)
#define PG8_SB(b, h) ((4 + (b) * 2 + (h)) * HTB)
#define PG8_STAGE(bufoff, gbase, voff) do { _Pragma("unroll") for (int _i = 0; _i < 2; ++_i) \
        __builtin_amdgcn_global_load_lds((const unsigned*)((const char*)(gbase) + (voff)[_i]), (PG8_LAS unsigned*)(lds + (bufoff) + ldsw + _i * 8192), 16, 0, 0); } while (0)
#define PG8_LDA(dst, b, h) do { _Pragma("unroll") for (int m = 0; m < 4; ++m) _Pragma("unroll") for (int k = 0; k < 2; ++k) dst[m][k] = *(const PG8_LAS bf16x8*)(lds + PG8_SA(b, h) + aoff + m * 2048 + k * 1024); } while (0)
#define PG8_LDB(dst, b, h) do { _Pragma("unroll") for (int n = 0; n < 2; ++n) _Pragma("unroll") for (int k = 0; k < 2; ++k) dst[n][k] = *(const PG8_LAS bf16x8*)(lds + PG8_SB(b, h) + boff + n * 2048 + k * 1024); } while (0)
#define PG8_MMA(ai, bj, At, Bt) do { __builtin_amdgcn_s_setprio(1); _Pragma("unroll") for (int m = 0; m < 4; ++m) _Pragma("unroll") for (int n = 0; n < 2; ++n) _Pragma("unroll") for (int k = 0; k < 2; ++k) \
        acc[ai][bj][m][n] = __builtin_amdgcn_mfma_f32_16x16x32_bf16(Bt[n][k], At[m][k], acc[ai][bj][m][n], 0, 0, 0); __builtin_amdgcn_s_setprio(0); } while (0)
#define PG8_WAIT_V(n) asm volatile("s_waitcnt vmcnt(" #n ")" ::: "memory")
#define PG8_WAIT_L(n) asm volatile("s_waitcnt lgkmcnt(" #n ")" ::: "memory")
#define PG8_BAR __builtin_amdgcn_s_barrier()
#define PG8_SCHED __builtin_amdgcn_sched_barrier(0)
    Unit cur, nxt; int ui = 0;
    if (!S.next(0, cur)) return;
    f32x4 acc[2][2][4][2];
#pragma unroll
    for (int a = 0; a < 2; ++a)
#pragma unroll
        for (int b = 0; b < 2; ++b)
#pragma unroll
            for (int m = 0; m < 4; ++m)
#pragma unroll
                for (int n = 0; n < 2; ++n) acc[a][b][m][n] = (f32x4){0.f, 0.f, 0.f, 0.f};
    bf16x8 At[4][2], B0[2][2], B1[2][2];
    const char* cA = (const char*)g.A + (size_t)cur.pm * tstep; const char* cB = (const char*)g.Bt + (size_t)cur.pn * tstep;
    S.a_ready(cur);
    if constexpr (SP2) {
        PG8_STAGE(PG8_SB(0, 0), cB, voffB); PG8_STAGE(PG8_SB(0, 1), cB + hstep, voffB); PG8_STAGE(PG8_SA(0, 0), cA, voffA); PG8_STAGE(PG8_SA(0, 1), cA + hstep, voffA);
        if (wr == 1) PG8_BAR;
        PG8_WAIT_V(2); PG8_BAR;
        PG8_STAGE(PG8_SB(1, 0), cB + kstep, voffB); PG8_STAGE(PG8_SA(1, 0), cA + kstep, voffA); PG8_STAGE(PG8_SB(1, 1), cB + hstep + kstep, voffB);
        PG8_WAIT_V(6); PG8_BAR;
    } else {
        PG8_STAGE(PG8_SB(0, 0), cB, voffB); PG8_STAGE(PG8_SA(0, 0), cA, voffA); PG8_STAGE(PG8_SB(0, 1), cB + hstep, voffB); PG8_STAGE(PG8_SA(0, 1), cA + hstep, voffA);
        if (wr == 1) PG8_BAR;
        PG8_WAIT_V(4); PG8_BAR;
        PG8_STAGE(PG8_SB(1, 0), cB + kstep, voffB); PG8_STAGE(PG8_SA(1, 0), cA + kstep, voffA); PG8_STAGE(PG8_SB(1, 1), cB + hstep + kstep, voffB);
        PG8_WAIT_V(6); PG8_BAR;
    }
    for (;;) {
        const bool has_next = S.next(ui + 1, nxt);
        const char* nA = has_next ? (const char*)g.A + (size_t)nxt.pm * tstep : cA; const char* nB = has_next ? (const char*)g.Bt + (size_t)nxt.pn * tstep : cB;
        for (int t = 0; t < nt; t += 2) {
            const bool last = (t == nt - 2);
            const char* a1 = cA + (size_t)(t + 1) * kstep;
            const char* a2 = last ? nA : cA + (size_t)(t + 2) * kstep; const char* b2 = last ? nB : cB + (size_t)(t + 2) * kstep;
            const char* a3 = a2 + kstep; const char* b3 = b2 + kstep;
            if (last && has_next) S.a_ready(nxt);
            if constexpr (SP2) {
            PG8_LDB(B0, 0, 0); PG8_LDB(B1, 0, 1); PG8_SCHED; PG8_LDA(At, 0, 0); PG8_STAGE(PG8_SA(1, 1), a1 + hstep, voffA);
            PG8_WAIT_V(8); PG8_WAIT_L(0); PG8_BAR; PG8_MMA(0, 0, At, B0); PG8_MMA(0, 1, At, B1); PG8_BAR; PG8_SCHED;
            PG8_LDA(At, 0, 1); PG8_STAGE(PG8_SB(0, 0), b2, voffB); PG8_STAGE(PG8_SB(0, 1), b2 + hstep, voffB); PG8_STAGE(PG8_SA(0, 0), a2, voffA);
            PG8_WAIT_V(8); PG8_WAIT_L(0); PG8_BAR; PG8_MMA(1, 0, At, B0); PG8_MMA(1, 1, At, B1); PG8_BAR; PG8_SCHED;
            PG8_LDB(B0, 1, 0); PG8_LDB(B1, 1, 1); PG8_SCHED; PG8_LDA(At, 1, 0); PG8_STAGE(PG8_SA(0, 1), a2 + hstep, voffA);
            PG8_WAIT_V(8); PG8_WAIT_L(0); PG8_BAR; PG8_MMA(0, 0, At, B0); PG8_MMA(0, 1, At, B1); PG8_BAR; PG8_SCHED;
            PG8_LDA(At, 1, 1); PG8_STAGE(PG8_SB(1, 0), b3, voffB); PG8_STAGE(PG8_SB(1, 1), b3 + hstep, voffB); PG8_STAGE(PG8_SA(1, 0), a3, voffA);
            PG8_WAIT_V(8); PG8_WAIT_L(0); PG8_BAR; PG8_MMA(1, 0, At, B0); PG8_MMA(1, 1, At, B1); PG8_BAR; PG8_SCHED;
            } else {
            PG8_LDB(B0, 0, 0); PG8_SCHED; PG8_LDA(At, 0, 0); PG8_STAGE(PG8_SA(1, 1), a1 + hstep, voffA);
            PG8_WAIT_L(8); PG8_BAR; PG8_WAIT_L(0); PG8_MMA(0, 0, At, B0); PG8_BAR; PG8_SCHED;
            PG8_LDB(B1, 0, 1); PG8_STAGE(PG8_SB(0, 0), b2, voffB);
            PG8_BAR; PG8_WAIT_L(0); PG8_MMA(0, 1, At, B1); PG8_BAR;
            PG8_LDA(At, 0, 1); PG8_STAGE(PG8_SA(0, 0), a2, voffA);
            PG8_BAR; PG8_WAIT_L(0); PG8_MMA(1, 0, At, B0); PG8_BAR; PG8_SCHED;
            PG8_STAGE(PG8_SB(0, 1), b2 + hstep, voffB);
            PG8_WAIT_V(6); PG8_BAR; PG8_MMA(1, 1, At, B1); PG8_BAR;
            PG8_LDB(B0, 1, 0); PG8_SCHED; PG8_LDA(At, 1, 0); PG8_STAGE(PG8_SA(0, 1), a2 + hstep, voffA);
            PG8_WAIT_L(8); PG8_BAR; PG8_WAIT_L(0); PG8_MMA(0, 0, At, B0); PG8_BAR; PG8_SCHED;
            PG8_LDB(B1, 1, 1); PG8_STAGE(PG8_SB(1, 0), b3, voffB);
            PG8_BAR; PG8_WAIT_L(0); PG8_MMA(0, 1, At, B1); PG8_BAR;
            PG8_LDA(At, 1, 1); PG8_STAGE(PG8_SA(1, 0), a3, voffA);
            PG8_BAR; PG8_WAIT_L(0); PG8_MMA(1, 0, At, B0); PG8_BAR; PG8_SCHED;
            PG8_STAGE(PG8_SB(1, 1), b3 + hstep, voffB);
            PG8_WAIT_V(6); PG8_BAR; PG8_MMA(1, 1, At, B1); PG8_BAR;
            }
        }
        if constexpr (ALIGN_EPI) { if (wr == 0) PG8_BAR; }
        if constexpr (!Epi::AFTER_DRAIN) { E(acc, cur, wr, wc, fr, fq); S.done(cur); }
        if (!has_next) break;
#pragma unroll
        for (int a = 0; a < 2; ++a)
#pragma unroll
            for (int b = 0; b < 2; ++b)
#pragma unroll
                for (int m = 0; m < 4; ++m)
#pragma unroll
                    for (int n = 0; n < 2; ++n) acc[a][b][m][n] = (f32x4){0.f, 0.f, 0.f, 0.f};
        cur = nxt; cA = nA; cB = nB; ++ui;
        if constexpr (ALIGN_EPI) { if (wr == 1) PG8_BAR; }
    }
    PG8_WAIT_V(0);
    if constexpr (!ALIGN_EPI) { if (wr == 0) PG8_BAR; }
    PG8_BAR;
    if constexpr (Epi::AFTER_DRAIN) { E.fused(acc, cur, wr, wc, fr, fq, lds, wid, lane); S.done(cur); }
#undef PG8_SA
#undef PG8_SB
#undef PG8_STAGE
#undef PG8_LDA
#undef PG8_LDB
#undef PG8_MMA
#undef PG8_WAIT_V
#undef PG8_WAIT_L
#undef PG8_BAR
#undef PG8_SCHED
}
}
#define XB_TMO      128
#define XB_XCNT(j)  (256  + 64 * (j))
#define XB_XSUB(j)  (1280 + 64 * (j))
#define XB_XGEN(j)  (2304 + 64 * (j))
#define XB_TOP      3328
#define XB_TOPGEN   3392
#define XCD_BAR_WORDS 3456
#define XB_SPIN_CAP (1u << 18)

__device__ __forceinline__ unsigned xb_ld(unsigned* p)              { return __hip_atomic_load(p, __ATOMIC_RELAXED, __HIP_MEMORY_SCOPE_AGENT); }
__device__ __forceinline__ unsigned xb_add(unsigned* p, unsigned v) { return __hip_atomic_fetch_add(p, v, __ATOMIC_RELAXED, __HIP_MEMORY_SCOPE_AGENT); }
__device__ __forceinline__ unsigned xb_xcc_id() { return (unsigned)__builtin_amdgcn_s_getreg((3 << 11) | 20) & 0xFu; }
#define XB_SPIN(cond, bar) do { unsigned _sp = 0; while (cond) { __builtin_amdgcn_s_sleep(1); \
    if ((++_sp & 255u) == 0u) { if (xb_ld(&(bar)[XB_TMO])) break; if (_sp > XB_SPIN_CAP) { atomicAdd(&(bar)[XB_TMO], 1u); break; } } } } while (0)

struct XcdBarrier {
    unsigned* bar; unsigned x;
    volatile LAS unsigned* st;
};

__device__ __forceinline__ XcdBarrier xcd_barrier_post(unsigned* bar, volatile LAS unsigned* st) {
    XcdBarrier b; b.bar = bar; b.x = xb_xcc_id(); b.st = st;
    if (threadIdx.x == 0) (void)xb_add(&bar[XB_XCNT(b.x)], 1u);
    return b;
}
__device__ __forceinline__ void xcd_barrier_complete(unsigned* bar, unsigned x, unsigned& nloc, unsigned& nx) {
    const unsigned G = gridDim.x * gridDim.y * gridDim.z;
    unsigned sum, cnt, mine, sp = 0u;
    for (;;) {
        sum = 0u; cnt = 0u; mine = 0u;
#pragma unroll
        for (unsigned j = 0; j < 16; ++j) { const unsigned c = xb_ld(&bar[XB_XCNT(j)]); sum += c; cnt += (c > 0u) ? 1u : 0u; mine = (j == x) ? c : mine; }
        if (sum == G) break;
        __builtin_amdgcn_s_sleep(1);
        if ((++sp & 255u) == 0u) { if (xb_ld(&bar[XB_TMO])) break; if (sp > XB_SPIN_CAP) { atomicAdd(&bar[XB_TMO], 1u); break; } }
    }
    nloc = mine > 0u ? mine : 1u; nx = cnt > 0u ? cnt : 1u;
}

__device__ __forceinline__ void xcd_barrier(const XcdBarrier& b) {
    asm volatile("s_waitcnt vmcnt(0)" ::: "memory");
    __syncthreads();
    if (threadIdx.x == 0) {
        unsigned* bar = b.bar;
        __builtin_amdgcn_s_waitcnt(0);
        unsigned nloc = b.st[0], nx = b.st[1];
        if (nloc == 0u) { xcd_barrier_complete(bar, b.x, nloc, nx); b.st[0] = nloc; b.st[1] = nx; }
        const unsigned old = xb_add(&bar[XB_XSUB(b.x)], 1u);
        const unsigned gen = old / nloc;
        if (old + 1u == (gen + 1u) * nloc) {
            __builtin_amdgcn_fence(__ATOMIC_RELEASE, "agent");
            asm volatile("s_waitcnt vmcnt(0)" ::: "memory");
            const unsigned og = xb_add(&bar[XB_TOP], 1u);
            const unsigned tg = og / nx;
            if (og + 1u == (tg + 1u) * nx) xb_add(&bar[XB_TOPGEN], 1u);
            else XB_SPIN(xb_ld(&bar[XB_TOPGEN]) == tg, bar);
            __builtin_amdgcn_fence(__ATOMIC_ACQUIRE, "agent");
            xb_add(&bar[XB_XGEN(b.x)], 1u);
            asm volatile("s_waitcnt vmcnt(0)" ::: "memory");
        } else {
            XB_SPIN(xb_ld(&bar[XB_XGEN(b.x)]) == gen, bar);
            __builtin_amdgcn_fence(__ATOMIC_ACQUIRE, "agent");
            asm volatile("s_waitcnt vmcnt(0)" ::: "memory");
        }
    }
    __syncthreads();
}
constexpr size_t MiB = 1u << 20;
constexpr size_t WS_CTL = 0, CTL_ZERO_BYTES = 1 * MiB;
constexpr size_t WS_WAB_IN = 1 * MiB, WS_WAB_OUT = 97 * MiB, WS_WGU0 = 129 * MiB, WS_WDN0 = 301 * MiB, WS_WCD_IN = 387 * MiB, WS_WCD_OUT = 467 * MiB, WS_WGU1 = 499 * MiB, WS_WDN1 = 671 * MiB;
constexpr size_t WS_WSMALL = 757 * MiB, WS_WRG = 758 * MiB;
constexpr size_t WS_U = 760 * MiB, WS_PROJ = 824 * MiB, WS_O = 1016 * MiB, WS_H = 1080 * MiB;
constexpr size_t WS_ACT = WS_PROJ;
constexpr size_t WS_SMALL32 = 1208 * MiB, WS_CF = 1209 * MiB, WS_QT = 1210 * MiB, WS_KDT = 1226 * MiB, WS_PM = 1242 * MiB, WS_GDEC = 1246 * MiB, WS_ORAW = 1247 * MiB, WS_SSQ = 1311 * MiB;
constexpr size_t WS_END = 1313 * MiB;
constexpr int CW_BAR = 4096, CW_SSQ = 131072;

constexpr int RING_BYTES = 131072;
constexpr int LDSCTL_OFF = RING_BYTES, MISC_OFF = LDSCTL_OFF + 320;
constexpr int LDS_BYTES = 147456;
constexpr int NWAVES = 8, NTHR = 512;

struct Params {
    const float *x, *norm_mix, *norm_ffn, *ffn_w_gate, *ffn_w_up, *ffn_w_down, *ab_w_in, *gla_w_gate_up, *gla_b_gate, *gla_norm, *fox_b_f, *ab_w_out,
                *cd_w_in, *rg_conv_w, *rg_conv_b, *rg_w_x, *rg_b_x, *rg_w_a, *rg_b_a, *rg_lambda, *cd_w_out, *final_norm;
    float* out; unsigned char* ws; int ph_lo, ph_hi;
};

__device__ __forceinline__ void tr_item(const float* W, int ldn, int K, int n_src0, bf16_t* WT, int row_dst0, LAS float* scr, int kb, int lane, const float* gain = nullptr) {
    const int k0 = 64 * kb, c = lane & 7;
    f32x4 g0 = {1.f, 1.f, 1.f, 1.f}, g1 = {1.f, 1.f, 1.f, 1.f};
    if (gain) { g0 = *(const f32x4*)(gain + k0 + 8 * c); g1 = *(const f32x4*)(gain + k0 + 8 * c + 4); }
#pragma unroll 8
    for (int i = 0; i < 32; ++i) { const int kk = 2 * i + (lane >> 5); scr[kk * 33 + (lane & 31)] = W[(size_t)(k0 + kk) * ldn + n_src0 + (lane & 31)]; }
    LDS_WAIT(); asm volatile("" ::: "memory");
#pragma unroll
    for (int j = 0; j < 4; ++j) { const int n = (lane >> 3) + 8 * j; const LAS float* s = scr + (8 * c) * 33 + n;
        u32x4 o; o.x = cvt_pk_bf16(s[0 * 33] * g0.x, s[1 * 33] * g0.y); o.y = cvt_pk_bf16(s[2 * 33] * g0.z, s[3 * 33] * g0.w); o.z = cvt_pk_bf16(s[4 * 33] * g1.x, s[5 * 33] * g1.y); o.w = cvt_pk_bf16(s[6 * 33] * g1.z, s[7 * 33] * g1.w);
        *(u32x4*)(WT + (size_t)(row_dst0 + n) * K + k0 + 8 * c) = o; }
    LDS_WAIT(); asm volatile("" ::: "memory");
}
#define TR_JOB(W_, ldn_, K_, nsrc0_, ncols_, WT_, rdst0_, gain_) { constexpr int nnb_ = (ncols_) / 32, nit_ = ((K_) / 64) * nnb_; \
    if (r < nit_) { const int kb_ = r / nnb_, nb_ = r % nnb_; tr_item((W_), (ldn_), (K_), (nsrc0_) + 32 * nb_, (WT_), (rdst0_) + 32 * nb_, scr, kb_, lane, (gain_)); continue; } r -= nit_; }
#define TR_JOB_GU(W_, WT_, off_, gain_) { constexpr int nnb_ = DFF / 32, nit_ = (DM / 64) * nnb_; \
    if (r < nit_) { const int kb_ = r / nnb_, nb_ = r % nnb_, c0_ = 32 * nb_; tr_item((W_), DFF, DM, c0_, (WT_), 256 * (c0_ / 128) + (c0_ % 128) + (off_), scr, kb_, lane, (gain_)); continue; } r -= nit_; }

__device__ __forceinline__ void rms_row_bf16(const float* xrow, const float* g, bf16_t* orow, int lane) {
    const f32x4* xr = (const f32x4*)xrow + lane; const f32x4* gr = (const f32x4*)g + lane;
    f32x4 v[16]; float s = 0.f;
#pragma unroll
    for (int j = 0; j < 16; ++j) { v[j] = xr[64 * j]; s += (v[j].x * v[j].x + v[j].y * v[j].y) + (v[j].z * v[j].z + v[j].w * v[j].w); }
    const float rstd = 1.0f / sqrtf(wave_sum(s) * (1.0f / DM) + EPS);
    u32x2* o8 = (u32x2*)orow + lane;
#pragma unroll
    for (int j = 0; j < 16; ++j) { const f32x4 gg = gr[64 * j]; u32x2 w; w.x = cvt_pk_bf16(v[j].x * rstd * gg.x, v[j].y * rstd * gg.y); w.y = cvt_pk_bf16(v[j].z * rstd * gg.z, v[j].w * rstd * gg.w); o8[64 * j] = w; }
}
__device__ __forceinline__ void rms_row_f32(const float* xrow, const float* g, float* orow, int lane) {
    const f32x4* xr = (const f32x4*)xrow + lane; const f32x4* gr = (const f32x4*)g + lane;
    f32x4 v[16]; float s = 0.f;
#pragma unroll
    for (int j = 0; j < 16; ++j) { v[j] = xr[64 * j]; s += (v[j].x * v[j].x + v[j].y * v[j].y) + (v[j].z * v[j].z + v[j].w * v[j].w); }
    const float rstd = 1.0f / sqrtf(wave_sum(s) * (1.0f / DM) + EPS);
    f32x4* o = (f32x4*)orow + lane;
#pragma unroll
    for (int j = 0; j < 16; ++j) { const f32x4 gg = gr[64 * j]; o[64 * j] = v[j] * rstd * gg; }
}
__device__ __forceinline__ void phase_final_norm(const float* H, const float* ssq, const float* g, float* out, int gw, int ngw, int lane) {
    const f32x4* gr = (const f32x4*)g + lane;
    for (int m = gw; m < MTOK; m += ngw) { const float rstd = 1.0f / sqrtf(ssq[m] * (1.0f / DM) + EPS);
        const f32x4* xr = (const f32x4*)(H + (size_t)m * DM) + lane; f32x4* o = (f32x4*)(out + (size_t)m * DM) + lane;
#pragma unroll
        for (int j = 0; j < 16; ++j) o[64 * j] = xr[64 * j] * rstd * gr[64 * j]; }
}
__device__ __forceinline__ void phase_rms_bf16(const float* src, const float* g, bf16_t* dst, int gw, int ngw, int lane) {
    for (int m = gw; m < MTOK; m += ngw) rms_row_bf16(src + (size_t)m * DM, g, dst + (size_t)m * DM, lane);
}

__device__ __forceinline__ void phase_p0(const Params& p, LAS unsigned char* lds, int gw, int ngw, int wave, int lane) {
    unsigned char* ws = p.ws;
    LAS float* scr = (LAS float*)(lds + wave * 8704);
    bf16_t* WAB_IN = (bf16_t*)(ws + WS_WAB_IN); bf16_t* WAB_OUT = (bf16_t*)(ws + WS_WAB_OUT); bf16_t* WGU0 = (bf16_t*)(ws + WS_WGU0); bf16_t* WDN0 = (bf16_t*)(ws + WS_WDN0);
    bf16_t* WCD_IN = (bf16_t*)(ws + WS_WCD_IN); bf16_t* WCD_OUT = (bf16_t*)(ws + WS_WCD_OUT); bf16_t* WGU1 = (bf16_t*)(ws + WS_WGU1); bf16_t* WDN1 = (bf16_t*)(ws + WS_WDN1);
    bf16_t* WRG = (bf16_t*)(ws + WS_WRG);
    constexpr int I_AB = (DM / 64) * (6144 / 32), I_SQ = (DM / 64) * (DM / 32), I_CD = (DM / 64) * (CD_IN / 32), I_GU = (DM / 64) * (DFF / 32), I_DN = (DFF / 64) * (DM / 32), I_RG = 16 * (256 / 64) * (256 / 32);
    constexpr int NITEMS = 2 * I_AB + 2 * I_SQ + I_CD + 4 * I_GU + 2 * I_DN + I_RG;
    for (int it = gw; it < NITEMS; it += ngw) {
        int r = it;
        TR_JOB(p.ab_w_in, AB_IN, DM, 0, 6144, WAB_IN, 0, nullptr)
        TR_JOB(p.ab_w_in, AB_IN, DM, 6160, 6144, WAB_IN, 6144, nullptr)
        TR_JOB(p.ab_w_out, DM, DM, 0, DM, WAB_OUT, 0, nullptr)
        TR_JOB_GU(p.ffn_w_gate, WGU0, 0, p.norm_ffn)
        TR_JOB_GU(p.ffn_w_up, WGU0, 128, p.norm_ffn)
        TR_JOB(p.ffn_w_down, DM, DFF, 0, DM, WDN0, 0, nullptr)
        TR_JOB(p.cd_w_in, CD_IN, DM, 0, CD_IN, WCD_IN, 0, p.norm_mix + DM)
        TR_JOB(p.cd_w_out, DM, DM, 0, DM, WCD_OUT, 0, nullptr)
        TR_JOB_GU(p.ffn_w_gate + (size_t)DM * DFF, WGU1, 0, p.norm_ffn + DM)
        TR_JOB_GU(p.ffn_w_up + (size_t)DM * DFF, WGU1, 128, p.norm_ffn + DM)
        TR_JOB(p.ffn_w_down + (size_t)DFF * DM, DM, DFF, 0, DM, WDN1, 0, nullptr)
        {
            const int mat = r / 32, rr = r % 32, kb_ = rr / 8, nb_ = rr % 8;
            const float* W = (mat < 8 ? p.rg_w_x : p.rg_w_a) + (size_t)(mat & 7) * 65536;
            tr_item(W, 256, 256, 32 * nb_, WRG + (size_t)mat * 65536, 32 * nb_, scr, kb_, lane);
        }
    }
    { bf16_t* WS_ = (bf16_t*)(ws + WS_WSMALL);
      for (int i = gw * 64 + lane; i < 32 * DM; i += ngw * 64) { const int c = i & 31, k = i >> 5; const int sc = c < 16 ? 6144 + c : 12304 + (c - 16);
          WS_[(size_t)c * DM + k] = f2bf(p.ab_w_in[(size_t)k * AB_IN + sc]); } }
    phase_rms_bf16(p.x, p.norm_mix, (bf16_t*)(ws + WS_U), gw, ngw, lane);
}

__device__ __forceinline__ void phase_small32(const Params& p, LAS unsigned char* lds, int wave, int lane) {
    const bf16_t* U = (const bf16_t*)(p.ws + WS_U); const bf16_t* WS_ = (const bf16_t*)(p.ws + WS_WSMALL); float* S32 = (float*)(p.ws + WS_SMALL32);
    LAS float* red = (LAS float*)lds;
    const int h = lane >> 5, c = lane & 31;
    for (int unit = blockIdx.x; unit < MTOK / 32; unit += gridDim.x) {
        const int row0 = unit * 32, kbase = wave * 512;
        f32x16 acc; for (int i = 0; i < 16; ++i) acc[i] = 0.f;
        const bf16_t* ap = U + (size_t)(row0 + c) * DM + kbase + 8 * h; const bf16_t* bp = WS_ + (size_t)c * DM + kbase + 8 * h;
#pragma unroll 8
        for (int s = 0; s < 32; ++s) { const bf16x8 a = *(const bf16x8*)(ap + 16 * s), b = *(const bf16x8*)(bp + 16 * s); acc = MFMA32(a, b, acc); }
#pragma unroll
        for (int r = 0; r < 16; ++r) red[(wave * 32 + crow(r, h)) * 33 + c] = acc[r];
        __syncthreads();
        for (int i = threadIdx.x; i < 1024; i += NTHR) { const int t = i >> 5, cc = i & 31; float s = 0.f;
#pragma unroll
            for (int w = 0; w < 8; ++w) s += red[(w * 32 + t) * 33 + cc];
            S32[(size_t)(row0 + t) * 32 + cc] = s; }
        __syncthreads();
    }
}

__device__ __forceinline__ void phase_fox_cumsum(const Params& p, int gw, int ngw, int lane) {
    const float* S32 = (const float*)(p.ws + WS_SMALL32); float* CF = (float*)(p.ws + WS_CF);
    for (int u = gw; u < NB * 16; u += ngw) { const int b = u >> 4, hd = u & 15; const float bias = p.fox_b_f[hd];
        float v[32]; float run = 0.f;
#pragma unroll
        for (int i = 0; i < 32; ++i) { const int t = 32 * lane + i; run += log_sigmoid_acc(S32[(size_t)(b * SEQ + t) * 32 + 16 + hd] + bias); v[i] = run; }
        float incl = run;
#pragma unroll
        for (int o = 1; o < 64; o <<= 1) { const float t = __shfl_up(incl, o); if (lane >= o) incl += t; }
        const float off = incl - run;
#pragma unroll
        for (int i = 0; i < 32; ++i) CF[(size_t)u * SEQ + 32 * lane + i] = v[i] + off;
    }
}

constexpr int GP_PITCH = 528;
__device__ __forceinline__ void phase_gla_pre(const Params& p, LAS unsigned char* lds, int wave, int lane) {
    const unsigned char* ws = p.ws;
    const bf16_t* PROJ = (const bf16_t*)(ws + WS_PROJ); const float* S32 = (const float*)(ws + WS_SMALL32);
    bf16_t* QT = (bf16_t*)(ws + WS_QT); bf16_t* KDT = (bf16_t*)(ws + WS_KDT); bf16_t* PM = (bf16_t*)(ws + WS_PM); float* GDEC = (float*)(ws + WS_GDEC);
    LAS float* G = (LAS float*)lds;
    LAS float* TOT = (LAS float*)(lds + 4096);
    LAS unsigned char* QTl = lds + 8192;
    LAS unsigned char* KTl = lds + 8192 + 64 * GP_PITCH;
    const int tid = threadIdx.x, k = tid & 255, th = tid >> 8, h = lane >> 5;
    for (int unit = blockIdx.x; unit < NB * 4 * 32; unit += gridDim.x) {
        const int b = unit >> 7, hd = (unit >> 5) & 3, c = unit & 31, R0 = b * SEQ + 64 * c;
        for (int i = tid; i < 1024; i += NTHR) G[i] = S32[(size_t)(R0 + (i >> 4)) * 32 + (i & 15)];
        float w[16];
#pragma unroll
        for (int r = 0; r < 16; ++r) w[r] = p.gla_w_gate_up[r * 1024 + hd * 256 + k];
        const float bias = p.gla_b_gate[hd * 256 + k];
        __syncthreads();
        float bc[32]; float run = 0.f;
#pragma unroll
        for (int tt = 0; tt < 32; ++tt) { const LAS f32x4* g4 = (const LAS f32x4*)(G + (32 * th + tt) * 16); float xx = bias;
#pragma unroll
            for (int q4 = 0; q4 < 4; ++q4) { const f32x4 gv = g4[q4]; xx += gv.x * w[4 * q4] + gv.y * w[4 * q4 + 1] + gv.z * w[4 * q4 + 2] + gv.w * w[4 * q4 + 3]; }
            run += log_sigmoid_acc(xx) * (1.0f / 16.0f); bc[tt] = run; }
        TOT[th * 256 + k] = run;
        __syncthreads();
        const float t0 = TOT[k], t1 = TOT[256 + k], blast = t0 + t1, boff = th ? t0 : 0.f;
        if (th == 0) GDEC[(size_t)unit * 256 + k] = expf(blast);
        const bf16_t* qp = PROJ + (size_t)(R0 + 32 * th) * AB_MAIN + PJ_GQ + hd * 256 + k; const bf16_t* kp = PROJ + (size_t)(R0 + 32 * th) * AB_MAIN + PJ_GK + hd * 256 + k;
        bf16_t* qto = QT + (size_t)(R0 + 32 * th) * 1024 + hd * 256 + k;
        bf16_t* kdo = KDT + ((size_t)unit * 256 + k) * 64 + 32 * th;
#pragma unroll
        for (int t8 = 0; t8 < 4; ++t8) { float kd[8];
#pragma unroll
            for (int i = 0; i < 8; ++i) { const int tt = 8 * t8 + i; const float bb = bc[tt] + boff;
                const float qv = bf2f(qp[(size_t)tt * AB_MAIN]), kv = bf2f(kp[(size_t)tt * AB_MAIN]);
                const float qt = qv * 0.0625f * expf(bb), kt = kv * expf(-bb); kd[i] = kv * expf(blast - bb);
                const bf16_t qb = f2bf(qt);
                *(LAS bf16_t*)(QTl + (32 * th + tt) * GP_PITCH + 2 * k) = qb; *(LAS bf16_t*)(KTl + (32 * th + tt) * GP_PITCH + 2 * k) = f2bf(kt);
                qto[(size_t)tt * 1024] = qb; }
            u32x4 o; o.x = cvt_pk_bf16(kd[0], kd[1]); o.y = cvt_pk_bf16(kd[2], kd[3]); o.z = cvt_pk_bf16(kd[4], kd[5]); o.w = cvt_pk_bf16(kd[6], kd[7]);
            *(u32x4*)(kdo + 8 * t8) = o; }
        __syncthreads();
        if (wave < 4) { const int ti = wave & 1, si = wave >> 1;
            f32x16 acc; for (int i = 0; i < 16; ++i) acc[i] = 0.f;
            const LAS unsigned char* ap = QTl + (32 * ti + (lane & 31)) * GP_PITCH + 16 * h; const LAS unsigned char* bp = KTl + (32 * si + (lane & 31)) * GP_PITCH + 16 * h;
#pragma unroll
            for (int s = 0; s < 16; ++s) { const bf16x8 a = *(const LAS bf16x8*)(ap + 32 * s), bb = *(const LAS bf16x8*)(bp + 32 * s); acc = MFMA32(a, bb, acc); }
            const int sc = 32 * si + (lane & 31);
#pragma unroll
            for (int r = 0; r < 16; ++r) { const int t = 32 * ti + crow(r, h); PM[(size_t)unit * 4096 + t * 64 + sc] = f2bf(sc <= t ? acc[r] : 0.f); }
        }
        __syncthreads();
    }
}

constexpr int VT_PITCH = 144;
__device__ __forceinline__ void phase_gla_seq(const Params& p, LAS unsigned char* lds, int wave, int lane) {
    const unsigned char* ws = p.ws;
    const bf16_t* PROJ = (const bf16_t*)(ws + WS_PROJ); const bf16_t* QT = (const bf16_t*)(ws + WS_QT); const bf16_t* KDT = (const bf16_t*)(ws + WS_KDT); const bf16_t* PM = (const bf16_t*)(ws + WS_PM);
    const float* GDEC = (const float*)(ws + WS_GDEC); float* ORAW = (float*)(p.ws + WS_ORAW); float* SSQ = (float*)(p.ws + WS_SSQ);
    LAS float* RED = (LAS float*)lds;
    LAS unsigned char* VT = lds + 65536;
    const int tid = threadIdx.x, h = lane >> 5, l31 = lane & 31;
    for (int unit = blockIdx.x; unit < NB * 4 * 16; unit += gridDim.x) {
        const int b = unit >> 6, hd = (unit >> 4) & 3, vs = unit & 15, v0 = 32 * vs;
        f32x16 S; for (int i = 0; i < 16; ++i) S[i] = 0.f;
        for (int c = 0; c < 32; ++c) {
            const int R0 = b * SEQ + 64 * c, cu = (b * 4 + hd) * 32 + c;
            LAS unsigned char* vt = VT + (c & 1) * (32 * VT_PITCH);
            { const int s = tid >> 3, v4 = (tid & 7) * 4; const u32x2 raw = *(const u32x2*)(PROJ + (size_t)(R0 + s) * AB_MAIN + PJ_GV + hd * 512 + v0 + v4);
              *(LAS bf16_t*)(vt + (v4 + 0) * VT_PITCH + 2 * s) = (bf16_t)(raw.x & 0xffffu); *(LAS bf16_t*)(vt + (v4 + 1) * VT_PITCH + 2 * s) = (bf16_t)(raw.x >> 16);
              *(LAS bf16_t*)(vt + (v4 + 2) * VT_PITCH + 2 * s) = (bf16_t)(raw.y & 0xffffu); *(LAS bf16_t*)(vt + (v4 + 3) * VT_PITCH + 2 * s) = (bf16_t)(raw.y >> 16); }
            bf16x8 qa[2][2];
#pragma unroll
            for (int ti = 0; ti < 2; ++ti)
#pragma unroll
                for (int s2 = 0; s2 < 2; ++s2) { const bf16_t* q = QT + (size_t)(R0 + 32 * ti + l31) * 1024 + hd * 256 + 32 * wave + 16 * s2 + 4 * h;
                    const s16x4 lo = *(const s16x4*)q, hi = *(const s16x4*)(q + 8); qa[ti][s2] = cat4(lo, hi); }
            bf16x8 kda[4];
#pragma unroll
            for (int ss = 0; ss < 4; ++ss) kda[ss] = *(const bf16x8*)(KDT + ((size_t)cu * 256 + 32 * wave + l31) * 64 + 16 * ss + 8 * h);
            const int tip = wave & 1, ssp = wave >> 1;
            const bf16x8 pa = *(const bf16x8*)(PM + (size_t)cu * 4096 + (32 * tip + l31) * 64 + 16 * ssp + 8 * h);
            f32x4 gd[4];
#pragma unroll
            for (int g = 0; g < 4; ++g) gd[g] = *(const f32x4*)(GDEC + (size_t)cu * 256 + 32 * wave + 8 * g + 4 * h);
            __syncthreads();
            f32x16 oacc[2];
#pragma unroll
            for (int ti = 0; ti < 2; ++ti) for (int i = 0; i < 16; ++i) oacc[ti][i] = 0.f;
            const bf16x8 sb0 = pack8(S[0], S[1], S[2], S[3], S[4], S[5], S[6], S[7]), sb1 = pack8(S[8], S[9], S[10], S[11], S[12], S[13], S[14], S[15]);
#pragma unroll
            for (int ti = 0; ti < 2; ++ti) { oacc[ti] = MFMA32(qa[ti][0], sb0, oacc[ti]); oacc[ti] = MFMA32(qa[ti][1], sb1, oacc[ti]); }
            bf16x8 vb[4];
#pragma unroll
            for (int ss = 0; ss < 4; ++ss) vb[ss] = *(const LAS bf16x8*)(vt + l31 * VT_PITCH + 32 * ss + 16 * h);
            { const bf16x8 vbp = ssp == 0 ? vb[0] : ssp == 1 ? vb[1] : ssp == 2 ? vb[2] : vb[3];
              if (tip == 0) oacc[0] = MFMA32(pa, vbp, oacc[0]); else oacc[1] = MFMA32(pa, vbp, oacc[1]); }
#pragma unroll
            for (int r = 0; r < 16; ++r) S[r] *= gd[r >> 2][r & 3];
#pragma unroll
            for (int ss = 0; ss < 4; ++ss) S = MFMA32(kda[ss], vb[ss], S);
#pragma unroll
            for (int ti = 0; ti < 2; ++ti)
#pragma unroll
                for (int r = 0; r < 16; ++r) RED[(wave * 64 + 32 * ti + crow(r, h)) * 32 + l31] = oacc[ti][r];
            __syncthreads();
            { const int t = tid >> 3, v4 = (tid & 7) * 4; f32x4 o = {0.f, 0.f, 0.f, 0.f};
#pragma unroll
              for (int w = 0; w < 8; ++w) o += *(const LAS f32x4*)(RED + (w * 64 + t) * 32 + v4);
              *(f32x4*)(ORAW + (size_t)(R0 + t) * 2048 + hd * 512 + v0 + v4) = o;
              float q = (o.x * o.x + o.y * o.y) + (o.z * o.z + o.w * o.w);
              q += __shfl_xor(q, 1); q += __shfl_xor(q, 2); q += __shfl_xor(q, 4);
              if ((tid & 7) == 0) SSQ[(size_t)(R0 + t) * 64 + hd * 16 + vs] = q; }
        }
        __syncthreads();
    }
}

__device__ __forceinline__ void phase_gla_post(const Params& p, int gw, int ngw, int lane) {
    const bf16_t* PROJ = (const bf16_t*)(p.ws + WS_PROJ); const float* ORAW = (const float*)(p.ws + WS_ORAW); const float* SSQ = (const float*)(p.ws + WS_SSQ); bf16_t* O = (bf16_t*)(p.ws + WS_O);
    const f32x4 gn0 = *(const f32x4*)(p.gla_norm + 8 * lane), gn1 = *(const f32x4*)(p.gla_norm + 8 * lane + 4);
    for (int u = gw; u < MTOK * 4; u += ngw) { const int row = u >> 2, hd = u & 3;
        float ss = 0.f;
#pragma unroll
        for (int i = 0; i < 4; ++i) { const f32x4 s4 = *(const f32x4*)(SSQ + (size_t)row * 64 + hd * 16 + 4 * i); ss += (s4.x + s4.y) + (s4.z + s4.w); }
        const float rstd = 1.0f / sqrtf(ss * (1.0f / 512.0f) + EPS);
        const f32x4 o0 = *(const f32x4*)(ORAW + (size_t)row * 2048 + hd * 512 + 8 * lane), o1 = *(const f32x4*)(ORAW + (size_t)row * 2048 + hd * 512 + 8 * lane + 4);
        const u32x4 gr = *(const u32x4*)(PROJ + (size_t)row * AB_MAIN + PJ_GG + hd * 512 + 8 * lane);
        float g[8] = {bflo(gr.x), bfhi(gr.x), bflo(gr.y), bfhi(gr.y), bflo(gr.z), bfhi(gr.z), bflo(gr.w), bfhi(gr.w)};
        float o[8] = {o0.x * gn0.x, o0.y * gn0.y, o0.z * gn0.z, o0.w * gn0.w, o1.x * gn1.x, o1.y * gn1.y, o1.z * gn1.z, o1.w * gn1.w};
#pragma unroll
        for (int i = 0; i < 8; ++i) o[i] = o[i] * rstd * g[i] / (1.0f + __expf(-g[i]));
        u32x4 w; w.x = cvt_pk_bf16(o[0], o[1]); w.y = cvt_pk_bf16(o[2], o[3]); w.z = cvt_pk_bf16(o[4], o[5]); w.w = cvt_pk_bf16(o[6], o[7]);
        *(u32x4*)(O + (size_t)row * DM + hd * 512 + 8 * lane) = w; }
}

constexpr int AK_PITCH = 272, AV_PITCH = 320;
constexpr int AK_BYTES = 64 * AK_PITCH, AV_BYTES = 64 * AV_PITCH;
constexpr int A_KOFF = 0, A_VOFF = 2 * AK_BYTES, A_COFF = A_VOFF + 2 * AV_BYTES;
constexpr float ATT_SCALE = 0.08838834764831845f;
constexpr float LOG2E = 1.4426950408889634f;

struct AttnIO { const bf16_t* Q; const bf16_t* K; const bf16_t* V; int ld; bf16_t* O; int ldo; };

__device__ __forceinline__ void attn_stage_load(const AttnIO& io, size_t rowbase, int hd, int key0, u32x4 (&kr)[2], u32x4 (&vr)[2], int tid) {
#pragma unroll
    for (int i = 0; i < 2; ++i) { const int idx = tid + NTHR * i, r = idx >> 4, ch = idx & 15; const size_t off = (rowbase + key0 + r) * (size_t)io.ld + hd * 128 + ch * 8;
        kr[i] = *(const u32x4*)(io.K + off); vr[i] = *(const u32x4*)(io.V + off); }
}
__device__ __forceinline__ void attn_stage_store(LAS unsigned char* lds, int buf, const u32x4 (&kr)[2], const u32x4 (&vr)[2], int tid) {
#pragma unroll
    for (int i = 0; i < 2; ++i) { const int idx = tid + NTHR * i, r = idx >> 4, ch = idx & 15;
        *(LAS u32x4*)(lds + A_KOFF + buf * AK_BYTES + r * AK_PITCH + ch * 16) = kr[i]; *(LAS u32x4*)(lds + A_VOFF + buf * AV_BYTES + r * AV_PITCH + ch * 16) = vr[i]; }
}
__device__ __forceinline__ void attn_qk(LAS unsigned char* lds, int buf, const bf16x8 (&qf)[8], f32x16& s0, f32x16& s1, int lane) {
    const LAS unsigned char* kp = lds + A_KOFF + buf * AK_BYTES + (lane & 31) * AK_PITCH + (lane >> 5) * 16;
    for (int i = 0; i < 16; ++i) { s0[i] = 0.f; s1[i] = 0.f; }
#pragma unroll
    for (int s = 0; s < 8; ++s) { const bf16x8 a0 = *(const LAS bf16x8*)(kp + 32 * s), a1 = *(const LAS bf16x8*)(kp + 32 * AK_PITCH + 32 * s);
        s0 = MFMA32(a0, qf[s], s0); s1 = MFMA32(a1, qf[s], s1); }
}
__device__ __forceinline__ void attn_pv(LAS unsigned char* lds, int buf, const f32x16& p0, const f32x16& p1, f32x16 (&o)[4], int lane) {
    const lds_cptr vp = (lds_cptr)(lds + A_VOFF + buf * AV_BYTES + (4 * (lane >> 5) + ((lane & 15) >> 2)) * AV_PITCH + (((lane >> 4) & 1) * 16 + (lane & 3) * 4) * 2);
    const bf16x8 pf00 = pack8(p0[0], p0[1], p0[2], p0[3], p0[4], p0[5], p0[6], p0[7]), pf01 = pack8(p0[8], p0[9], p0[10], p0[11], p0[12], p0[13], p0[14], p0[15]);
    const bf16x8 pf10 = pack8(p1[0], p1[1], p1[2], p1[3], p1[4], p1[5], p1[6], p1[7]), pf11 = pack8(p1[8], p1[9], p1[10], p1[11], p1[12], p1[13], p1[14], p1[15]);
#pragma unroll
    for (int dt = 0; dt < 4; ++dt) {
        const bf16x8 a00 = cat4(vtr(vp + (0) * AV_PITCH + dt * 64), vtr(vp + (8) * AV_PITCH + dt * 64));
        const bf16x8 a01 = cat4(vtr(vp + (16) * AV_PITCH + dt * 64), vtr(vp + (24) * AV_PITCH + dt * 64));
        const bf16x8 a10 = cat4(vtr(vp + (32) * AV_PITCH + dt * 64), vtr(vp + (40) * AV_PITCH + dt * 64));
        const bf16x8 a11 = cat4(vtr(vp + (48) * AV_PITCH + dt * 64), vtr(vp + (56) * AV_PITCH + dt * 64));
        o[dt] = MFMA32(a00, pf00, o[dt]); o[dt] = MFMA32(a01, pf01, o[dt]); o[dt] = MFMA32(a10, pf10, o[dt]); o[dt] = MFMA32(a11, pf11, o[dt]);
    }
}
__device__ __forceinline__ void attn_store_o(const AttnIO& io, size_t row, int hd, const f32x16 (&o)[4], float scl, int lane) {
    bf16_t* op = io.O + row * (size_t)io.ldo + hd * 128 + 4 * (lane >> 5);
#pragma unroll
    for (int dt = 0; dt < 4; ++dt)
#pragma unroll
        for (int g = 0; g < 4; ++g) { u32x2 w; w.x = cvt_pk_bf16(o[dt][4 * g] * scl, o[dt][4 * g + 1] * scl); w.y = cvt_pk_bf16(o[dt][4 * g + 2] * scl, o[dt][4 * g + 3] * scl);
            *(u32x2*)(op + 32 * dt + 8 * g) = w; }
}

__device__ __forceinline__ void fox_unit(const AttnIO& io, const float* CF, LAS unsigned char* lds, int b, int hd, int qb, int wave, int lane) {
    const int tid = threadIdx.x, h = lane >> 5, l31 = lane & 31;
    const size_t rowbase = (size_t)b * SEQ; const int qpos = 256 * qb + 32 * wave + l31;
    const float* cf = CF + (size_t)(b * 16 + hd) * SEQ;
    bf16x8 qf[8];
#pragma unroll
    for (int s = 0; s < 8; ++s) qf[s] = *(const bf16x8*)(io.Q + (rowbase + qpos) * (size_t)io.ld + hd * 128 + 16 * s + 8 * h);
    const float cq = cf[qpos] * LOG2E;
    f32x16 o[4];
#pragma unroll
    for (int dt = 0; dt < 4; ++dt) for (int i = 0; i < 16; ++i) o[dt][i] = 0.f;
    float m = -1e30f, l = 0.f;
    const int ntiles = 4 * qb + 4;
    u32x4 kr[2], vr[2];
    LAS float* cks = (LAS float*)(lds + A_COFF);
    attn_stage_load(io, rowbase, hd, 0, kr, vr, tid);
    attn_stage_store(lds, 0, kr, vr, tid);
    if (tid < 64) cks[tid] = cf[tid] * LOG2E;
    __syncthreads();
    for (int j = 0; j < ntiles; ++j) {
        const int buf = j & 1; const bool more = j + 1 < ntiles;
        float cnext = 0.f;
        if (more) { attn_stage_load(io, rowbase, hd, 64 * (j + 1), kr, vr, tid); if (tid < 64) cnext = cf[64 * (j + 1) + tid] * LOG2E; }
        if (64 * j <= 256 * qb + 32 * wave + 31) {
            f32x16 s0, s1; attn_qk(lds, buf, qf, s0, s1, lane);
            const LAS float* ck = cks + buf * 64;
            float mx = -__builtin_inff();
#pragma unroll
            for (int g = 0; g < 4; ++g) { const f32x4 c0 = *(const LAS f32x4*)(ck + 8 * g + 4 * h), c1 = *(const LAS f32x4*)(ck + 32 + 8 * g + 4 * h);
#pragma unroll
                for (int i = 0; i < 4; ++i) { const int r = 4 * g + i, key = 64 * j + 8 * g + 4 * h + i;
                    float y0 = s0[r] * (ATT_SCALE * LOG2E) + (cq - c0[i]), y1 = s1[r] * (ATT_SCALE * LOG2E) + (cq - c1[i]);
                    y0 = key <= qpos ? y0 : -__builtin_inff(); y1 = key + 32 <= qpos ? y1 : -__builtin_inff();
                    s0[r] = y0; s1[r] = y1; mx = fmaxf(mx, fmaxf(y0, y1)); } }
            mx = fmaxf(mx, __shfl_xor(mx, 32));
            const float mn = fmaxf(m, mx), alpha = __builtin_amdgcn_exp2f(m - mn); m = mn;
            float ps = 0.f;
#pragma unroll
            for (int r = 0; r < 16; ++r) { s0[r] = __builtin_amdgcn_exp2f(s0[r] - mn); s1[r] = __builtin_amdgcn_exp2f(s1[r] - mn); ps += s0[r] + s1[r]; }
            l = l * alpha + ps;
#pragma unroll
            for (int dt = 0; dt < 4; ++dt) for (int i = 0; i < 16; ++i) o[dt][i] *= alpha;
            attn_pv(lds, buf, s0, s1, o, lane);
        }
        if (more) { attn_stage_store(lds, buf ^ 1, kr, vr, tid); if (tid < 64) cks[(buf ^ 1) * 64 + tid] = cnext; }
        __syncthreads();
    }
    l += __shfl_xor(l, 32);
    attn_store_o(io, rowbase + qpos, hd, o, 1.0f / l, lane);
}

__device__ __forceinline__ void sb_subtile(f32x16& s, int keybase, int qpos, int h, float& R) {
    float lb[16], l1[16];
#pragma unroll
    for (int r = 0; r < 16; ++r) { const float z = s[r] * ATT_SCALE; const int key = keybase + crow(r, h);
        const float lp = __logf(1.0f + __expf(-fabsf(z)));
        lb[r] = fminf(z, 0.f) - lp; l1[r] = key < qpos ? lb[r] - z : 0.f; }
    float T[4], Tp[4];
#pragma unroll
    for (int g = 0; g < 4; ++g) { T[g] = (l1[4 * g] + l1[4 * g + 1]) + (l1[4 * g + 2] + l1[4 * g + 3]); Tp[g] = __shfl_xor(T[g], 32); }
    float run = R;
#pragma unroll
    for (int g = 3; g >= 0; --g) {
        const float off = h ? run : run + Tp[g];
        const float sf2 = l1[4 * g + 3], sf1 = sf2 + l1[4 * g + 2], sf0 = sf1 + l1[4 * g + 1];
        const float e3 = lb[4 * g + 3] + off, e2 = lb[4 * g + 2] + off + sf2, e1 = lb[4 * g + 1] + off + sf1, e0 = lb[4 * g] + off + sf0;
        const int key = keybase + 8 * g + 4 * h;
        s[4 * g + 3] = key + 3 < qpos ? __builtin_amdgcn_exp2f(e3 * LOG2E) : 0.f; s[4 * g + 2] = key + 2 < qpos ? __builtin_amdgcn_exp2f(e2 * LOG2E) : 0.f;
        s[4 * g + 1] = key + 1 < qpos ? __builtin_amdgcn_exp2f(e1 * LOG2E) : 0.f; s[4 * g] = key < qpos ? __builtin_amdgcn_exp2f(e0 * LOG2E) : 0.f;
        run += T[g] + Tp[g];
    }
    R = run;
}
__device__ __forceinline__ void sb_unit(const AttnIO& io, LAS unsigned char* lds, int b, int hd, int qb, int wave, int lane) {
    const int tid = threadIdx.x, h = lane >> 5, l31 = lane & 31;
    const size_t rowbase = (size_t)b * SEQ; const int qpos = 256 * qb + 32 * wave + l31;
    bf16x8 qf[8];
#pragma unroll
    for (int s = 0; s < 8; ++s) qf[s] = *(const bf16x8*)(io.Q + (rowbase + qpos) * (size_t)io.ld + hd * 128 + 16 * s + 8 * h);
    f32x16 o[4];
#pragma unroll
    for (int dt = 0; dt < 4; ++dt) for (int i = 0; i < 16; ++i) o[dt][i] = 0.f;
    float R = 0.f;
    const int ntiles = 4 * qb + 4;
    u32x4 kr[2], vr[2];
    attn_stage_load(io, rowbase, hd, 64 * (ntiles - 1), kr, vr, tid);
    attn_stage_store(lds, 0, kr, vr, tid);
    __syncthreads();
    for (int jj = 0; jj < ntiles; ++jj) {
        const int j = ntiles - 1 - jj, buf = jj & 1; const bool more = jj + 1 < ntiles;
        if (more) attn_stage_load(io, rowbase, hd, 64 * (j - 1), kr, vr, tid);
        if (64 * j < 256 * qb + 32 * wave + 31) {
            f32x16 s0, s1; attn_qk(lds, buf, qf, s0, s1, lane);
            sb_subtile(s1, 64 * j + 32, qpos, h, R);
            sb_subtile(s0, 64 * j, qpos, h, R);
            attn_pv(lds, buf, s0, s1, o, lane);
        }
        if (more) attn_stage_store(lds, buf ^ 1, kr, vr, tid);
        __syncthreads();
    }
    attn_store_o(io, rowbase + qpos, hd, o, 1.0f, lane);
}

constexpr int RG_XPITCH = 528;
constexpr int RG_XC = 0, RG_GX = 128 * RG_XPITCH, RG_GA = RG_GX + 128 * 32 * 4, RG_HB = RG_GA + 128 * 32 * 4, RG_CW = RG_HB + 128 * 32 * 4, RG_SPL = RG_CW + 5 * 256 * 4;
__device__ __forceinline__ float gelu_tanh(float x) { const float u = 0.7978845608028654f * (x + 0.044715f * x * x * x); const float e = __expf(2.0f * u); const float th = 1.0f - 2.0f * __builtin_amdgcn_rcpf(e + 1.0f); return 0.5f * x * (1.0f + th); }
__device__ __forceinline__ void rg_load_raw(const bf16_t* PROJ, size_t rowb, int T0, int tg, int cb, int cc, u32x4 (&raw)[11]) {
    const bf16_t* base = PROJ + (rowb + T0 + 8 * tg) * CD_IN + PJ_RX + cb + 8 * cc;
#pragma unroll
    for (int i = 0; i < 11; ++i) { const int t = T0 + 8 * tg - 3 + i; if (t >= 0) raw[i] = *(const u32x4*)(base + (ptrdiff_t)(i - 3) * CD_IN); else raw[i] = (u32x4){0u, 0u, 0u, 0u}; }
}
__device__ __forceinline__ void phase_rg(const Params& p, LAS unsigned char* lds, int wave, int lane) {
    const unsigned char* ws = p.ws;
    const bf16_t* PROJ = (const bf16_t*)(ws + WS_PROJ); const bf16_t* WRG = (const bf16_t*)(ws + WS_WRG); bf16_t* O = (bf16_t*)(p.ws + WS_O);
    const int tid = threadIdx.x, h = lane >> 5, l31 = lane & 31;
    LAS float* GX = (LAS float*)(lds + RG_GX); LAS float* GA = (LAS float*)(lds + RG_GA); LAS float* HB = (LAS float*)(lds + RG_HB); LAS float* CW = (LAS float*)(lds + RG_CW); LAS float* SPL = (LAS float*)(lds + RG_SPL);
    const int cc = tid & 31, tg = tid >> 5;
    const int et = tid >> 2, ej = (tid & 3) * 8;
    for (int unit = blockIdx.x; unit < NB * 8 * 8; unit += gridDim.x) {
        const int b = unit >> 6, g = (unit >> 3) & 7, js = unit & 7, cb = 256 * g, c0 = cb + 32 * js;
        const size_t rowb = (size_t)b * SEQ;
        const int gate = wave >> 2, ti = wave & 3;
        bf16x8 wf[16];
        { const bf16_t* wp = WRG + ((size_t)(gate * 8 + g) * 256 + 32 * js + l31) * 256 + 8 * h;
#pragma unroll
          for (int s = 0; s < 16; ++s) wf[s] = *(const bf16x8*)(wp + 16 * s); }
        const float gbias = (gate ? p.rg_b_a : p.rg_b_x)[c0 + l31];
        for (int i = tid; i < 5 * 256; i += NTHR) { const int j = i >> 8, c = i & 255; CW[i] = j < 4 ? p.rg_conv_w[j * 2048 + cb + c] : p.rg_conv_b[cb + c]; }
        if (tid < 32) { const float lam = p.rg_lambda[c0 + tid]; SPL[tid] = -8.0f * LOG2E * (fmaxf(-lam, 0.f) + log1pf(expf(-fabsf(lam)))); }
        u32x4 raw[11];
        rg_load_raw(PROJ, rowb, 0, tg, cb, cc, raw);
        float hstate = 0.f;
        __syncthreads();
        for (int tt = 0; tt < SEQ / 128; ++tt) {
            const int T0 = 128 * tt; const size_t R0 = rowb + T0;
            const u32x4 ryraw = *(const u32x4*)(PROJ + (R0 + et) * CD_IN + PJ_RY + c0 + ej);
            { float w0[8], w1[8], w2[8], w3[8], bb[8];
#pragma unroll
              for (int q = 0; q < 2; ++q) { const f32x4 a0 = *(const LAS f32x4*)(CW + 0 * 256 + 8 * cc + 4 * q), a1 = *(const LAS f32x4*)(CW + 1 * 256 + 8 * cc + 4 * q), a2 = *(const LAS f32x4*)(CW + 2 * 256 + 8 * cc + 4 * q),
                                                          a3 = *(const LAS f32x4*)(CW + 3 * 256 + 8 * cc + 4 * q), a4 = *(const LAS f32x4*)(CW + 4 * 256 + 8 * cc + 4 * q);
#pragma unroll
                  for (int e = 0; e < 4; ++e) { w0[4 * q + e] = a0[e]; w1[4 * q + e] = a1[e]; w2[4 * q + e] = a2[e]; w3[4 * q + e] = a3[e]; bb[4 * q + e] = a4[e]; } }
#pragma unroll
              for (int i = 0; i < 8; ++i) { float xo[8];
#pragma unroll
                  for (int e2 = 0; e2 < 4; ++e2) { const unsigned r0 = raw[i][e2], r1 = raw[i + 1][e2], r2 = raw[i + 2][e2], r3 = raw[i + 3][e2];
                      xo[2 * e2] = bb[2 * e2] + w0[2 * e2] * bflo(r0) + w1[2 * e2] * bflo(r1) + w2[2 * e2] * bflo(r2) + w3[2 * e2] * bflo(r3);
                      xo[2 * e2 + 1] = bb[2 * e2 + 1] + w0[2 * e2 + 1] * bfhi(r0) + w1[2 * e2 + 1] * bfhi(r1) + w2[2 * e2 + 1] * bfhi(r2) + w3[2 * e2 + 1] * bfhi(r3); }
                  u32x4 o; o.x = cvt_pk_bf16(xo[0], xo[1]); o.y = cvt_pk_bf16(xo[2], xo[3]); o.z = cvt_pk_bf16(xo[4], xo[5]); o.w = cvt_pk_bf16(xo[6], xo[7]);
                  *(LAS u32x4*)(lds + RG_XC + (8 * tg + i) * RG_XPITCH + 16 * cc) = o; } }
            if (tt + 1 < SEQ / 128) rg_load_raw(PROJ, rowb, T0 + 128, tg, cb, cc, raw);
            __syncthreads();
            { f32x16 acc; for (int i = 0; i < 16; ++i) acc[i] = 0.f;
              const LAS unsigned char* ap = lds + RG_XC + (32 * ti + l31) * RG_XPITCH + 16 * h;
#pragma unroll
              for (int s = 0; s < 16; ++s) { const bf16x8 a = *(const LAS bf16x8*)(ap + 32 * s); acc = MFMA32(a, wf[s], acc); }
              LAS float* gout = gate ? GA : GX;
#pragma unroll
              for (int r = 0; r < 16; ++r) { const float v = acc[r] + gbias; gout[(32 * ti + crow(r, h)) * 32 + l31] = __builtin_amdgcn_rcpf(1.0f + __expf(-v)); } }
            __syncthreads();
            { const u32x4 xr = *(const LAS u32x4*)(lds + RG_XC + et * RG_XPITCH + 2 * (32 * js + ej));
              const float xc[8] = {bflo(xr.x), bfhi(xr.x), bflo(xr.y), bfhi(xr.y), bflo(xr.z), bfhi(xr.z), bflo(xr.w), bfhi(xr.w)};
#pragma unroll
              for (int q = 0; q < 2; ++q) { f32x4 ga = *(const LAS f32x4*)(GA + et * 32 + ej + 4 * q), gx = *(const LAS f32x4*)(GX + et * 32 + ej + 4 * q); const f32x4 sp = *(const LAS f32x4*)(SPL + ej + 4 * q);
#pragma unroll
                  for (int e = 0; e < 4; ++e) { const float a = __builtin_amdgcn_exp2f(ga[e] * sp[e]); const float mult = sqrtf(fmaxf(1.0f - a * a, 0.f)); ga[e] = a; gx[e] = mult * gx[e] * xc[4 * q + e]; }
                  *(LAS f32x4*)(GA + et * 32 + ej + 4 * q) = ga; *(LAS f32x4*)(GX + et * 32 + ej + 4 * q) = gx; } }
            __syncthreads();
            if (wave == 0 && lane < 32) {
#pragma unroll 16
                for (int t = 0; t < 128; ++t) { hstate = GA[t * 32 + lane] * hstate + GX[t * 32 + lane]; HB[t * 32 + lane] = hstate; } }
            __syncthreads();
            { const float ry[8] = {bflo(ryraw.x), bfhi(ryraw.x), bflo(ryraw.y), bfhi(ryraw.y), bflo(ryraw.z), bfhi(ryraw.z), bflo(ryraw.w), bfhi(ryraw.w)};
              const f32x4 h0 = *(const LAS f32x4*)(HB + et * 32 + ej), h1 = *(const LAS f32x4*)(HB + et * 32 + ej + 4);
              u32x4 o; o.x = cvt_pk_bf16(h0.x * gelu_tanh(ry[0]), h0.y * gelu_tanh(ry[1])); o.y = cvt_pk_bf16(h0.z * gelu_tanh(ry[2]), h0.w * gelu_tanh(ry[3]));
              o.z = cvt_pk_bf16(h1.x * gelu_tanh(ry[4]), h1.y * gelu_tanh(ry[5])); o.w = cvt_pk_bf16(h1.z * gelu_tanh(ry[6]), h1.w * gelu_tanh(ry[7]));
              *(u32x4*)(O + (R0 + et) * DM + c0 + ej) = o; }
        }
        __syncthreads();
    }
}

#ifndef REP_P0
#define REP_P0 1
#endif
#ifndef REP_GEMM
#define REP_GEMM 1
#endif
#ifndef REP_MIX0
#define REP_MIX0 1
#endif
#ifndef REP_MIX1
#define REP_MIX1 1
#endif
#ifndef REP_RMS
#define REP_RMS 1
#endif
#ifndef MK_N_LAUNCHES
#define MK_N_LAUNCHES 1
#endif
constexpr int N_PHASES = 16;
struct Args { Params p; int li, pad; };

__device__ __forceinline__ void attn_phase_fox(const Params& p, LAS unsigned char* lds, int wave, int lane) {
    const bf16_t* PROJ = (const bf16_t*)(p.ws + WS_PROJ);
    const AttnIO io{PROJ + PJ_FQ, PROJ + PJ_FK, PROJ + PJ_FV, AB_MAIN, (bf16_t*)(p.ws + WS_O) + 2048, DM};
    const float* CF = (const float*)(p.ws + WS_CF);
    for (int pr = blockIdx.x; pr < 256; pr += gridDim.x) { const int b = pr >> 6, hd = (pr >> 2) & 15, x = pr & 3;
        fox_unit(io, CF, lds, b, hd, 7 - x, wave, lane);
        fox_unit(io, CF, lds, b, hd, x, wave, lane); }
}
__device__ __forceinline__ void attn_phase_sb(const Params& p, LAS unsigned char* lds, int wave, int lane) {
    const bf16_t* PROJ = (const bf16_t*)(p.ws + WS_PROJ);
    const AttnIO io{PROJ + PJ_SQ, PROJ + PJ_SK, PROJ + PJ_SV, CD_IN, (bf16_t*)(p.ws + WS_O) + 2048, DM};
    for (int pr = blockIdx.x; pr < 256; pr += gridDim.x) { const int b = pr >> 6, hd = (pr >> 2) & 15, x = pr & 3;
        sb_unit(io, lds, b, hd, 7 - x, wave, lane);
        sb_unit(io, lds, b, hd, x, wave, lane); }
}

template <int layer>
__device__ __forceinline__ void layer_phases(const Params& p, LAS unsigned char* lds, const XcdBarrier& bar, int lo, int hi, int G, int gw, int ngw, int wave, int lane) {
    unsigned char* ws = p.ws;
    bf16_t* U = (bf16_t*)(ws + WS_U); bf16_t* PROJ = (bf16_t*)(ws + WS_PROJ); bf16_t* O = (bf16_t*)(ws + WS_O); float* H = (float*)(ws + WS_H); bf16_t* ACT = (bf16_t*)(ws + WS_ACT); float* SSQ = (float*)(ws + WS_CTL) + CW_SSQ;
#define IN(k) (lo <= (k) && (k) < hi)
#define SEAM(k) do { if ((k) + 1 < hi) xcd_barrier(bar); } while (0)
        constexpr int kb = 1 + 7 * layer;
        if (IN(kb)) {
            if (layer == 0) {
                pg8::Gemm g{U, (const bf16_t*)(ws + WS_WAB_IN), MTOK, AB_MAIN, DM}; pg8::StaticOrder S; S.init(MTOK, AB_MAIN, G, (int)blockIdx.x);
                pg8::EpiBf16<false> E{PROJ, AB_MAIN, nullptr};
                for (int rep = 0; rep < REP_GEMM; ++rep) { pg8::gemm_phase<pg8::EpiBf16<false>, pg8::StaticOrder, true, true>(lds, g, S, E); __syncthreads(); }
                phase_small32(p, lds, wave, lane);
            } else {
                pg8::Gemm g{U, (const bf16_t*)(ws + WS_WCD_IN), MTOK, CD_IN, DM}; pg8::StaticOrder S; S.init(MTOK, CD_IN, G, (int)blockIdx.x);
                pg8::EpiBf16<true> E{PROJ, CD_IN, SSQ + 1 * MTOK};
                for (int rep = 0; rep < REP_GEMM; ++rep) { pg8::gemm_phase<pg8::EpiBf16<true>, pg8::StaticOrder, true, true>(lds, g, S, E); __syncthreads(); }
            }
            SEAM(kb);
        }
        if (layer == 0 && IN(kb + 1)) { for (int rep = 0; rep < (REP_MIX0 == 5 ? 2 : 1); ++rep) { phase_fox_cumsum(p, gw, ngw, lane); phase_gla_pre(p, lds, wave, lane); } SEAM(kb + 1); }
        if (IN(kb + 2)) {
            if (layer == 0) { phase_gla_seq(p, lds, wave, lane); __syncthreads(); attn_phase_fox(p, lds, wave, lane); __syncthreads();
#if REP_MIX0 == 3
 attn_phase_fox(p, lds, wave, lane); __syncthreads();
#endif
#if REP_MIX0 == 4
 phase_gla_seq(p, lds, wave, lane); __syncthreads();
#endif
 }
            else { phase_rg(p, lds, wave, lane); __syncthreads(); attn_phase_sb(p, lds, wave, lane); __syncthreads();
#if REP_MIX1 == 2
 phase_rg(p, lds, wave, lane); __syncthreads(); attn_phase_sb(p, lds, wave, lane); __syncthreads();
#endif
#if REP_MIX1 == 3
 phase_rg(p, lds, wave, lane); __syncthreads();
#endif
 }
            SEAM(kb + 2);
        }
        if (layer == 0 && IN(kb + 3)) { for (int rep = 0; rep < (REP_MIX0 == 6 ? 2 : 1); ++rep) phase_gla_post(p, gw, ngw, lane); SEAM(kb + 3); }
        if (IN(kb + 4)) {
            pg8::Gemm g{O, (const bf16_t*)(ws + (layer ? WS_WCD_OUT : WS_WAB_OUT)), MTOK, DM, DM}; pg8::StaticOrder S; S.init(MTOK, DM, G, (int)blockIdx.x);
            pg8::EpiRes E{layer ? (const float*)H : p.x, H, DM, U, SSQ + (2 * layer) * MTOK};
            pg8::gemm_phase<pg8::EpiRes, pg8::StaticOrder, true, true>(lds, g, S, E);
            SEAM(kb + 4);
        }
        if (IN(kb + 5)) {
            pg8::Gemm g{U, (const bf16_t*)(ws + (layer ? WS_WGU1 : WS_WGU0)), MTOK, 2 * DFF, DM}; pg8::StaticOrder S; S.init(MTOK, 2 * DFF, G, (int)blockIdx.x);
            pg8::EpiSwiGLU E{ACT, DFF, SSQ + (2 * layer) * MTOK};
            for (int rep = 0; rep < REP_GEMM; ++rep) { pg8::gemm_phase<pg8::EpiSwiGLU, pg8::StaticOrder, true, true>(lds, g, S, E); __syncthreads(); }
            SEAM(kb + 5);
        }
        if (IN(kb + 6)) {
            pg8::Gemm g{ACT, (const bf16_t*)(ws + (layer ? WS_WDN1 : WS_WDN0)), MTOK, DM, DFF}; pg8::StaticOrder S; S.init(MTOK, DM, G, (int)blockIdx.x);
            pg8::EpiRes E{H, H, DM, layer ? (bf16_t*)nullptr : U, SSQ + (2 * layer + 1) * MTOK};
            pg8::gemm_phase<pg8::EpiRes, pg8::StaticOrder, true, true>(lds, g, S, E);
            SEAM(kb + 6);
        }
#undef IN
#undef SEAM
}

__global__ void __launch_bounds__(NTHR, 2) hybrid_fwd(Args args) {
    extern __shared__ __attribute__((aligned(16))) unsigned char lds_raw[];
    LAS unsigned char* lds = (LAS unsigned char*)lds_raw;
    const Params& p = args.p;
    const int tid = threadIdx.x, lane = tid & 63, wave = __builtin_amdgcn_readfirstlane(tid >> 6);
    const int G = gridDim.x, gw = blockIdx.x * NWAVES + wave, ngw = G * NWAVES;
    for (int u = tid; u < (LDS_BYTES - LDSCTL_OFF) / 4; u += NTHR) ((LAS unsigned*)(lds + LDSCTL_OFF))[u] = 0u;
    __syncthreads();
    unsigned* ctl = (unsigned*)(p.ws + WS_CTL);
    XcdBarrier bar = xcd_barrier_post(ctl + CW_BAR + args.li * XCD_BAR_WORDS, (volatile LAS unsigned*)(lds + MISC_OFF) + 8);
    const int lo = p.ph_lo, hi = p.ph_hi;
#define IN(k) (lo <= (k) && (k) < hi)
#define SEAM(k) do { if ((k) + 1 < hi) xcd_barrier(bar); } while (0)
    if (IN(0)) { for (int rep = 0; rep < REP_P0; ++rep) { phase_p0(p, lds, gw, ngw, wave, lane); __syncthreads(); } SEAM(0); }

    layer_phases<0>(p, lds, bar, lo, hi, G, gw, ngw, wave, lane);
    layer_phases<1>(p, lds, bar, lo, hi, G, gw, ngw, wave, lane);
    if (IN(15)) phase_final_norm((const float*)(p.ws + WS_H), (const float*)(p.ws + WS_CTL) + CW_SSQ + 3 * MTOK, p.final_norm, p.out, gw, ngw, lane);
#undef IN
#undef SEAM
}

extern "C" void kernel_launch(void* const* d_in, const int* in_sizes, int n_in, void* d_out, int out_size, void* d_ws, size_t ws_size, hipStream_t stream) {
    static int grid = 0;
    if (grid == 0) {
        if (n_in != 22 || in_sizes[0] != MTOK * DM || out_size != MTOK * DM || ws_size < WS_END) {
            fprintf(stderr, "kernel_launch: unexpected problem (n_in %d, in0 %d, out %d, ws %zu, need %zu); nothing launched\n", n_in, n_in > 0 ? in_sizes[0] : -1, out_size, ws_size, (size_t)WS_END); grid = -1; return; }
        int dev = 0, cus = 0, per_cu = 0;
        if (hipGetDevice(&dev) != hipSuccess || hipDeviceGetAttribute(&cus, hipDeviceAttributeMultiprocessorCount, dev) != hipSuccess) { fprintf(stderr, "kernel_launch: device query failed\n"); grid = -1; return; }
        if (hipFuncSetAttribute((const void*)hybrid_fwd, hipFuncAttributeMaxDynamicSharedMemorySize, LDS_BYTES) != hipSuccess) { fprintf(stderr, "kernel_launch: hipFuncSetAttribute failed\n"); grid = -1; return; }
        if (hipOccupancyMaxActiveBlocksPerMultiprocessor(&per_cu, (const void*)hybrid_fwd, NTHR, LDS_BYTES) != hipSuccess || per_cu < 1) {
            fprintf(stderr, "kernel_launch: occupancy query reports %d workgroups per CU; nothing launched\n", per_cu); (void)hipGetLastError(); grid = -1; return; }
        grid = cus;
    }
    if (grid < 0) return;
    if (hipMemsetAsync((char*)d_ws + WS_CTL, 0, CTL_ZERO_BYTES, stream) != hipSuccess) { fprintf(stderr, "kernel_launch: memset failed\n"); return; }
    Args a{};
    const float** pp = (const float**)&a.p;
    for (int i = 0; i < 22; ++i) pp[i] = (const float*)d_in[i];
    a.p.out = (float*)d_out; a.p.ws = (unsigned char*)d_ws;
#if MK_N_LAUNCHES == 1
    a.p.ph_lo = 0; a.p.ph_hi = N_PHASES; a.li = 0; a.pad = 0;
    hipLaunchKernelGGL(hybrid_fwd, dim3(grid), dim3(NTHR), LDS_BYTES, stream, a);
    { const hipError_t le = hipPeekAtLastError(); if (le != hipSuccess) fprintf(stderr, "kernel_launch: launch failed: %s\n", hipGetErrorName(le)); }
#else
    for (int k = 0; k < N_PHASES; ++k) { a.p.ph_lo = k; a.p.ph_hi = k + 1; a.li = k; a.pad = 0;
        hipLaunchKernelGGL(hybrid_fwd, dim3(grid), dim3(NTHR), LDS_BYTES, stream, a);
        const hipError_t le = hipPeekAtLastError(); if (le != hipSuccess) { fprintf(stderr, "kernel_launch: launch %d failed: %s\n", k, hipGetErrorName(le)); break; } }
#endif
}
```

```cpp
#include <hip/hip_runtime.h>
#include <cstdio>
#include <cstdint>

#define LAS __attribute__((address_space(3)))
#define GAS __attribute__((address_space(1)))
typedef unsigned short bf16_t;
typedef short bf16x8 __attribute__((ext_vector_type(8)));
typedef short s16x4 __attribute__((ext_vector_type(4)));
typedef float f32x4 __attribute__((ext_vector_type(4)));
typedef float f32x2 __attribute__((ext_vector_type(2)));
typedef float f32x16 __attribute__((ext_vector_type(16)));
typedef unsigned u32x4 __attribute__((ext_vector_type(4)));
typedef unsigned u32x2 __attribute__((ext_vector_type(2)));

constexpr int DM = 4096, NB = 4, SEQ = 2048, MTOK = NB * SEQ;
constexpr int DFF = 11008;
constexpr int AB_MAIN = 12288;
constexpr int AB_IN = 12320, CD_IN = 10240;
constexpr int PJ_GQ = 0, PJ_GK = 1024, PJ_GV = 2048, PJ_GG = 4096, PJ_FQ = 6144, PJ_FK = 8192, PJ_FV = 10240;
constexpr int PJ_RY = 0, PJ_RX = 2048, PJ_SQ = 4096, PJ_SK = 6144, PJ_SV = 8192;
constexpr float EPS = 1e-6f;

__device__ __forceinline__ unsigned cvt_pk_bf16(float lo, float hi) { unsigned r; asm volatile("v_cvt_pk_bf16_f32 %0, %1, %2" : "=v"(r) : "v"(lo), "v"(hi)); return r; }
__device__ __forceinline__ float bf2f(bf16_t v) { return __uint_as_float(((unsigned)v) << 16); }
__device__ __forceinline__ float bflo(unsigned w) { return __uint_as_float(w << 16); }
__device__ __forceinline__ float bfhi(unsigned w) { return __uint_as_float(w & 0xffff0000u); }
__device__ __forceinline__ bf16_t f2bf(float f) { return (bf16_t)(cvt_pk_bf16(f, 0.f) & 0xffffu); }
__device__ __forceinline__ int crow(int r, int hi) { return (r & 3) + 8 * (r >> 2) + 4 * hi; }
__device__ __forceinline__ bf16x8 pack8(float a0, float a1, float a2, float a3, float a4, float a5, float a6, float a7) {
    u32x4 w = {cvt_pk_bf16(a0, a1), cvt_pk_bf16(a2, a3), cvt_pk_bf16(a4, a5), cvt_pk_bf16(a6, a7)}; return __builtin_bit_cast(bf16x8, w); }
__device__ __forceinline__ float wave_sum(float v) {
#pragma unroll
    for (int o = 1; o < 64; o <<= 1) v += __shfl_xor(v, o);
    return v; }
__device__ __forceinline__ float log_sigmoid_acc(float x) { return fminf(x, 0.f) - log1pf(expf(-fabsf(x))); }
#define LDS_WAIT() asm volatile("s_waitcnt lgkmcnt(0)" ::: "memory")
#define VM_WAIT() asm volatile("s_waitcnt vmcnt(0)" ::: "memory")
#define MFMA32(a, b, c) __builtin_amdgcn_mfma_f32_32x32x16_bf16((a), (b), (c), 0, 0, 0)
typedef LAS const char* lds_cptr;
__device__ __forceinline__ s16x4 vtr(lds_cptr p) { return __builtin_bit_cast(s16x4, __builtin_amdgcn_ds_read_tr16_b64_v4i16((LAS s16x4*)p)); }
__device__ __forceinline__ bf16x8 cat4(s16x4 lo, s16x4 hi) { bf16x8 r; r[0] = lo[0]; r[1] = lo[1]; r[2] = lo[2]; r[3] = lo[3]; r[4] = hi[0]; r[5] = hi[1]; r[6] = hi[2]; r[7] = hi[3]; return r; }

namespace pg8 {
#define PG8_LAS __attribute__((address_space(3)))
typedef unsigned short bf16_t;
typedef short bf16x8 __attribute__((ext_vector_type(8)));
typedef float f32x4 __attribute__((ext_vector_type(4)));
typedef unsigned u32x4 __attribute__((ext_vector_type(4)));
constexpr int BM = 256, BK = 64, HALF = 128, HTB = HALF * BK * 2  , STAGE_BYTES = 8 * HTB, NXCD = 8, WGM = 8;

__host__ __device__ __forceinline__ int lds_byte(int r, int c) { const int st = (r >> 4) * 2 + (c >> 5), rr = r & 15, cc = c & 31, ob = rr * 64 + cc * 2; return st * 1024 + (ob ^ (((ob >> 9) & 1) << 5)); }
__host__ __device__ __forceinline__ void stage_rc(int b, int& R, int& C) { const int st = b / 1024, sb = b % 1024, swz = sb ^ (((sb >> 9) & 1) << 5); R = (st >> 1) * 16 + swz / 64; C = (st & 1) * 32 + (swz % 64) / 2; }
__host__ __device__ __forceinline__ int perm32(int rho) { const int n = rho >> 4, i = rho & 15; return 8 * (i >> 2) + 4 * n + (i & 3); }

struct Unit { int pm, pn; };
struct Gemm { const bf16_t* A; const bf16_t* Bt; int M, N, K; };

struct StaticOrder {
    int nM, nN, nwg, G, c;
    __host__ __device__ void init(int M, int N, int G_, int c_) { nM = M / BM; nN = N / BM; nwg = nM * nN; G = G_; c = c_; }
    __host__ __device__ bool next(int i, Unit& u) const {
        const long L = (long)i * G + c; if (L >= nwg) return false;
        int wgid = (int)L; { const int q = nwg / NXCD, r = nwg % NXCD, xcd = wgid % NXCD, off = wgid / NXCD; wgid = (xcd < r ? xcd * (q + 1) : r * (q + 1) + (xcd - r) * q) + off; }
        const int nig = WGM * nN, gid = wgid / nig, fm = gid * WGM, gsz = (nM - fm) < WGM ? (nM - fm) : WGM;
        u.pm = fm + ((wgid % nig) % gsz); u.pn = (wgid % nig) / gsz; return true;
    }
    __device__ __forceinline__ void a_ready(const Unit&) const {}
    __device__ __forceinline__ void done(const Unit&) const {}
};
__device__ __forceinline__ unsigned cvt_pk_bf16(float lo, float hi) { unsigned r; asm volatile("v_cvt_pk_bf16_f32 %0, %1, %2" : "=v"(r) : "v"(lo), "v"(hi)); return r; }
constexpr float RMS_EPS = 1e-6f, RMS_INV_D = 1.0f / 4096.0f, SSQ_FIX = 16777216.0f, SSQ_UNFIX = 1.0f / 16777216.0f;
typedef unsigned long long ssq_t;
__device__ __forceinline__ float ssq_rstd(const ssq_t* ssq, int row) { return __builtin_amdgcn_rsqf((float)ssq[row] * (SSQ_UNFIX * RMS_INV_D) + RMS_EPS); }

template <bool SCALE> struct EpiBf16 {
    static constexpr bool PERM = true, AFTER_DRAIN = false;
    bf16_t* O; int ldc; const ssq_t* ssq;
    __device__ __forceinline__ void operator()(const f32x4 (&acc)[2][2][4][2], const Unit& u, int wr, int wc, int fr, int fq) const {
        const int row0 = u.pm * BM + wr * 64 + fr, col0 = u.pn * BM + wc * 32 + 8 * fq;
#pragma unroll
        for (int ai = 0; ai < 2; ++ai)
#pragma unroll
            for (int m = 0; m < 4; ++m) { const int row = row0 + ai * HALF + m * 16; bf16_t* rowp = O + (size_t)row * ldc + col0;
                float rs = 1.0f; if (SCALE) rs = ssq_rstd(ssq, row);
#pragma unroll
                for (int bj = 0; bj < 2; ++bj) { const f32x4 v0 = acc[ai][bj][m][0] * rs, v1 = acc[ai][bj][m][1] * rs;
                    u32x4 w; w.x = cvt_pk_bf16(v0[0], v0[1]); w.y = cvt_pk_bf16(v0[2], v0[3]); w.z = cvt_pk_bf16(v1[0], v1[1]); w.w = cvt_pk_bf16(v1[2], v1[3]);
                    *(u32x4*)(rowp + bj * HALF) = w; } }
    }
};
template <bool BASE_F32> struct EpiRes {
    static constexpr bool PERM = true, AFTER_DRAIN = false;
    const void* base; bf16_t* out; int ldc; ssq_t* ssq;
    __device__ __forceinline__ void operator()(const f32x4 (&acc)[2][2][4][2], const Unit& u, int wr, int wc, int fr, int fq) const {
        const int row0 = u.pm * BM + wr * 64 + fr, col0 = u.pn * BM + wc * 32 + 8 * fq;
#pragma unroll
        for (int ai = 0; ai < 2; ++ai)
#pragma unroll
            for (int m = 0; m < 4; ++m) { const int row = row0 + ai * HALF + m * 16; const size_t off = (size_t)row * ldc + col0; float q = 0.f;
#pragma unroll
                for (int bj = 0; bj < 2; ++bj) { f32x4 v0 = acc[ai][bj][m][0], v1 = acc[ai][bj][m][1];
                    if (BASE_F32) { const float* bp = (const float*)base + off + bj * HALF; v0 += *(const f32x4*)bp; v1 += *(const f32x4*)(bp + 4); }
                    else { const u32x4 r = *(const u32x4*)((const bf16_t*)base + off + bj * HALF);
                        v0 += (f32x4){__uint_as_float(r.x << 16), __uint_as_float(r.x & 0xffff0000u), __uint_as_float(r.y << 16), __uint_as_float(r.y & 0xffff0000u)};
                        v1 += (f32x4){__uint_as_float(r.z << 16), __uint_as_float(r.z & 0xffff0000u), __uint_as_float(r.w << 16), __uint_as_float(r.w & 0xffff0000u)}; }
                    q += ((v0[0] * v0[0] + v0[1] * v0[1]) + (v0[2] * v0[2] + v0[3] * v0[3])) + ((v1[0] * v1[0] + v1[1] * v1[1]) + (v1[2] * v1[2] + v1[3] * v1[3]));
                    u32x4 w; w.x = cvt_pk_bf16(v0[0], v0[1]); w.y = cvt_pk_bf16(v0[2], v0[3]); w.z = cvt_pk_bf16(v1[0], v1[1]); w.w = cvt_pk_bf16(v1[2], v1[3]);
                    *(u32x4*)(out + off + bj * HALF) = w; }
                q += __shfl_xor(q, 16); q += __shfl_xor(q, 32);
                if (fq == 0) atomicAdd(ssq + row, (ssq_t)(q * SSQ_FIX + 0.5f));
                asm volatile("" ::: "memory"); }
    }
};
struct EpiSwiGLU {
    static constexpr bool PERM = true, AFTER_DRAIN = false;
    bf16_t* O; int ldc; const ssq_t* ssq;
    __device__ __forceinline__ void operator()(const f32x4 (&acc)[2][2][4][2], const Unit& u, int wr, int wc, int fr, int fq) const {
        const int row0 = u.pm * BM + wr * 64 + fr, col0 = u.pn * HALF + wc * 32 + 8 * fq;
#pragma unroll
        for (int ai = 0; ai < 2; ++ai)
#pragma unroll
            for (int m = 0; m < 4; ++m) { const int row = row0 + ai * HALF + m * 16; bf16_t* rowp = O + (size_t)row * ldc + col0; float a[8];
                const float rs = ssq_rstd(ssq, row);
#pragma unroll
                for (int n = 0; n < 2; ++n)
#pragma unroll
                    for (int i = 0; i < 4; ++i) { const float g = acc[ai][0][m][n][i] * rs, up = acc[ai][1][m][n][i] * rs; a[4 * n + i] = g * up * __builtin_amdgcn_rcpf(1.0f + __expf(-g)); }
                u32x4 w; w.x = cvt_pk_bf16(a[0], a[1]); w.y = cvt_pk_bf16(a[2], a[3]); w.z = cvt_pk_bf16(a[4], a[5]); w.w = cvt_pk_bf16(a[6], a[7]);
                *(u32x4*)rowp = w; }
    }
};

template <class Epi, class Sched, bool ALIGN_EPI = false, bool SP2 = false>
__device__ __forceinline__ void gemm_phase(PG8_LAS unsigned char* lds, const Gemm g, const Sched& S, const Epi& E) {
    const int tid = threadIdx.x, wid = __builtin_amdgcn_readfirstlane(tid >> 6), lane = tid & 63, wr = wid >> 2, wc = wid & 3, fr = lane & 15, fq = lane >> 4;
    const int K = g.K, nt = K / BK;
    unsigned voffA[2], voffB[2];
#pragma unroll
    for (int i = 0; i < 2; ++i) { int R, C; stage_rc(tid * 16 + i * 8192, R, C); const int Rb = Epi::PERM ? ((R & ~31) + perm32(R & 31)) : R;
        voffA[i] = (unsigned)(R * K + C) * 2u; voffB[i] = (unsigned)(Rb * K + C) * 2u; }
    const size_t kstep = (size_t)(BK * 2);
    const size_t hstep = (size_t)HALF * K * 2;
    const size_t tstep = 2 * hstep;
    const unsigned ldsw = (unsigned)wid * 1024u;
    const int aoff = lds_byte(wr * 64 + fr, fq * 8), boff = lds_byte(wc * 32 + fr, fq * 8);
#define PG8_SA(b, h) (((b) * 2 + (h)) * HTB)
#define PG8_SB(b, h) ((4 + (b) * 2 + (h)) * HTB)
#define PG8_STAGE(bufoff, gbase, voff) do { _Pragma("unroll") for (int _i = 0; _i < 2; ++_i) \
        __builtin_amdgcn_global_load_lds((const unsigned*)((const char*)(gbase) + (voff)[_i]), (PG8_LAS unsigned*)(lds + (bufoff) + ldsw + _i * 8192), 16, 0, 0); } while (0)
#define PG8_LDA(dst, b, h) do { _Pragma("unroll") for (int m = 0; m < 4; ++m) _Pragma("unroll") for (int k = 0; k < 2; ++k) dst[m][k] = *(const PG8_LAS bf16x8*)(lds + PG8_SA(b, h) + aoff + m * 2048 + k * 1024); } while (0)
#define PG8_LDB(dst, b, h) do { _Pragma("unroll") for (int n = 0; n < 2; ++n) _Pragma("unroll") for (int k = 0; k < 2; ++k) dst[n][k] = *(const PG8_LAS bf16x8*)(lds + PG8_SB(b, h) + boff + n * 2048 + k * 1024); } while (0)
#define PG8_MMA(ai, bj, At, Bt) do { __builtin_amdgcn_s_setprio(1); _Pragma("unroll") for (int m = 0; m < 4; ++m) _Pragma("unroll") for (int n = 0; n < 2; ++n) _Pragma("unroll") for (int k = 0; k < 2; ++k) \
        acc[ai][bj][m][n] = __builtin_amdgcn_mfma_f32_16x16x32_bf16(Bt[n][k], At[m][k], acc[ai][bj][m][n], 0, 0, 0); __builtin_amdgcn_s_setprio(0); } while (0)
#define PG8_WAIT_V(n) asm volatile("s_waitcnt vmcnt(" #n ")" ::: "memory")
#define PG8_WAIT_L(n) asm volatile("s_waitcnt lgkmcnt(" #n ")" ::: "memory")
#define PG8_BAR __builtin_amdgcn_s_barrier()
#define PG8_SCHED __builtin_amdgcn_sched_barrier(0)
    Unit cur, nxt; int ui = 0;
    if (!S.next(0, cur)) return;
    f32x4 acc[2][2][4][2];
#pragma unroll
    for (int a = 0; a < 2; ++a)
#pragma unroll
        for (int b = 0; b < 2; ++b)
#pragma unroll
            for (int m = 0; m < 4; ++m)
#pragma unroll
                for (int n = 0; n < 2; ++n) acc[a][b][m][n] = (f32x4){0.f, 0.f, 0.f, 0.f};
    bf16x8 At[4][2], B0[2][2], B1[2][2];
    const char* cA = (const char*)g.A + (size_t)cur.pm * tstep; const char* cB = (const char*)g.Bt + (size_t)cur.pn * tstep;
    S.a_ready(cur);
    if constexpr (SP2) {
        PG8_STAGE(PG8_SB(0, 0), cB, voffB); PG8_STAGE(PG8_SB(0, 1), cB + hstep, voffB); PG8_STAGE(PG8_SA(0, 0), cA, voffA); PG8_STAGE(PG8_SA(0, 1), cA + hstep, voffA);
        if (wr == 1) PG8_BAR;
        PG8_WAIT_V(2); PG8_BAR;
        PG8_STAGE(PG8_SB(1, 0), cB + kstep, voffB); PG8_STAGE(PG8_SA(1, 0), cA + kstep, voffA); PG8_STAGE(PG8_SB(1, 1), cB + hstep + kstep, voffB);
        PG8_WAIT_V(6); PG8_BAR;
    } else {
        PG8_STAGE(PG8_SB(0, 0), cB, voffB); PG8_STAGE(PG8_SA(0, 0), cA, voffA); PG8_STAGE(PG8_SB(0, 1), cB + hstep, voffB); PG8_STAGE(PG8_SA(0, 1), cA + hstep, voffA);
        if (wr == 1) PG8_BAR;
        PG8_WAIT_V(4); PG8_BAR;
        PG8_STAGE(PG8_SB(1, 0), cB + kstep, voffB); PG8_STAGE(PG8_SA(1, 0), cA + kstep, voffA); PG8_STAGE(PG8_SB(1, 1), cB + hstep + kstep, voffB);
        PG8_WAIT_V(6); PG8_BAR;
    }
    for (;;) {
        const bool has_next = S.next(ui + 1, nxt);
        const char* nA = has_next ? (const char*)g.A + (size_t)nxt.pm * tstep : cA; const char* nB = has_next ? (const char*)g.Bt + (size_t)nxt.pn * tstep : cB;
        for (int t = 0; t < nt; t += 2) {
            const bool last = (t == nt - 2);
            const char* a1 = cA + (size_t)(t + 1) * kstep;
            const char* a2 = last ? nA : cA + (size_t)(t + 2) * kstep; const char* b2 = last ? nB : cB + (size_t)(t + 2) * kstep;
            const char* a3 = a2 + kstep; const char* b3 = b2 + kstep;
            if (last && has_next) S.a_ready(nxt);
            if constexpr (SP2) {
            PG8_LDB(B0, 0, 0); PG8_LDB(B1, 0, 1); PG8_SCHED; PG8_LDA(At, 0, 0); PG8_STAGE(PG8_SA(1, 1), a1 + hstep, voffA);
            PG8_WAIT_V(8); PG8_WAIT_L(0); PG8_BAR; PG8_MMA(0, 0, At, B0); PG8_MMA(0, 1, At, B1); PG8_BAR; PG8_SCHED;
            PG8_LDA(At, 0, 1); PG8_STAGE(PG8_SB(0, 0), b2, voffB); PG8_STAGE(PG8_SB(0, 1), b2 + hstep, voffB); PG8_STAGE(PG8_SA(0, 0), a2, voffA);
            PG8_WAIT_V(8); PG8_WAIT_L(0); PG8_BAR; PG8_MMA(1, 0, At, B0); PG8_MMA(1, 1, At, B1); PG8_BAR; PG8_SCHED;
            PG8_LDB(B0, 1, 0); PG8_LDB(B1, 1, 1); PG8_SCHED; PG8_LDA(At, 1, 0); PG8_STAGE(PG8_SA(0, 1), a2 + hstep, voffA);
            PG8_WAIT_V(8); PG8_WAIT_L(0); PG8_BAR; PG8_MMA(0, 0, At, B0); PG8_MMA(0, 1, At, B1); PG8_BAR; PG8_SCHED;
            PG8_LDA(At, 1, 1); PG8_STAGE(PG8_SB(1, 0), b3, voffB); PG8_STAGE(PG8_SB(1, 1), b3 + hstep, voffB); PG8_STAGE(PG8_SA(1, 0), a3, voffA);
            PG8_WAIT_V(8); PG8_WAIT_L(0); PG8_BAR; PG8_MMA(1, 0, At, B0); PG8_MMA(1, 1, At, B1); PG8_BAR; PG8_SCHED;
            } else {
            PG8_LDB(B0, 0, 0); PG8_SCHED; PG8_LDA(At, 0, 0); PG8_STAGE(PG8_SA(1, 1), a1 + hstep, voffA);
            PG8_WAIT_L(8); PG8_BAR; PG8_WAIT_L(0); PG8_MMA(0, 0, At, B0); PG8_BAR; PG8_SCHED;
            PG8_LDB(B1, 0, 1); PG8_STAGE(PG8_SB(0, 0), b2, voffB);
            PG8_BAR; PG8_WAIT_L(0); PG8_MMA(0, 1, At, B1); PG8_BAR;
            PG8_LDA(At, 0, 1); PG8_STAGE(PG8_SA(0, 0), a2, voffA);
            PG8_BAR; PG8_WAIT_L(0); PG8_MMA(1, 0, At, B0); PG8_BAR; PG8_SCHED;
            PG8_STAGE(PG8_SB(0, 1), b2 + hstep, voffB);
            PG8_WAIT_V(6); PG8_BAR; PG8_MMA(1, 1, At, B1); PG8_BAR;
            PG8_LDB(B0, 1, 0); PG8_SCHED; PG8_LDA(At, 1, 0); PG8_STAGE(PG8_SA(0, 1), a2 + hstep, voffA);
            PG8_WAIT_L(8); PG8_BAR; PG8_WAIT_L(0); PG8_MMA(0, 0, At, B0); PG8_BAR; PG8_SCHED;
            PG8_LDB(B1, 1, 1); PG8_STAGE(PG8_SB(1, 0), b3, voffB);
            PG8_BAR; PG8_WAIT_L(0); PG8_MMA(0, 1, At, B1); PG8_BAR;
            PG8_LDA(At, 1, 1); PG8_STAGE(PG8_SA(1, 0), a3, voffA);
            PG8_BAR; PG8_WAIT_L(0); PG8_MMA(1, 0, At, B0); PG8_BAR; PG8_SCHED;
            PG8_STAGE(PG8_SB(1, 1), b3 + hstep, voffB);
            PG8_WAIT_V(6); PG8_BAR; PG8_MMA(1, 1, At, B1); PG8_BAR;
            }
        }
        if constexpr (ALIGN_EPI) { if (wr == 0) PG8_BAR; }
        if constexpr (!Epi::AFTER_DRAIN) { E(acc, cur, wr, wc, fr, fq); S.done(cur); }
        if (!has_next) break;
#pragma unroll
        for (int a = 0; a < 2; ++a)
#pragma unroll
            for (int b = 0; b < 2; ++b)
#pragma unroll
                for (int m = 0; m < 4; ++m)
#pragma unroll
                    for (int n = 0; n < 2; ++n) acc[a][b][m][n] = (f32x4){0.f, 0.f, 0.f, 0.f};
        cur = nxt; cA = nA; cB = nB; ++ui;
        if constexpr (ALIGN_EPI) { if (wr == 1) PG8_BAR; }
    }
    PG8_WAIT_V(0);
    if constexpr (!ALIGN_EPI) { if (wr == 0) PG8_BAR; }
    PG8_BAR;
    if constexpr (Epi::AFTER_DRAIN) { E.fused(acc, cur, wr, wc, fr, fq, lds, wid, lane); S.done(cur); }
#undef PG8_SA
#undef PG8_SB
#undef PG8_STAGE
#undef PG8_LDA
#undef PG8_LDB
#undef PG8_MMA
#undef PG8_WAIT_V
#undef PG8_WAIT_L
#undef PG8_BAR
#undef PG8_SCHED
}
}
#define XB_TMO      128
#define XB_XCNT(j)  (256  + 64 * (j))
#define XB_XSUB(j)  (1280 + 64 * (j))
#define XB_XGEN(j)  (2304 + 64 * (j))
#define XB_TOP      3328
#define XB_TOPGEN   3392
#define XCD_BAR_WORDS 3456
#define XB_SPIN_CAP (1u << 18)

__device__ __forceinline__ unsigned xb_ld(unsigned* p)              { return __hip_atomic_load(p, __ATOMIC_RELAXED, __HIP_MEMORY_SCOPE_AGENT); }
__device__ __forceinline__ unsigned xb_add(unsigned* p, unsigned v) { return __hip_atomic_fetch_add(p, v, __ATOMIC_RELAXED, __HIP_MEMORY_SCOPE_AGENT); }
__device__ __forceinline__ unsigned xb_xcc_id() { return (unsigned)__builtin_amdgcn_s_getreg((3 << 11) | 20) & 0xFu; }
#define XB_SPIN(cond, bar) do { unsigned _sp = 0; while (cond) { __builtin_amdgcn_s_sleep(1); \
    if ((++_sp & 255u) == 0u) { if (xb_ld(&(bar)[XB_TMO])) break; if (_sp > XB_SPIN_CAP) { atomicAdd(&(bar)[XB_TMO], 1u); break; } } } } while (0)

struct XcdBarrier {
    unsigned* bar; unsigned x;
    volatile LAS unsigned* st;
};

__device__ __forceinline__ XcdBarrier xcd_barrier_post(unsigned* bar, volatile LAS unsigned* st) {
    XcdBarrier b; b.bar = bar; b.x = xb_xcc_id(); b.st = st;
    if (threadIdx.x == 0) (void)xb_add(&bar[XB_XCNT(b.x)], 1u);
    return b;
}
__device__ __forceinline__ void xcd_barrier_complete(unsigned* bar, unsigned x, unsigned& nloc, unsigned& nx) {
    const unsigned G = gridDim.x * gridDim.y * gridDim.z;
    unsigned sum, cnt, mine, sp = 0u;
    for (;;) {
        sum = 0u; cnt = 0u; mine = 0u;
#pragma unroll
        for (unsigned j = 0; j < 16; ++j) { const unsigned c = xb_ld(&bar[XB_XCNT(j)]); sum += c; cnt += (c > 0u) ? 1u : 0u; mine = (j == x) ? c : mine; }
        if (sum == G) break;
        __builtin_amdgcn_s_sleep(1);
        if ((++sp & 255u) == 0u) { if (xb_ld(&bar[XB_TMO])) break; if (sp > XB_SPIN_CAP) { atomicAdd(&bar[XB_TMO], 1u); break; } }
    }
    nloc = mine > 0u ? mine : 1u; nx = cnt > 0u ? cnt : 1u;
}

__device__ __forceinline__ void xcd_barrier(const XcdBarrier& b) {
    asm volatile("s_waitcnt vmcnt(0)" ::: "memory");
    __syncthreads();
    if (threadIdx.x == 0) {
        unsigned* bar = b.bar;
        __builtin_amdgcn_s_waitcnt(0);
        unsigned nloc = b.st[0], nx = b.st[1];
        if (nloc == 0u) { xcd_barrier_complete(bar, b.x, nloc, nx); b.st[0] = nloc; b.st[1] = nx; }
        const unsigned old = xb_add(&bar[XB_XSUB(b.x)], 1u);
        const unsigned gen = old / nloc;
        if (old + 1u == (gen + 1u) * nloc) {
            __builtin_amdgcn_fence(__ATOMIC_RELEASE, "agent");
            asm volatile("s_waitcnt vmcnt(0)" ::: "memory");
            const unsigned og = xb_add(&bar[XB_TOP], 1u);
            const unsigned tg = og / nx;
            if (og + 1u == (tg + 1u) * nx) xb_add(&bar[XB_TOPGEN], 1u);
            else XB_SPIN(xb_ld(&bar[XB_TOPGEN]) == tg, bar);
            __builtin_amdgcn_fence(__ATOMIC_ACQUIRE, "agent");
            xb_add(&bar[XB_XGEN(b.x)], 1u);
            asm volatile("s_waitcnt vmcnt(0)" ::: "memory");
        } else {
            XB_SPIN(xb_ld(&bar[XB_XGEN(b.x)]) == gen, bar);
            __builtin_amdgcn_fence(__ATOMIC_ACQUIRE, "agent");
            asm volatile("s_waitcnt vmcnt(0)" ::: "memory");
        }
    }
    __syncthreads();
}
constexpr size_t MiB = 1u << 20;
constexpr size_t WS_CTL = 0, CTL_ZERO_BYTES = 1 * MiB;
constexpr size_t WS_WAB_IN = 1 * MiB, WS_WAB_OUT = 97 * MiB, WS_WGU0 = 129 * MiB, WS_WDN0 = 301 * MiB, WS_WCD_IN = 387 * MiB, WS_WCD_OUT = 467 * MiB, WS_WGU1 = 499 * MiB, WS_WDN1 = 671 * MiB;
constexpr size_t WS_WSMALL = 757 * MiB, WS_WRG = 758 * MiB;
constexpr size_t WS_U = 760 * MiB, WS_PROJ = 824 * MiB, WS_O = 1016 * MiB, WS_H = 1080 * MiB;
constexpr size_t WS_ACT = WS_PROJ;
constexpr size_t WS_SMALL32 = 1208 * MiB, WS_CF = 1209 * MiB, WS_QT = 1210 * MiB, WS_KDT = 1226 * MiB, WS_PM = 1242 * MiB, WS_GDEC = 1246 * MiB, WS_ORAW = 1247 * MiB, WS_SSQ = 1311 * MiB;
constexpr size_t WS_END = 1313 * MiB;
constexpr int CW_BAR = 4096, CW_SSQ = 131072;

constexpr int RING_BYTES = 131072;
constexpr int LDSCTL_OFF = RING_BYTES, MISC_OFF = LDSCTL_OFF + 320;
constexpr int LDS_BYTES = 147456;
constexpr int NWAVES = 8, NTHR = 512;

struct Params {
    const float *x, *norm_mix, *norm_ffn, *ffn_w_gate, *ffn_w_up, *ffn_w_down, *ab_w_in, *gla_w_gate_up, *gla_b_gate, *gla_norm, *fox_b_f, *ab_w_out,
                *cd_w_in, *rg_conv_w, *rg_conv_b, *rg_w_x, *rg_b_x, *rg_w_a, *rg_b_a, *rg_lambda, *cd_w_out, *final_norm;
    float* out; unsigned char* ws; int ph_lo, ph_hi;
};

__device__ __forceinline__ void tr_item(const float* W, int ldn, int K, int n_src0, bf16_t* WT, int row_dst0, LAS float* scr, int kb, int lane, const float* gain = nullptr) {
    const int k0 = 64 * kb, c = lane & 7;
    f32x4 g0 = {1.f, 1.f, 1.f, 1.f}, g1 = {1.f, 1.f, 1.f, 1.f};
    if (gain) { g0 = *(const f32x4*)(gain + k0 + 8 * c); g1 = *(const f32x4*)(gain + k0 + 8 * c + 4); }
#pragma unroll 8
    for (int i = 0; i < 32; ++i) { const int kk = 2 * i + (lane >> 5); scr[kk * 33 + (lane & 31)] = W[(size_t)(k0 + kk) * ldn + n_src0 + (lane & 31)]; }
    LDS_WAIT(); asm volatile("" ::: "memory");
#pragma unroll
    for (int j = 0; j < 4; ++j) { const int n = (lane >> 3) + 8 * j; const LAS float* s = scr + (8 * c) * 33 + n;
        u32x4 o; o.x = cvt_pk_bf16(s[0 * 33] * g0.x, s[1 * 33] * g0.y); o.y = cvt_pk_bf16(s[2 * 33] * g0.z, s[3 * 33] * g0.w); o.z = cvt_pk_bf16(s[4 * 33] * g1.x, s[5 * 33] * g1.y); o.w = cvt_pk_bf16(s[6 * 33] * g1.z, s[7 * 33] * g1.w);
        *(u32x4*)(WT + (size_t)(row_dst0 + n) * K + k0 + 8 * c) = o; }
    LDS_WAIT(); asm volatile("" ::: "memory");
}
#define TR_JOB(W_, ldn_, K_, nsrc0_, ncols_, WT_, rdst0_, gain_) { constexpr int nnb_ = (ncols_) / 32, nit_ = ((K_) / 64) * nnb_; \
    if (r < nit_) { const int kb_ = r / nnb_, nb_ = r % nnb_; tr_item((W_), (ldn_), (K_), (nsrc0_) + 32 * nb_, (WT_), (rdst0_) + 32 * nb_, scr, kb_, lane, (gain_)); continue; } r -= nit_; }
#define TR_JOB_GU(W_, WT_, off_, gain_) { constexpr int nnb_ = DFF / 32, nit_ = (DM / 64) * nnb_; \
    if (r < nit_) { const int kb_ = r / nnb_, nb_ = r % nnb_, c0_ = 32 * nb_; tr_item((W_), DFF, DM, c0_, (WT_), 256 * (c0_ / 128) + (c0_ % 128) + (off_), scr, kb_, lane, (gain_)); continue; } r -= nit_; }

__device__ __forceinline__ void rms_row_bf16(const float* xrow, const float* g, bf16_t* orow, int lane) {
    const f32x4* xr = (const f32x4*)xrow + lane; const f32x4* gr = (const f32x4*)g + lane;
    f32x4 v[16]; float s = 0.f;
#pragma unroll
    for (int j = 0; j < 16; ++j) { v[j] = xr[64 * j]; s += (v[j].x * v[j].x + v[j].y * v[j].y) + (v[j].z * v[j].z + v[j].w * v[j].w); }
    const float rstd = 1.0f / sqrtf(wave_sum(s) * (1.0f / DM) + EPS);
    u32x2* o8 = (u32x2*)orow + lane;
#pragma unroll
    for (int j = 0; j < 16; ++j) { const f32x4 gg = gr[64 * j]; u32x2 w; w.x = cvt_pk_bf16(v[j].x * rstd * gg.x, v[j].y * rstd * gg.y); w.y = cvt_pk_bf16(v[j].z * rstd * gg.z, v[j].w * rstd * gg.w); o8[64 * j] = w; }
}
__device__ __forceinline__ void rms_row_f32(const float* xrow, const float* g, float* orow, int lane) {
    const f32x4* xr = (const f32x4*)xrow + lane; const f32x4* gr = (const f32x4*)g + lane;
    f32x4 v[16]; float s = 0.f;
#pragma unroll
    for (int j = 0; j < 16; ++j) { v[j] = xr[64 * j]; s += (v[j].x * v[j].x + v[j].y * v[j].y) + (v[j].z * v[j].z + v[j].w * v[j].w); }
    const float rstd = 1.0f / sqrtf(wave_sum(s) * (1.0f / DM) + EPS);
    f32x4* o = (f32x4*)orow + lane;
#pragma unroll
    for (int j = 0; j < 16; ++j) { const f32x4 gg = gr[64 * j]; o[64 * j] = v[j] * rstd * gg; }
}
__device__ __forceinline__ void phase_final_norm(const bf16_t* Hb, const unsigned long long* ssq, const float* g, float* out, int gw, int ngw, int lane) {
    for (int m = gw; m < MTOK; m += ngw) { const float rstd = 1.0f / sqrtf((float)ssq[m] * (1.0f / 16777216.0f) * (1.0f / DM) + EPS);
        const u32x4* xr = (const u32x4*)(Hb + (size_t)m * DM) + lane; f32x4* o = (f32x4*)(out + (size_t)m * DM); const f32x4* gr = (const f32x4*)g;
#pragma unroll
        for (int j = 0; j < 8; ++j) { const u32x4 r = xr[64 * j]; const int c4 = 2 * (64 * j + lane);
            const f32x4 g0 = gr[c4], g1 = gr[c4 + 1];
            o[c4] = (f32x4){bflo(r.x) * rstd * g0.x, bfhi(r.x) * rstd * g0.y, bflo(r.y) * rstd * g0.z, bfhi(r.y) * rstd * g0.w};
            o[c4 + 1] = (f32x4){bflo(r.z) * rstd * g1.x, bfhi(r.z) * rstd * g1.y, bflo(r.w) * rstd * g1.z, bfhi(r.w) * rstd * g1.w}; } }
}
__device__ __forceinline__ void phase_rms_bf16(const float* src, const float* g, bf16_t* dst, int gw, int ngw, int lane) {
    for (int m = gw; m < MTOK; m += ngw) rms_row_bf16(src + (size_t)m * DM, g, dst + (size_t)m * DM, lane);
}

__device__ __forceinline__ void phase_p0(const Params& p, LAS unsigned char* lds, int gw, int ngw, int wave, int lane) {
    unsigned char* ws = p.ws;
    LAS float* scr = (LAS float*)(lds + wave * 8704);
    bf16_t* WAB_IN = (bf16_t*)(ws + WS_WAB_IN); bf16_t* WAB_OUT = (bf16_t*)(ws + WS_WAB_OUT); bf16_t* WGU0 = (bf16_t*)(ws + WS_WGU0); bf16_t* WDN0 = (bf16_t*)(ws + WS_WDN0);
    bf16_t* WCD_IN = (bf16_t*)(ws + WS_WCD_IN); bf16_t* WCD_OUT = (bf16_t*)(ws + WS_WCD_OUT); bf16_t* WGU1 = (bf16_t*)(ws + WS_WGU1); bf16_t* WDN1 = (bf16_t*)(ws + WS_WDN1);
    bf16_t* WRG = (bf16_t*)(ws + WS_WRG);
    constexpr int I_AB = (DM / 64) * (6144 / 32), I_SQ = (DM / 64) * (DM / 32), I_CD = (DM / 64) * (CD_IN / 32), I_GU = (DM / 64) * (DFF / 32), I_DN = (DFF / 64) * (DM / 32), I_RG = 16 * (256 / 64) * (256 / 32);
    constexpr int NITEMS = 2 * I_AB + 2 * I_SQ + I_CD + 4 * I_GU + 2 * I_DN + I_RG;
    for (int it = gw; it < NITEMS; it += ngw) {
        int r = it;
        TR_JOB(p.ab_w_in, AB_IN, DM, 0, 6144, WAB_IN, 0, nullptr)
        TR_JOB(p.ab_w_in, AB_IN, DM, 6160, 6144, WAB_IN, 6144, nullptr)
        TR_JOB(p.ab_w_out, DM, DM, 0, DM, WAB_OUT, 0, nullptr)
        TR_JOB_GU(p.ffn_w_gate, WGU0, 0, p.norm_ffn)
        TR_JOB_GU(p.ffn_w_up, WGU0, 128, p.norm_ffn)
        TR_JOB(p.ffn_w_down, DM, DFF, 0, DM, WDN0, 0, nullptr)
        TR_JOB(p.cd_w_in, CD_IN, DM, 0, CD_IN, WCD_IN, 0, p.norm_mix + DM)
        TR_JOB(p.cd_w_out, DM, DM, 0, DM, WCD_OUT, 0, nullptr)
        TR_JOB_GU(p.ffn_w_gate + (size_t)DM * DFF, WGU1, 0, p.norm_ffn + DM)
        TR_JOB_GU(p.ffn_w_up + (size_t)DM * DFF, WGU1, 128, p.norm_ffn + DM)
        TR_JOB(p.ffn_w_down + (size_t)DFF * DM, DM, DFF, 0, DM, WDN1, 0, nullptr)
        {
            const int mat = r / 32, rr = r % 32, kb_ = rr / 8, nb_ = rr % 8;
            const float* W = (mat < 8 ? p.rg_w_x : p.rg_w_a) + (size_t)(mat & 7) * 65536;
            tr_item(W, 256, 256, 32 * nb_, WRG + (size_t)mat * 65536, 32 * nb_, scr, kb_, lane);
        }
    }
    { bf16_t* WS_ = (bf16_t*)(ws + WS_WSMALL);
      for (int i = gw * 64 + lane; i < 32 * DM; i += ngw * 64) { const int c = i & 31, k = i >> 5; const int sc = c < 16 ? 6144 + c : 12304 + (c - 16);
          WS_[(size_t)c * DM + k] = f2bf(p.ab_w_in[(size_t)k * AB_IN + sc]); } }
    phase_rms_bf16(p.x, p.norm_mix, (bf16_t*)(ws + WS_U), gw, ngw, lane);
}

__device__ __forceinline__ void phase_small32(const Params& p, LAS unsigned char* lds, int wave, int lane) {
    const bf16_t* U = (const bf16_t*)(p.ws + WS_U); const bf16_t* WS_ = (const bf16_t*)(p.ws + WS_WSMALL); float* S32 = (float*)(p.ws + WS_SMALL32);
    LAS float* red = (LAS float*)lds;
    const int h = lane >> 5, c = lane & 31;
    for (int unit = blockIdx.x; unit < MTOK / 32; unit += gridDim.x) {
        const int row0 = unit * 32, kbase = wave * 512;
        f32x16 acc; for (int i = 0; i < 16; ++i) acc[i] = 0.f;
        const bf16_t* ap = U + (size_t)(row0 + c) * DM + kbase + 8 * h; const bf16_t* bp = WS_ + (size_t)c * DM + kbase + 8 * h;
#pragma unroll 8
        for (int s = 0; s < 32; ++s) { const bf16x8 a = *(const bf16x8*)(ap + 16 * s), b = *(const bf16x8*)(bp + 16 * s); acc = MFMA32(a, b, acc); }
#pragma unroll
        for (int r = 0; r < 16; ++r) red[(wave * 32 + crow(r, h)) * 33 + c] = acc[r];
        __syncthreads();
        for (int i = threadIdx.x; i < 1024; i += NTHR) { const int t = i >> 5, cc = i & 31; float s = 0.f;
#pragma unroll
            for (int w = 0; w < 8; ++w) s += red[(w * 32 + t) * 33 + cc];
            S32[(size_t)(row0 + t) * 32 + cc] = s; }
        __syncthreads();
    }
}

__device__ __forceinline__ void phase_fox_cumsum(const Params& p, int gw, int ngw, int lane) {
    const float* S32 = (const float*)(p.ws + WS_SMALL32); float* CF = (float*)(p.ws + WS_CF);
    for (int u = gw; u < NB * 16; u += ngw) { const int b = u >> 4, hd = u & 15; const float bias = p.fox_b_f[hd];
        float v[32]; float run = 0.f;
#pragma unroll
        for (int i = 0; i < 32; ++i) { const int t = 32 * lane + i; run += log_sigmoid_acc(S32[(size_t)(b * SEQ + t) * 32 + 16 + hd] + bias); v[i] = run; }
        float incl = run;
#pragma unroll
        for (int o = 1; o < 64; o <<= 1) { const float t = __shfl_up(incl, o); if (lane >= o) incl += t; }
        const float off = incl - run;
#pragma unroll
        for (int i = 0; i < 32; ++i) CF[(size_t)u * SEQ + 32 * lane + i] = v[i] + off;
    }
}

constexpr int GP_PITCH = 528;
__device__ __forceinline__ void phase_gla_pre(const Params& p, LAS unsigned char* lds, int wave, int lane) {
    const unsigned char* ws = p.ws;
    const bf16_t* PROJ = (const bf16_t*)(ws + WS_PROJ); const float* S32 = (const float*)(ws + WS_SMALL32);
    bf16_t* QT = (bf16_t*)(ws + WS_QT); bf16_t* KDT = (bf16_t*)(ws + WS_KDT); bf16_t* PM = (bf16_t*)(ws + WS_PM); float* GDEC = (float*)(ws + WS_GDEC);
    LAS float* G = (LAS float*)lds;
    LAS float* TOT = (LAS float*)(lds + 4096);
    LAS unsigned char* QTl = lds + 8192;
    LAS unsigned char* KTl = lds + 8192 + 64 * GP_PITCH;
    const int tid = threadIdx.x, k = tid & 255, th = tid >> 8, h = lane >> 5;
    for (int unit = blockIdx.x; unit < NB * 4 * 32; unit += gridDim.x) {
        const int b = unit >> 7, hd = (unit >> 5) & 3, c = unit & 31, R0 = b * SEQ + 64 * c;
        for (int i = tid; i < 1024; i += NTHR) G[i] = S32[(size_t)(R0 + (i >> 4)) * 32 + (i & 15)];
        float w[16];
#pragma unroll
        for (int r = 0; r < 16; ++r) w[r] = p.gla_w_gate_up[r * 1024 + hd * 256 + k];
        const float bias = p.gla_b_gate[hd * 256 + k];
        __syncthreads();
        float bc[32]; float run = 0.f;
#pragma unroll
        for (int tt = 0; tt < 32; ++tt) { const LAS f32x4* g4 = (const LAS f32x4*)(G + (32 * th + tt) * 16); float xx = bias;
#pragma unroll
            for (int q4 = 0; q4 < 4; ++q4) { const f32x4 gv = g4[q4]; xx += gv.x * w[4 * q4] + gv.y * w[4 * q4 + 1] + gv.z * w[4 * q4 + 2] + gv.w * w[4 * q4 + 3]; }
            run += log_sigmoid_acc(xx) * (1.0f / 16.0f); bc[tt] = run; }
        TOT[th * 256 + k] = run;
        __syncthreads();
        const float t0 = TOT[k], t1 = TOT[256 + k], blast = t0 + t1, boff = th ? t0 : 0.f;
        if (th == 0) GDEC[(size_t)unit * 256 + k] = expf(blast);
        const bf16_t* qp = PROJ + (size_t)(R0 + 32 * th) * AB_MAIN + PJ_GQ + hd * 256 + k; const bf16_t* kp = PROJ + (size_t)(R0 + 32 * th) * AB_MAIN + PJ_GK + hd * 256 + k;
        bf16_t* qto = QT + (size_t)(R0 + 32 * th) * 1024 + hd * 256 + k;
        bf16_t* kdo = KDT + ((size_t)unit * 256 + k) * 64 + 32 * th;
#pragma unroll
        for (int t8 = 0; t8 < 4; ++t8) { float kd[8];
#pragma unroll
            for (int i = 0; i < 8; ++i) { const int tt = 8 * t8 + i; const float bb = bc[tt] + boff;
                const float qv = bf2f(qp[(size_t)tt * AB_MAIN]), kv = bf2f(kp[(size_t)tt * AB_MAIN]);
                const float qt = qv * 0.0625f * expf(bb), kt = kv * expf(-bb); kd[i] = kv * expf(blast - bb);
                const bf16_t qb = f2bf(qt);
                *(LAS bf16_t*)(QTl + (32 * th + tt) * GP_PITCH + 2 * k) = qb; *(LAS bf16_t*)(KTl + (32 * th + tt) * GP_PITCH + 2 * k) = f2bf(kt);
                qto[(size_t)tt * 1024] = qb; }
            u32x4 o; o.x = cvt_pk_bf16(kd[0], kd[1]); o.y = cvt_pk_bf16(kd[2], kd[3]); o.z = cvt_pk_bf16(kd[4], kd[5]); o.w = cvt_pk_bf16(kd[6], kd[7]);
            *(u32x4*)(kdo + 8 * t8) = o; }
        __syncthreads();
        if (wave < 4) { const int ti = wave & 1, si = wave >> 1;
            f32x16 acc; for (int i = 0; i < 16; ++i) acc[i] = 0.f;
            const LAS unsigned char* ap = QTl + (32 * ti + (lane & 31)) * GP_PITCH + 16 * h; const LAS unsigned char* bp = KTl + (32 * si + (lane & 31)) * GP_PITCH + 16 * h;
#pragma unroll
            for (int s = 0; s < 16; ++s) { const bf16x8 a = *(const LAS bf16x8*)(ap + 32 * s), bb = *(const LAS bf16x8*)(bp + 32 * s); acc = MFMA32(a, bb, acc); }
            const int sc = 32 * si + (lane & 31);
#pragma unroll
            for (int r = 0; r < 16; ++r) { const int t = 32 * ti + crow(r, h); PM[(size_t)unit * 4096 + t * 64 + sc] = f2bf(sc <= t ? acc[r] : 0.f); }
        }
        __syncthreads();
    }
}

constexpr int VT_PITCH = 144;
__device__ __forceinline__ void phase_gla_seq(const Params& p, LAS unsigned char* lds, int wave, int lane) {
    const unsigned char* ws = p.ws;
    const bf16_t* PROJ = (const bf16_t*)(ws + WS_PROJ); const bf16_t* QT = (const bf16_t*)(ws + WS_QT); const bf16_t* KDT = (const bf16_t*)(ws + WS_KDT); const bf16_t* PM = (const bf16_t*)(ws + WS_PM);
    const float* GDEC = (const float*)(ws + WS_GDEC); float* ORAW = (float*)(p.ws + WS_ORAW); float* SSQ = (float*)(p.ws + WS_SSQ);
    LAS float* RED = (LAS float*)lds;
    LAS unsigned char* VT = lds + 65536;
    const int tid = threadIdx.x, h = lane >> 5, l31 = lane & 31;
    for (int unit = blockIdx.x; unit < NB * 4 * 16; unit += gridDim.x) {
        const int b = unit >> 6, hd = (unit >> 4) & 3, vs = unit & 15, v0 = 32 * vs;
        f32x16 S; for (int i = 0; i < 16; ++i) S[i] = 0.f;
        for (int c = 0; c < 32; ++c) {
            const int R0 = b * SEQ + 64 * c, cu = (b * 4 + hd) * 32 + c;
            LAS unsigned char* vt = VT + (c & 1) * (32 * VT_PITCH);
            { const int s = tid >> 3, v4 = (tid & 7) * 4; const u32x2 raw = *(const u32x2*)(PROJ + (size_t)(R0 + s) * AB_MAIN + PJ_GV + hd * 512 + v0 + v4);
              *(LAS bf16_t*)(vt + (v4 + 0) * VT_PITCH + 2 * s) = (bf16_t)(raw.x & 0xffffu); *(LAS bf16_t*)(vt + (v4 + 1) * VT_PITCH + 2 * s) = (bf16_t)(raw.x >> 16);
              *(LAS bf16_t*)(vt + (v4 + 2) * VT_PITCH + 2 * s) = (bf16_t)(raw.y & 0xffffu); *(LAS bf16_t*)(vt + (v4 + 3) * VT_PITCH + 2 * s) = (bf16_t)(raw.y >> 16); }
            bf16x8 qa[2][2];
#pragma unroll
            for (int ti = 0; ti < 2; ++ti)
#pragma unroll
                for (int s2 = 0; s2 < 2; ++s2) { const bf16_t* q = QT + (size_t)(R0 + 32 * ti + l31) * 1024 + hd * 256 + 32 * wave + 16 * s2 + 4 * h;
                    const s16x4 lo = *(const s16x4*)q, hi = *(const s16x4*)(q + 8); qa[ti][s2] = cat4(lo, hi); }
            bf16x8 kda[4];
#pragma unroll
            for (int ss = 0; ss < 4; ++ss) kda[ss] = *(const bf16x8*)(KDT + ((size_t)cu * 256 + 32 * wave + l31) * 64 + 16 * ss + 8 * h);
            const int tip = wave & 1, ssp = wave >> 1;
            const bf16x8 pa = *(const bf16x8*)(PM + (size_t)cu * 4096 + (32 * tip + l31) * 64 + 16 * ssp + 8 * h);
            f32x4 gd[4];
#pragma unroll
            for (int g = 0; g < 4; ++g) gd[g] = *(const f32x4*)(GDEC + (size_t)cu * 256 + 32 * wave + 8 * g + 4 * h);
            __syncthreads();
            f32x16 oacc[2];
#pragma unroll
            for (int ti = 0; ti < 2; ++ti) for (int i = 0; i < 16; ++i) oacc[ti][i] = 0.f;
            const bf16x8 sb0 = pack8(S[0], S[1], S[2], S[3], S[4], S[5], S[6], S[7]), sb1 = pack8(S[8], S[9], S[10], S[11], S[12], S[13], S[14], S[15]);
#pragma unroll
            for (int ti = 0; ti < 2; ++ti) { oacc[ti] = MFMA32(qa[ti][0], sb0, oacc[ti]); oacc[ti] = MFMA32(qa[ti][1], sb1, oacc[ti]); }
            bf16x8 vb[4];
#pragma unroll
            for (int ss = 0; ss < 4; ++ss) vb[ss] = *(const LAS bf16x8*)(vt + l31 * VT_PITCH + 32 * ss + 16 * h);
            { const bf16x8 vbp = ssp == 0 ? vb[0] : ssp == 1 ? vb[1] : ssp == 2 ? vb[2] : vb[3];
              if (tip == 0) oacc[0] = MFMA32(pa, vbp, oacc[0]); else oacc[1] = MFMA32(pa, vbp, oacc[1]); }
#pragma unroll
            for (int r = 0; r < 16; ++r) S[r] *= gd[r >> 2][r & 3];
#pragma unroll
            for (int ss = 0; ss < 4; ++ss) S = MFMA32(kda[ss], vb[ss], S);
#pragma unroll
            for (int ti = 0; ti < 2; ++ti)
#pragma unroll
                for (int r = 0; r < 16; ++r) RED[(wave * 64 + 32 * ti + crow(r, h)) * 32 + l31] = oacc[ti][r];
            __syncthreads();
            { const int t = tid >> 3, v4 = (tid & 7) * 4; f32x4 o = {0.f, 0.f, 0.f, 0.f};
#pragma unroll
              for (int w = 0; w < 8; ++w) o += *(const LAS f32x4*)(RED + (w * 64 + t) * 32 + v4);
              *(f32x4*)(ORAW + (size_t)(R0 + t) * 2048 + hd * 512 + v0 + v4) = o;
              float q = (o.x * o.x + o.y * o.y) + (o.z * o.z + o.w * o.w);
              q += __shfl_xor(q, 1); q += __shfl_xor(q, 2); q += __shfl_xor(q, 4);
              if ((tid & 7) == 0) SSQ[(size_t)(R0 + t) * 64 + hd * 16 + vs] = q; }
        }
        __syncthreads();
    }
}

__device__ __forceinline__ void phase_gla_post(const Params& p, int gw, int ngw, int lane) {
    const bf16_t* PROJ = (const bf16_t*)(p.ws + WS_PROJ); const float* ORAW = (const float*)(p.ws + WS_ORAW); const float* SSQ = (const float*)(p.ws + WS_SSQ); bf16_t* O = (bf16_t*)(p.ws + WS_O);
    const f32x4 gn0 = *(const f32x4*)(p.gla_norm + 8 * lane), gn1 = *(const f32x4*)(p.gla_norm + 8 * lane + 4);
    for (int u = gw; u < MTOK * 4; u += ngw) { const int row = u >> 2, hd = u & 3;
        float ss = 0.f;
#pragma unroll
        for (int i = 0; i < 4; ++i) { const f32x4 s4 = *(const f32x4*)(SSQ + (size_t)row * 64 + hd * 16 + 4 * i); ss += (s4.x + s4.y) + (s4.z + s4.w); }
        const float rstd = 1.0f / sqrtf(ss * (1.0f / 512.0f) + EPS);
        const f32x4 o0 = *(const f32x4*)(ORAW + (size_t)row * 2048 + hd * 512 + 8 * lane), o1 = *(const f32x4*)(ORAW + (size_t)row * 2048 + hd * 512 + 8 * lane + 4);
        const u32x4 gr = *(const u32x4*)(PROJ + (size_t)row * AB_MAIN + PJ_GG + hd * 512 + 8 * lane);
        float g[8] = {bflo(gr.x), bfhi(gr.x), bflo(gr.y), bfhi(gr.y), bflo(gr.z), bfhi(gr.z), bflo(gr.w), bfhi(gr.w)};
        float o[8] = {o0.x * gn0.x, o0.y * gn0.y, o0.z * gn0.z, o0.w * gn0.w, o1.x * gn1.x, o1.y * gn1.y, o1.z * gn1.z, o1.w * gn1.w};
#pragma unroll
        for (int i = 0; i < 8; ++i) o[i] = o[i] * rstd * g[i] / (1.0f + __expf(-g[i]));
        u32x4 w; w.x = cvt_pk_bf16(o[0], o[1]); w.y = cvt_pk_bf16(o[2], o[3]); w.z = cvt_pk_bf16(o[4], o[5]); w.w = cvt_pk_bf16(o[6], o[7]);
        *(u32x4*)(O + (size_t)row * DM + hd * 512 + 8 * lane) = w; }
}

constexpr int AK_PITCH = 272, AV_PITCH = 320;
constexpr int AK_BYTES = 64 * AK_PITCH, AV_BYTES = 64 * AV_PITCH;
constexpr int A_KOFF = 0, A_VOFF = 2 * AK_BYTES, A_COFF = A_VOFF + 2 * AV_BYTES;
constexpr float ATT_SCALE = 0.08838834764831845f;
constexpr float LOG2E = 1.4426950408889634f;

struct AttnIO { const bf16_t* Q; const bf16_t* K; const bf16_t* V; int ld; bf16_t* O; int ldo; };

__device__ __forceinline__ void attn_stage_load(const AttnIO& io, size_t rowbase, int hd, int key0, u32x4 (&kr)[2], u32x4 (&vr)[2], int tid) {
#pragma unroll
    for (int i = 0; i < 2; ++i) { const int idx = tid + NTHR * i, r = idx >> 4, ch = idx & 15; const size_t off = (rowbase + key0 + r) * (size_t)io.ld + hd * 128 + ch * 8;
        kr[i] = *(const u32x4*)(io.K + off); vr[i] = *(const u32x4*)(io.V + off); }
}
__device__ __forceinline__ void attn_stage_store(LAS unsigned char* lds, int buf, const u32x4 (&kr)[2], const u32x4 (&vr)[2], int tid) {
#pragma unroll
    for (int i = 0; i < 2; ++i) { const int idx = tid + NTHR * i, r = idx >> 4, ch = idx & 15;
        *(LAS u32x4*)(lds + A_KOFF + buf * AK_BYTES + r * AK_PITCH + ch * 16) = kr[i]; *(LAS u32x4*)(lds + A_VOFF + buf * AV_BYTES + r * AV_PITCH + ch * 16) = vr[i]; }
}
__device__ __forceinline__ void attn_qk(LAS unsigned char* lds, int buf, const bf16x8 (&qf)[8], f32x16& s0, f32x16& s1, int lane) {
    const LAS unsigned char* kp = lds + A_KOFF + buf * AK_BYTES + (lane & 31) * AK_PITCH + (lane >> 5) * 16;
    for (int i = 0; i < 16; ++i) { s0[i] = 0.f; s1[i] = 0.f; }
#pragma unroll
    for (int s = 0; s < 8; ++s) { const bf16x8 a0 = *(const LAS bf16x8*)(kp + 32 * s), a1 = *(const LAS bf16x8*)(kp + 32 * AK_PITCH + 32 * s);
        s0 = MFMA32(a0, qf[s], s0); s1 = MFMA32(a1, qf[s], s1); }
}
__device__ __forceinline__ void attn_pv(LAS unsigned char* lds, int buf, const f32x16& p0, const f32x16& p1, f32x16 (&o)[4], int lane) {
    const lds_cptr vp = (lds_cptr)(lds + A_VOFF + buf * AV_BYTES + (4 * (lane >> 5) + ((lane & 15) >> 2)) * AV_PITCH + (((lane >> 4) & 1) * 16 + (lane & 3) * 4) * 2);
    const bf16x8 pf00 = pack8(p0[0], p0[1], p0[2], p0[3], p0[4], p0[5], p0[6], p0[7]), pf01 = pack8(p0[8], p0[9], p0[10], p0[11], p0[12], p0[13], p0[14], p0[15]);
    const bf16x8 pf10 = pack8(p1[0], p1[1], p1[2], p1[3], p1[4], p1[5], p1[6], p1[7]), pf11 = pack8(p1[8], p1[9], p1[10], p1[11], p1[12], p1[13], p1[14], p1[15]);
#pragma unroll
    for (int dt = 0; dt < 4; ++dt) {
        const bf16x8 a00 = cat4(vtr(vp + (0) * AV_PITCH + dt * 64), vtr(vp + (8) * AV_PITCH + dt * 64));
        const bf16x8 a01 = cat4(vtr(vp + (16) * AV_PITCH + dt * 64), vtr(vp + (24) * AV_PITCH + dt * 64));
        const bf16x8 a10 = cat4(vtr(vp + (32) * AV_PITCH + dt * 64), vtr(vp + (40) * AV_PITCH + dt * 64));
        const bf16x8 a11 = cat4(vtr(vp + (48) * AV_PITCH + dt * 64), vtr(vp + (56) * AV_PITCH + dt * 64));
        o[dt] = MFMA32(a00, pf00, o[dt]); o[dt] = MFMA32(a01, pf01, o[dt]); o[dt] = MFMA32(a10, pf10, o[dt]); o[dt] = MFMA32(a11, pf11, o[dt]);
    }
}
__device__ __forceinline__ void attn_store_o(const AttnIO& io, size_t row, int hd, const f32x16 (&o)[4], float scl, int lane) {
    bf16_t* op = io.O + row * (size_t)io.ldo + hd * 128 + 4 * (lane >> 5);
#pragma unroll
    for (int dt = 0; dt < 4; ++dt)
#pragma unroll
        for (int g = 0; g < 4; ++g) { u32x2 w; w.x = cvt_pk_bf16(o[dt][4 * g] * scl, o[dt][4 * g + 1] * scl); w.y = cvt_pk_bf16(o[dt][4 * g + 2] * scl, o[dt][4 * g + 3] * scl);
            *(u32x2*)(op + 32 * dt + 8 * g) = w; }
}

__device__ __forceinline__ void fox_unit(const AttnIO& io, const float* CF, LAS unsigned char* lds, int b, int hd, int qb, int wave, int lane) {
    const int tid = threadIdx.x, h = lane >> 5, l31 = lane & 31;
    const size_t rowbase = (size_t)b * SEQ; const int qpos = 256 * qb + 32 * wave + l31;
    const float* cf = CF + (size_t)(b * 16 + hd) * SEQ;
    bf16x8 qf[8];
#pragma unroll
    for (int s = 0; s < 8; ++s) qf[s] = *(const bf16x8*)(io.Q + (rowbase + qpos) * (size_t)io.ld + hd * 128 + 16 * s + 8 * h);
    const float cq = cf[qpos] * LOG2E;
    f32x16 o[4];
#pragma unroll
    for (int dt = 0; dt < 4; ++dt) for (int i = 0; i < 16; ++i) o[dt][i] = 0.f;
    float m = -1e30f, l = 0.f;
    const int ntiles = 4 * qb + 4;
    u32x4 kr[2], vr[2];
    LAS float* cks = (LAS float*)(lds + A_COFF);
    attn_stage_load(io, rowbase, hd, 0, kr, vr, tid);
    attn_stage_store(lds, 0, kr, vr, tid);
    if (tid < 64) cks[tid] = cf[tid] * LOG2E;
    __syncthreads();
    for (int j = 0; j < ntiles; ++j) {
        const int buf = j & 1; const bool more = j + 1 < ntiles;
        float cnext = 0.f;
        if (more) { attn_stage_load(io, rowbase, hd, 64 * (j + 1), kr, vr, tid); if (tid < 64) cnext = cf[64 * (j + 1) + tid] * LOG2E; }
        if (64 * j <= 256 * qb + 32 * wave + 31) {
            f32x16 s0, s1; attn_qk(lds, buf, qf, s0, s1, lane);
            const LAS float* ck = cks + buf * 64;
            float mx = -__builtin_inff();
#pragma unroll
            for (int g = 0; g < 4; ++g) { const f32x4 c0 = *(const LAS f32x4*)(ck + 8 * g + 4 * h), c1 = *(const LAS f32x4*)(ck + 32 + 8 * g + 4 * h);
#pragma unroll
                for (int i = 0; i < 4; ++i) { const int r = 4 * g + i, key = 64 * j + 8 * g + 4 * h + i;
                    float y0 = s0[r] * (ATT_SCALE * LOG2E) + (cq - c0[i]), y1 = s1[r] * (ATT_SCALE * LOG2E) + (cq - c1[i]);
                    y0 = key <= qpos ? y0 : -__builtin_inff(); y1 = key + 32 <= qpos ? y1 : -__builtin_inff();
                    s0[r] = y0; s1[r] = y1; mx = fmaxf(mx, fmaxf(y0, y1)); } }
            mx = fmaxf(mx, __shfl_xor(mx, 32));
            const float mn = fmaxf(m, mx), alpha = __builtin_amdgcn_exp2f(m - mn); m = mn;
            float ps = 0.f;
#pragma unroll
            for (int r = 0; r < 16; ++r) { s0[r] = __builtin_amdgcn_exp2f(s0[r] - mn); s1[r] = __builtin_amdgcn_exp2f(s1[r] - mn); ps += s0[r] + s1[r]; }
            l = l * alpha + ps;
#pragma unroll
            for (int dt = 0; dt < 4; ++dt) for (int i = 0; i < 16; ++i) o[dt][i] *= alpha;
            attn_pv(lds, buf, s0, s1, o, lane);
        }
        if (more) { attn_stage_store(lds, buf ^ 1, kr, vr, tid); if (tid < 64) cks[(buf ^ 1) * 64 + tid] = cnext; }
        __syncthreads();
    }
    l += __shfl_xor(l, 32);
    attn_store_o(io, rowbase + qpos, hd, o, 1.0f / l, lane);
}

__device__ __forceinline__ void sb_subtile(f32x16& s, int keybase, int qpos, int h, float& R) {
    float lb[16], l1[16];
#pragma unroll
    for (int r = 0; r < 16; ++r) { const float z = s[r] * ATT_SCALE; const int key = keybase + crow(r, h);
        const float lp = __logf(1.0f + __expf(-fabsf(z)));
        lb[r] = fminf(z, 0.f) - lp; l1[r] = key < qpos ? lb[r] - z : 0.f; }
    float T[4], Tp[4];
#pragma unroll
    for (int g = 0; g < 4; ++g) { T[g] = (l1[4 * g] + l1[4 * g + 1]) + (l1[4 * g + 2] + l1[4 * g + 3]); Tp[g] = __shfl_xor(T[g], 32); }
    float run = R;
#pragma unroll
    for (int g = 3; g >= 0; --g) {
        const float off = h ? run : run + Tp[g];
        const float sf2 = l1[4 * g + 3], sf1 = sf2 + l1[4 * g + 2], sf0 = sf1 + l1[4 * g + 1];
        const float e3 = lb[4 * g + 3] + off, e2 = lb[4 * g + 2] + off + sf2, e1 = lb[4 * g + 1] + off + sf1, e0 = lb[4 * g] + off + sf0;
        const int key = keybase + 8 * g + 4 * h;
        s[4 * g + 3] = key + 3 < qpos ? __builtin_amdgcn_exp2f(e3 * LOG2E) : 0.f; s[4 * g + 2] = key + 2 < qpos ? __builtin_amdgcn_exp2f(e2 * LOG2E) : 0.f;
        s[4 * g + 1] = key + 1 < qpos ? __builtin_amdgcn_exp2f(e1 * LOG2E) : 0.f; s[4 * g] = key < qpos ? __builtin_amdgcn_exp2f(e0 * LOG2E) : 0.f;
        run += T[g] + Tp[g];
    }
    R = run;
}
__device__ __forceinline__ void sb_unit(const AttnIO& io, LAS unsigned char* lds, int b, int hd, int qb, int wave, int lane) {
    const int tid = threadIdx.x, h = lane >> 5, l31 = lane & 31;
    const size_t rowbase = (size_t)b * SEQ; const int qpos = 256 * qb + 32 * wave + l31;
    bf16x8 qf[8];
#pragma unroll
    for (int s = 0; s < 8; ++s) qf[s] = *(const bf16x8*)(io.Q + (rowbase + qpos) * (size_t)io.ld + hd * 128 + 16 * s + 8 * h);
    f32x16 o[4];
#pragma unroll
    for (int dt = 0; dt < 4; ++dt) for (int i = 0; i < 16; ++i) o[dt][i] = 0.f;
    float R = 0.f;
    const int ntiles = 4 * qb + 4;
    u32x4 kr[2], vr[2];
    attn_stage_load(io, rowbase, hd, 64 * (ntiles - 1), kr, vr, tid);
    attn_stage_store(lds, 0, kr, vr, tid);
    __syncthreads();
    for (int jj = 0; jj < ntiles; ++jj) {
        const int j = ntiles - 1 - jj, buf = jj & 1; const bool more = jj + 1 < ntiles;
        if (more) attn_stage_load(io, rowbase, hd, 64 * (j - 1), kr, vr, tid);
        if (64 * j < 256 * qb + 32 * wave + 31) {
            f32x16 s0, s1; attn_qk(lds, buf, qf, s0, s1, lane);
            sb_subtile(s1, 64 * j + 32, qpos, h, R);
            sb_subtile(s0, 64 * j, qpos, h, R);
            attn_pv(lds, buf, s0, s1, o, lane);
        }
        if (more) attn_stage_store(lds, buf ^ 1, kr, vr, tid);
        __syncthreads();
    }
    attn_store_o(io, rowbase + qpos, hd, o, 1.0f, lane);
}

constexpr int RG_XPITCH = 528;
constexpr int RG_XC = 0, RG_GX = 128 * RG_XPITCH, RG_GA = RG_GX + 128 * 32 * 4, RG_HB = RG_GA + 128 * 32 * 4, RG_CW = RG_HB + 128 * 32 * 4, RG_SPL = RG_CW + 5 * 256 * 4;
__device__ __forceinline__ float gelu_tanh(float x) { const float u = 0.7978845608028654f * (x + 0.044715f * x * x * x); const float e = __expf(2.0f * u); const float th = 1.0f - 2.0f * __builtin_amdgcn_rcpf(e + 1.0f); return 0.5f * x * (1.0f + th); }
__device__ __forceinline__ void rg_load_raw(const bf16_t* PROJ, size_t rowb, int T0, int tg, int cb, int cc, u32x4 (&raw)[11]) {
    const bf16_t* base = PROJ + (rowb + T0 + 8 * tg) * CD_IN + PJ_RX + cb + 8 * cc;
#pragma unroll
    for (int i = 0; i < 11; ++i) { const int t = T0 + 8 * tg - 3 + i; if (t >= 0) raw[i] = *(const u32x4*)(base + (ptrdiff_t)(i - 3) * CD_IN); else raw[i] = (u32x4){0u, 0u, 0u, 0u}; }
}
__device__ __forceinline__ void phase_rg(const Params& p, LAS unsigned char* lds, int wave, int lane) {
    const unsigned char* ws = p.ws;
    const bf16_t* PROJ = (const bf16_t*)(ws + WS_PROJ); const bf16_t* WRG = (const bf16_t*)(ws + WS_WRG); bf16_t* O = (bf16_t*)(p.ws + WS_O);
    const int tid = threadIdx.x, h = lane >> 5, l31 = lane & 31;
    LAS float* GX = (LAS float*)(lds + RG_GX); LAS float* GA = (LAS float*)(lds + RG_GA); LAS float* HB = (LAS float*)(lds + RG_HB); LAS float* CW = (LAS float*)(lds + RG_CW); LAS float* SPL = (LAS float*)(lds + RG_SPL);
    const int cc = tid & 31, tg = tid >> 5;
    const int et = tid >> 2, ej = (tid & 3) * 8;
    for (int unit = blockIdx.x; unit < NB * 8 * 8; unit += gridDim.x) {
        const int b = unit >> 6, g = (unit >> 3) & 7, js = unit & 7, cb = 256 * g, c0 = cb + 32 * js;
        const size_t rowb = (size_t)b * SEQ;
        const int gate = wave >> 2, ti = wave & 3;
        bf16x8 wf[16];
        { const bf16_t* wp = WRG + ((size_t)(gate * 8 + g) * 256 + 32 * js + l31) * 256 + 8 * h;
#pragma unroll
          for (int s = 0; s < 16; ++s) wf[s] = *(const bf16x8*)(wp + 16 * s); }
        const float gbias = (gate ? p.rg_b_a : p.rg_b_x)[c0 + l31];
        for (int i = tid; i < 5 * 256; i += NTHR) { const int j = i >> 8, c = i & 255; CW[i] = j < 4 ? p.rg_conv_w[j * 2048 + cb + c] : p.rg_conv_b[cb + c]; }
        if (tid < 32) { const float lam = p.rg_lambda[c0 + tid]; SPL[tid] = -8.0f * LOG2E * (fmaxf(-lam, 0.f) + log1pf(expf(-fabsf(lam)))); }
        u32x4 raw[11];
        rg_load_raw(PROJ, rowb, 0, tg, cb, cc, raw);
        float hstate = 0.f;
        __syncthreads();
        for (int tt = 0; tt < SEQ / 128; ++tt) {
            const int T0 = 128 * tt; const size_t R0 = rowb + T0;
            const u32x4 ryraw = *(const u32x4*)(PROJ + (R0 + et) * CD_IN + PJ_RY + c0 + ej);
            { float w0[8], w1[8], w2[8], w3[8], bb[8];
#pragma unroll
              for (int q = 0; q < 2; ++q) { const f32x4 a0 = *(const LAS f32x4*)(CW + 0 * 256 + 8 * cc + 4 * q), a1 = *(const LAS f32x4*)(CW + 1 * 256 + 8 * cc + 4 * q), a2 = *(const LAS f32x4*)(CW + 2 * 256 + 8 * cc + 4 * q),
                                                          a3 = *(const LAS f32x4*)(CW + 3 * 256 + 8 * cc + 4 * q), a4 = *(const LAS f32x4*)(CW + 4 * 256 + 8 * cc + 4 * q);
#pragma unroll
                  for (int e = 0; e < 4; ++e) { w0[4 * q + e] = a0[e]; w1[4 * q + e] = a1[e]; w2[4 * q + e] = a2[e]; w3[4 * q + e] = a3[e]; bb[4 * q + e] = a4[e]; } }
#pragma unroll
              for (int i = 0; i < 8; ++i) { float xo[8];
#pragma unroll
                  for (int e2 = 0; e2 < 4; ++e2) { const unsigned r0 = raw[i][e2], r1 = raw[i + 1][e2], r2 = raw[i + 2][e2], r3 = raw[i + 3][e2];
                      xo[2 * e2] = bb[2 * e2] + w0[2 * e2] * bflo(r0) + w1[2 * e2] * bflo(r1) + w2[2 * e2] * bflo(r2) + w3[2 * e2] * bflo(r3);
                      xo[2 * e2 + 1] = bb[2 * e2 + 1] + w0[2 * e2 + 1] * bfhi(r0) + w1[2 * e2 + 1] * bfhi(r1) + w2[2 * e2 + 1] * bfhi(r2) + w3[2 * e2 + 1] * bfhi(r3); }
                  u32x4 o; o.x = cvt_pk_bf16(xo[0], xo[1]); o.y = cvt_pk_bf16(xo[2], xo[3]); o.z = cvt_pk_bf16(xo[4], xo[5]); o.w = cvt_pk_bf16(xo[6], xo[7]);
                  *(LAS u32x4*)(lds + RG_XC + (8 * tg + i) * RG_XPITCH + 16 * cc) = o; } }
            if (tt + 1 < SEQ / 128) rg_load_raw(PROJ, rowb, T0 + 128, tg, cb, cc, raw);
            __syncthreads();
            { f32x16 acc; for (int i = 0; i < 16; ++i) acc[i] = 0.f;
              const LAS unsigned char* ap = lds + RG_XC + (32 * ti + l31) * RG_XPITCH + 16 * h;
#pragma unroll
              for (int s = 0; s < 16; ++s) { const bf16x8 a = *(const LAS bf16x8*)(ap + 32 * s); acc = MFMA32(a, wf[s], acc); }
              LAS float* gout = gate ? GA : GX;
#pragma unroll
              for (int r = 0; r < 16; ++r) { const float v = acc[r] + gbias; gout[(32 * ti + crow(r, h)) * 32 + l31] = __builtin_amdgcn_rcpf(1.0f + __expf(-v)); } }
            __syncthreads();
            { const u32x4 xr = *(const LAS u32x4*)(lds + RG_XC + et * RG_XPITCH + 2 * (32 * js + ej));
              const float xc[8] = {bflo(xr.x), bfhi(xr.x), bflo(xr.y), bfhi(xr.y), bflo(xr.z), bfhi(xr.z), bflo(xr.w), bfhi(xr.w)};
#pragma unroll
              for (int q = 0; q < 2; ++q) { f32x4 ga = *(const LAS f32x4*)(GA + et * 32 + ej + 4 * q), gx = *(const LAS f32x4*)(GX + et * 32 + ej + 4 * q); const f32x4 sp = *(const LAS f32x4*)(SPL + ej + 4 * q);
#pragma unroll
                  for (int e = 0; e < 4; ++e) { const float a = __builtin_amdgcn_exp2f(ga[e] * sp[e]); const float mult = sqrtf(fmaxf(1.0f - a * a, 0.f)); ga[e] = a; gx[e] = mult * gx[e] * xc[4 * q + e]; }
                  *(LAS f32x4*)(GA + et * 32 + ej + 4 * q) = ga; *(LAS f32x4*)(GX + et * 32 + ej + 4 * q) = gx; } }
            __syncthreads();
            if (wave == 0 && lane < 32) {
#pragma unroll 16
                for (int t = 0; t < 128; ++t) { hstate = GA[t * 32 + lane] * hstate + GX[t * 32 + lane]; HB[t * 32 + lane] = hstate; } }
            __syncthreads();
            { const float ry[8] = {bflo(ryraw.x), bfhi(ryraw.x), bflo(ryraw.y), bfhi(ryraw.y), bflo(ryraw.z), bfhi(ryraw.z), bflo(ryraw.w), bfhi(ryraw.w)};
              const f32x4 h0 = *(const LAS f32x4*)(HB + et * 32 + ej), h1 = *(const LAS f32x4*)(HB + et * 32 + ej + 4);
              u32x4 o; o.x = cvt_pk_bf16(h0.x * gelu_tanh(ry[0]), h0.y * gelu_tanh(ry[1])); o.y = cvt_pk_bf16(h0.z * gelu_tanh(ry[2]), h0.w * gelu_tanh(ry[3]));
              o.z = cvt_pk_bf16(h1.x * gelu_tanh(ry[4]), h1.y * gelu_tanh(ry[5])); o.w = cvt_pk_bf16(h1.z * gelu_tanh(ry[6]), h1.w * gelu_tanh(ry[7]));
              *(u32x4*)(O + (R0 + et) * DM + c0 + ej) = o; }
        }
        __syncthreads();
    }
}

#ifndef REP_P0
#define REP_P0 1
#endif
#ifndef REP_GEMM
#define REP_GEMM 1
#endif
#ifndef REP_MIX0
#define REP_MIX0 1
#endif
#ifndef REP_MIX1
#define REP_MIX1 1
#endif
#ifndef REP_RMS
#define REP_RMS 1
#endif
#ifndef MK_N_LAUNCHES
#define MK_N_LAUNCHES 1
#endif
constexpr int N_PHASES = 16;
struct Args { Params p; int li, pad; };

__device__ __forceinline__ void attn_phase_fox(const Params& p, LAS unsigned char* lds, int wave, int lane) {
    const bf16_t* PROJ = (const bf16_t*)(p.ws + WS_PROJ);
    const AttnIO io{PROJ + PJ_FQ, PROJ + PJ_FK, PROJ + PJ_FV, AB_MAIN, (bf16_t*)(p.ws + WS_O) + 2048, DM};
    const float* CF = (const float*)(p.ws + WS_CF);
    for (int pr = blockIdx.x; pr < 256; pr += gridDim.x) { const int b = pr >> 6, hd = (pr >> 2) & 15, x = pr & 3;
        fox_unit(io, CF, lds, b, hd, 7 - x, wave, lane);
        fox_unit(io, CF, lds, b, hd, x, wave, lane); }
}
__device__ __forceinline__ void attn_phase_sb(const Params& p, LAS unsigned char* lds, int wave, int lane) {
    const bf16_t* PROJ = (const bf16_t*)(p.ws + WS_PROJ);
    const AttnIO io{PROJ + PJ_SQ, PROJ + PJ_SK, PROJ + PJ_SV, CD_IN, (bf16_t*)(p.ws + WS_O) + 2048, DM};
    for (int pr = blockIdx.x; pr < 256; pr += gridDim.x) { const int b = pr >> 6, hd = (pr >> 2) & 15, x = pr & 3;
        sb_unit(io, lds, b, hd, 7 - x, wave, lane);
        sb_unit(io, lds, b, hd, x, wave, lane); }
}

template <int layer>
__device__ __forceinline__ void layer_phases(const Params& p, LAS unsigned char* lds, const XcdBarrier& bar, int lo, int hi, int G, int gw, int ngw, int wave, int lane) {
    unsigned char* ws = p.ws;
    bf16_t* U = (bf16_t*)(ws + WS_U); bf16_t* PROJ = (bf16_t*)(ws + WS_PROJ); bf16_t* O = (bf16_t*)(ws + WS_O); bf16_t* ACT = (bf16_t*)(ws + WS_ACT); pg8::ssq_t* SSQ = (pg8::ssq_t*)((unsigned*)(ws + WS_CTL) + CW_SSQ);
#define IN(k) (lo <= (k) && (k) < hi)
#define SEAM(k) do { if ((k) + 1 < hi) xcd_barrier(bar); } while (0)
        constexpr int kb = 1 + 7 * layer;
        if (IN(kb)) {
            if (layer == 0) {
                pg8::Gemm g{U, (const bf16_t*)(ws + WS_WAB_IN), MTOK, AB_MAIN, DM}; pg8::StaticOrder S; S.init(MTOK, AB_MAIN, G, (int)blockIdx.x);
                pg8::EpiBf16<false> E{PROJ, AB_MAIN, nullptr};
                for (int rep = 0; rep < REP_GEMM; ++rep) { pg8::gemm_phase<pg8::EpiBf16<false>, pg8::StaticOrder, true, true>(lds, g, S, E); __syncthreads(); }
                phase_small32(p, lds, wave, lane);
            } else {
                pg8::Gemm g{U, (const bf16_t*)(ws + WS_WCD_IN), MTOK, CD_IN, DM}; pg8::StaticOrder S; S.init(MTOK, CD_IN, G, (int)blockIdx.x);
                pg8::EpiBf16<true> E{PROJ, CD_IN, SSQ + 1 * MTOK};
                for (int rep = 0; rep < REP_GEMM; ++rep) { pg8::gemm_phase<pg8::EpiBf16<true>, pg8::StaticOrder, true, true>(lds, g, S, E); __syncthreads(); }
            }
            SEAM(kb);
        }
        if (layer == 0 && IN(kb + 1)) { for (int rep = 0; rep < (REP_MIX0 == 5 ? 2 : 1); ++rep) { phase_fox_cumsum(p, gw, ngw, lane); phase_gla_pre(p, lds, wave, lane); } SEAM(kb + 1); }
        if (IN(kb + 2)) {
            if (layer == 0) { phase_gla_seq(p, lds, wave, lane); __syncthreads(); attn_phase_fox(p, lds, wave, lane); __syncthreads();
#if REP_MIX0 == 3
 attn_phase_fox(p, lds, wave, lane); __syncthreads();
#endif
#if REP_MIX0 == 4
 phase_gla_seq(p, lds, wave, lane); __syncthreads();
#endif
 }
            else { phase_rg(p, lds, wave, lane); __syncthreads(); attn_phase_sb(p, lds, wave, lane); __syncthreads();
#if REP_MIX1 == 2
 phase_rg(p, lds, wave, lane); __syncthreads(); attn_phase_sb(p, lds, wave, lane); __syncthreads();
#endif
#if REP_MIX1 == 3
 phase_rg(p, lds, wave, lane); __syncthreads();
#endif
 }
            SEAM(kb + 2);
        }
        if (layer == 0 && IN(kb + 3)) { for (int rep = 0; rep < (REP_MIX0 == 6 ? 2 : 1); ++rep) phase_gla_post(p, gw, ngw, lane); SEAM(kb + 3); }
        if (IN(kb + 4)) {
            pg8::Gemm g{O, (const bf16_t*)(ws + (layer ? WS_WCD_OUT : WS_WAB_OUT)), MTOK, DM, DM}; pg8::StaticOrder S; S.init(MTOK, DM, G, (int)blockIdx.x);
            if (layer == 0) { pg8::EpiRes<true> E{p.x, U, DM, SSQ + (2 * layer) * MTOK}; pg8::gemm_phase<pg8::EpiRes<true>, pg8::StaticOrder, true, true>(lds, g, S, E); }
            else { pg8::EpiRes<false> E{U, U, DM, SSQ + (2 * layer) * MTOK}; pg8::gemm_phase<pg8::EpiRes<false>, pg8::StaticOrder, true, true>(lds, g, S, E); }
            SEAM(kb + 4);
        }
        if (IN(kb + 5)) {
            pg8::Gemm g{U, (const bf16_t*)(ws + (layer ? WS_WGU1 : WS_WGU0)), MTOK, 2 * DFF, DM}; pg8::StaticOrder S; S.init(MTOK, 2 * DFF, G, (int)blockIdx.x);
            pg8::EpiSwiGLU E{ACT, DFF, SSQ + (2 * layer) * MTOK};
            for (int rep = 0; rep < REP_GEMM; ++rep) { pg8::gemm_phase<pg8::EpiSwiGLU, pg8::StaticOrder, true, true>(lds, g, S, E); __syncthreads(); }
            SEAM(kb + 5);
        }
        if (IN(kb + 6)) {
            pg8::Gemm g{ACT, (const bf16_t*)(ws + (layer ? WS_WDN1 : WS_WDN0)), MTOK, DM, DFF}; pg8::StaticOrder S; S.init(MTOK, DM, G, (int)blockIdx.x);
            pg8::EpiRes<false> E{U, U, DM, SSQ + (2 * layer + 1) * MTOK};
            pg8::gemm_phase<pg8::EpiRes<false>, pg8::StaticOrder, true, true>(lds, g, S, E);
            SEAM(kb + 6);
        }
#undef IN
#undef SEAM
}

__global__ void __launch_bounds__(NTHR, 2) hybrid_fwd(Args args) {
    extern __shared__ __attribute__((aligned(16))) unsigned char lds_raw[];
    LAS unsigned char* lds = (LAS unsigned char*)lds_raw;
    const Params& p = args.p;
    const int tid = threadIdx.x, lane = tid & 63, wave = __builtin_amdgcn_readfirstlane(tid >> 6);
    const int G = gridDim.x, gw = blockIdx.x * NWAVES + wave, ngw = G * NWAVES;
    for (int u = tid; u < (LDS_BYTES - LDSCTL_OFF) / 4; u += NTHR) ((LAS unsigned*)(lds + LDSCTL_OFF))[u] = 0u;
    __syncthreads();
    unsigned* ctl = (unsigned*)(p.ws + WS_CTL);
    XcdBarrier bar = xcd_barrier_post(ctl + CW_BAR + args.li * XCD_BAR_WORDS, (volatile LAS unsigned*)(lds + MISC_OFF) + 8);
    const int lo = p.ph_lo, hi = p.ph_hi;
#define IN(k) (lo <= (k) && (k) < hi)
#define SEAM(k) do { if ((k) + 1 < hi) xcd_barrier(bar); } while (0)
    if (IN(0)) { for (int rep = 0; rep < REP_P0; ++rep) { phase_p0(p, lds, gw, ngw, wave, lane); __syncthreads(); } SEAM(0); }

    layer_phases<0>(p, lds, bar, lo, hi, G, gw, ngw, wave, lane);
    layer_phases<1>(p, lds, bar, lo, hi, G, gw, ngw, wave, lane);
    if (IN(15)) phase_final_norm((const bf16_t*)(p.ws + WS_U), (const unsigned long long*)((const unsigned*)(p.ws + WS_CTL) + CW_SSQ) + 3 * MTOK, p.final_norm, p.out, gw, ngw, lane);
#undef IN
#undef SEAM
}

extern "C" void kernel_launch(void* const* d_in, const int* in_sizes, int n_in, void* d_out, int out_size, void* d_ws, size_t ws_size, hipStream_t stream) {
    static int grid = 0;
    if (grid == 0) {
        if (n_in != 22 || in_sizes[0] != MTOK * DM || out_size != MTOK * DM || ws_size < WS_END) {
            fprintf(stderr, "kernel_launch: unexpected problem (n_in %d, in0 %d, out %d, ws %zu, need %zu); nothing launched\n", n_in, n_in > 0 ? in_sizes[0] : -1, out_size, ws_size, (size_t)WS_END); grid = -1; return; }
        int dev = 0, cus = 0, per_cu = 0;
        if (hipGetDevice(&dev) != hipSuccess || hipDeviceGetAttribute(&cus, hipDeviceAttributeMultiprocessorCount, dev) != hipSuccess) { fprintf(stderr, "kernel_launch: device query failed\n"); grid = -1; return; }
        if (hipFuncSetAttribute((const void*)hybrid_fwd, hipFuncAttributeMaxDynamicSharedMemorySize, LDS_BYTES) != hipSuccess) { fprintf(stderr, "kernel_launch: hipFuncSetAttribute failed\n"); grid = -1; return; }
        if (hipOccupancyMaxActiveBlocksPerMultiprocessor(&per_cu, (const void*)hybrid_fwd, NTHR, LDS_BYTES) != hipSuccess || per_cu < 1) {
            fprintf(stderr, "kernel_launch: occupancy query reports %d workgroups per CU; nothing launched\n", per_cu); (void)hipGetLastError(); grid = -1; return; }
        grid = cus;
    }
    if (grid < 0) return;
    if (hipMemsetAsync((char*)d_ws + WS_CTL, 0, CTL_ZERO_BYTES, stream) != hipSuccess) { fprintf(stderr, "kernel_launch: memset failed\n"); return; }
    Args a{};
    const float** pp = (const float**)&a.p;
    for (int i = 0; i < 22; ++i) pp[i] = (const float*)d_in[i];
    a.p.out = (float*)d_out; a.p.ws = (unsigned char*)d_ws;
#if MK_N_LAUNCHES == 1
    a.p.ph_lo = 0; a.p.ph_hi = N_PHASES; a.li = 0; a.pad = 0;
    hipLaunchKernelGGL(hybrid_fwd, dim3(grid), dim3(NTHR), LDS_BYTES, stream, a);
    { const hipError_t le = hipPeekAtLastError(); if (le != hipSuccess) fprintf(stderr, "kernel_launch: launch failed: %s\n", hipGetErrorName(le)); }
#else
    for (int k = 0; k < N_PHASES; ++k) { a.p.ph_lo = k; a.p.ph_hi = k + 1; a.li = k; a.pad = 0;
        hipLaunchKernelGGL(hybrid_fwd, dim3(grid), dim3(NTHR), LDS_BYTES, stream, a);
        const hipError_t le = hipPeekAtLastError(); if (le != hipSuccess) { fprintf(stderr, "kernel_launch: launch %d failed: %s\n", k, hipGetErrorName(le)); break; } }
#endif
}
```

```cpp
#include <hip/hip_runtime.h>
#include <cstdio>
#include <cstdint>

#define LAS __attribute__((address_space(3)))
#define GAS __attribute__((address_space(1)))
typedef unsigned short bf16_t;
typedef short bf16x8 __attribute__((ext_vector_type(8)));
typedef short s16x4 __attribute__((ext_vector_type(4)));
typedef float f32x4 __attribute__((ext_vector_type(4)));
typedef float f32x2 __attribute__((ext_vector_type(2)));
typedef float f32x16 __attribute__((ext_vector_type(16)));
typedef unsigned u32x4 __attribute__((ext_vector_type(4)));
typedef unsigned u32x2 __attribute__((ext_vector_type(2)));

constexpr int DM = 4096, NB = 4, SEQ = 2048, MTOK = NB * SEQ;
constexpr int DFF = 11008;
constexpr int AB_MAIN = 12288;
constexpr int AB_IN = 12320, CD_IN = 10240;
constexpr int PJ_GQ = 0, PJ_GK = 1024, PJ_GV = 2048, PJ_GG = 4096, PJ_FQ = 6144, PJ_FK = 8192, PJ_FV = 10240;
constexpr int PJ_RY = 0, PJ_RX = 2048, PJ_SQ = 4096, PJ_SK = 6144, PJ_SV = 8192;
constexpr float EPS = 1e-6f;

__device__ __forceinline__ unsigned cvt_pk_bf16(float lo, float hi) { unsigned r; asm volatile("v_cvt_pk_bf16_f32 %0, %1, %2" : "=v"(r) : "v"(lo), "v"(hi)); return r; }
__device__ __forceinline__ float bf2f(bf16_t v) { return __uint_as_float(((unsigned)v) << 16); }
__device__ __forceinline__ float bflo(unsigned w) { return __uint_as_float(w << 16); }
__device__ __forceinline__ float bfhi(unsigned w) { return __uint_as_float(w & 0xffff0000u); }
__device__ __forceinline__ bf16_t f2bf(float f) { return (bf16_t)(cvt_pk_bf16(f, 0.f) & 0xffffu); }
__device__ __forceinline__ int crow(int r, int hi) { return (r & 3) + 8 * (r >> 2) + 4 * hi; }
__device__ __forceinline__ bf16x8 pack8(float a0, float a1, float a2, float a3, float a4, float a5, float a6, float a7) {
    u32x4 w = {cvt_pk_bf16(a0, a1), cvt_pk_bf16(a2, a3), cvt_pk_bf16(a4, a5), cvt_pk_bf16(a6, a7)}; return __builtin_bit_cast(bf16x8, w); }
__device__ __forceinline__ float wave_sum(float v) {
#pragma unroll
    for (int o = 1; o < 64; o <<= 1) v += __shfl_xor(v, o);
    return v; }
__device__ __forceinline__ float log_sigmoid_acc(float x) { return fminf(x, 0.f) - log1pf(expf(-fabsf(x))); }
#define LDS_WAIT() asm volatile("s_waitcnt lgkmcnt(0)" ::: "memory")
#define VM_WAIT() asm volatile("s_waitcnt vmcnt(0)" ::: "memory")
#define MFMA32(a, b, c) __builtin_amdgcn_mfma_f32_32x32x16_bf16((a), (b), (c), 0, 0, 0)
typedef LAS const char* lds_cptr;
__device__ __forceinline__ s16x4 vtr(lds_cptr p) { return __builtin_bit_cast(s16x4, __builtin_amdgcn_ds_read_tr16_b64_v4i16((LAS s16x4*)p)); }
__device__ __forceinline__ bf16x8 cat4(s16x4 lo, s16x4 hi) { bf16x8 r; r[0] = lo[0]; r[1] = lo[1]; r[2] = lo[2]; r[3] = lo[3]; r[4] = hi[0]; r[5] = hi[1]; r[6] = hi[2]; r[7] = hi[3]; return r; }

namespace pg8 {
#define PG8_LAS __attribute__((address_space(3)))
typedef unsigned short bf16_t;
typedef short bf16x8 __attribute__((ext_vector_type(8)));
typedef float f32x4 __attribute__((ext_vector_type(4)));
typedef unsigned u32x4 __attribute__((ext_vector_type(4)));
constexpr int BM = 256, BK = 64, HALF = 128, HTB = HALF * BK * 2  , STAGE_BYTES = 8 * HTB, NXCD = 8, WGM = 8;

__host__ __device__ __forceinline__ int lds_byte(int r, int c) { const int st = (r >> 4) * 2 + (c >> 5), rr = r & 15, cc = c & 31, ob = rr * 64 + cc * 2; return st * 1024 + (ob ^ (((ob >> 9) & 1) << 5)); }
__host__ __device__ __forceinline__ void stage_rc(int b, int& R, int& C) { const int st = b / 1024, sb = b % 1024, swz = sb ^ (((sb >> 9) & 1) << 5); R = (st >> 1) * 16 + swz / 64; C = (st & 1) * 32 + (swz % 64) / 2; }
__host__ __device__ __forceinline__ int perm32(int rho) { const int n = rho >> 4, i = rho & 15; return 8 * (i >> 2) + 4 * n + (i & 3); }

struct Unit { int pm, pn; };
struct Gemm { const bf16_t* A; const bf16_t* Bt; int M, N, K; };

struct StaticOrder {
    int nM, nN, nwg, G, c;
    __host__ __device__ void init(int M, int N, int G_, int c_) { nM = M / BM; nN = N / BM; nwg = nM * nN; G = G_; c = c_; }
    __host__ __device__ bool next(int i, Unit& u) const {
        const long L = (long)i * G + c; if (L >= nwg) return false;
        int wgid = (int)L; { const int q = nwg / NXCD, r = nwg % NXCD, xcd = wgid % NXCD, off = wgid / NXCD; wgid = (xcd < r ? xcd * (q + 1) : r * (q + 1) + (xcd - r) * q) + off; }
        const int nig = WGM * nN, gid = wgid / nig, fm = gid * WGM, gsz = (nM - fm) < WGM ? (nM - fm) : WGM;
        u.pm = fm + ((wgid % nig) % gsz); u.pn = (wgid % nig) / gsz; return true;
    }
    __device__ __forceinline__ void a_ready(const Unit&) const {}
    __device__ __forceinline__ void done(const Unit&) const {}
};
__device__ __forceinline__ unsigned cvt_pk_bf16(float lo, float hi) { unsigned r; asm volatile("v_cvt_pk_bf16_f32 %0, %1, %2" : "=v"(r) : "v"(lo), "v"(hi)); return r; }
constexpr float RMS_EPS = 1e-6f, RMS_INV_D = 1.0f / 4096.0f, SSQ_FIX = 16777216.0f, SSQ_UNFIX = 1.0f / 16777216.0f;
typedef unsigned long long ssq_t;
__device__ __forceinline__ float ssq_rstd(const ssq_t* ssq, int row) { return __builtin_amdgcn_rsqf((float)ssq[row] * (SSQ_UNFIX * RMS_INV_D) + RMS_EPS); }

template <bool SCALE> struct EpiBf16 {
    static constexpr bool PERM = true, AFTER_DRAIN = false;
    bf16_t* O; int ldc; const ssq_t* ssq;
    __device__ __forceinline__ void operator()(const f32x4 (&acc)[2][2][4][2], const Unit& u, int wr, int wc, int fr, int fq) const {
        const int row0 = u.pm * BM + wr * 64 + fr, col0 = u.pn * BM + wc * 32 + 8 * fq;
        float rs[2][4];
#pragma unroll
        for (int ai = 0; ai < 2; ++ai)
#pragma unroll
            for (int m = 0; m < 4; ++m) rs[ai][m] = SCALE ? ssq_rstd(ssq, row0 + ai * HALF + m * 16) : 1.0f;
#pragma unroll
        for (int ai = 0; ai < 2; ++ai)
#pragma unroll
            for (int m = 0; m < 4; ++m) { const int row = row0 + ai * HALF + m * 16; bf16_t* rowp = O + (size_t)row * ldc + col0;
#pragma unroll
                for (int bj = 0; bj < 2; ++bj) { const f32x4 v0 = acc[ai][bj][m][0] * rs[ai][m], v1 = acc[ai][bj][m][1] * rs[ai][m];
                    u32x4 w; w.x = cvt_pk_bf16(v0[0], v0[1]); w.y = cvt_pk_bf16(v0[2], v0[3]); w.z = cvt_pk_bf16(v1[0], v1[1]); w.w = cvt_pk_bf16(v1[2], v1[3]);
                    *(u32x4*)(rowp + bj * HALF) = w; } }
    }
};
template <bool BASE_F32> struct EpiRes {
    static constexpr bool PERM = true, AFTER_DRAIN = false;
    const void* base; bf16_t* out; int ldc; ssq_t* ssq;
    __device__ __forceinline__ void operator()(const f32x4 (&acc)[2][2][4][2], const Unit& u, int wr, int wc, int fr, int fq) const {
        const int row0 = u.pm * BM + wr * 64 + fr, col0 = u.pn * BM + wc * 32 + 8 * fq;
#pragma unroll
        for (int ai = 0; ai < 2; ++ai) {
            f32x4 b0[4][2], b1[4][2];
#pragma unroll
            for (int m = 0; m < 4; ++m)
#pragma unroll
                for (int bj = 0; bj < 2; ++bj) { const size_t off = (size_t)(row0 + ai * HALF + m * 16) * ldc + col0 + bj * HALF;
                    if (BASE_F32) { const float* bp = (const float*)base + off; b0[m][bj] = *(const f32x4*)bp; b1[m][bj] = *(const f32x4*)(bp + 4); }
                    else { const u32x4 r = *(const u32x4*)((const bf16_t*)base + off);
                        b0[m][bj] = (f32x4){__uint_as_float(r.x << 16), __uint_as_float(r.x & 0xffff0000u), __uint_as_float(r.y << 16), __uint_as_float(r.y & 0xffff0000u)};
                        b1[m][bj] = (f32x4){__uint_as_float(r.z << 16), __uint_as_float(r.z & 0xffff0000u), __uint_as_float(r.w << 16), __uint_as_float(r.w & 0xffff0000u)}; } }
#pragma unroll
            for (int m = 0; m < 4; ++m) { const int row = row0 + ai * HALF + m * 16; const size_t off = (size_t)row * ldc + col0; float q = 0.f;
#pragma unroll
                for (int bj = 0; bj < 2; ++bj) { const f32x4 v0 = acc[ai][bj][m][0] + b0[m][bj], v1 = acc[ai][bj][m][1] + b1[m][bj];
                    q += ((v0[0] * v0[0] + v0[1] * v0[1]) + (v0[2] * v0[2] + v0[3] * v0[3])) + ((v1[0] * v1[0] + v1[1] * v1[1]) + (v1[2] * v1[2] + v1[3] * v1[3]));
                    u32x4 w; w.x = cvt_pk_bf16(v0[0], v0[1]); w.y = cvt_pk_bf16(v0[2], v0[3]); w.z = cvt_pk_bf16(v1[0], v1[1]); w.w = cvt_pk_bf16(v1[2], v1[3]);
                    *(u32x4*)(out + off + bj * HALF) = w; }
                q += __shfl_xor(q, 16); q += __shfl_xor(q, 32);
                if (fq == 0) atomicAdd(ssq + row, (ssq_t)(q * SSQ_FIX + 0.5f)); }
        }
    }
};
struct EpiSwiGLU {
    static constexpr bool PERM = true, AFTER_DRAIN = false;
    bf16_t* O; int ldc; const ssq_t* ssq;
    __device__ __forceinline__ void operator()(const f32x4 (&acc)[2][2][4][2], const Unit& u, int wr, int wc, int fr, int fq) const {
        const int row0 = u.pm * BM + wr * 64 + fr, col0 = u.pn * HALF + wc * 32 + 8 * fq;
        float rs[2][4];
#pragma unroll
        for (int ai = 0; ai < 2; ++ai)
#pragma unroll
            for (int m = 0; m < 4; ++m) rs[ai][m] = ssq_rstd(ssq, row0 + ai * HALF + m * 16);
#pragma unroll
        for (int ai = 0; ai < 2; ++ai)
#pragma unroll
            for (int m = 0; m < 4; ++m) { const int row = row0 + ai * HALF + m * 16; bf16_t* rowp = O + (size_t)row * ldc + col0; float a[8];
#pragma unroll
                for (int n = 0; n < 2; ++n)
#pragma unroll
                    for (int i = 0; i < 4; ++i) { const float g = acc[ai][0][m][n][i] * rs[ai][m], up = acc[ai][1][m][n][i] * rs[ai][m]; a[4 * n + i] = g * up * __builtin_amdgcn_rcpf(1.0f + __expf(-g)); }
                u32x4 w; w.x = cvt_pk_bf16(a[0], a[1]); w.y = cvt_pk_bf16(a[2], a[3]); w.z = cvt_pk_bf16(a[4], a[5]); w.w = cvt_pk_bf16(a[6], a[7]);
                *(u32x4*)rowp = w; }
    }
};

template <class Epi, class Sched, bool ALIGN_EPI = false, bool SP2 = false>
__device__ __forceinline__ void gemm_phase(PG8_LAS unsigned char* lds, const Gemm g, const Sched& S, const Epi& E) {
    const int tid = threadIdx.x, wid = __builtin_amdgcn_readfirstlane(tid >> 6), lane = tid & 63, wr = wid >> 2, wc = wid & 3, fr = lane & 15, fq = lane >> 4;
    const int K = g.K, nt = K / BK;
    unsigned voffA[2], voffB[2];
#pragma unroll
    for (int i = 0; i < 2; ++i) { int R, C; stage_rc(tid * 16 + i * 8192, R, C); const int Rb = Epi::PERM ? ((R & ~31) + perm32(R & 31)) : R;
        voffA[i] = (unsigned)(R * K + C) * 2u; voffB[i] = (unsigned)(Rb * K + C) * 2u; }
    const size_t kstep = (size_t)(BK * 2);
    const size_t hstep = (size_t)HALF * K * 2;
    const size_t tstep = 2 * hstep;
    const unsigned ldsw = (unsigned)wid * 1024u;
    const int aoff = lds_byte(wr * 64 + fr, fq * 8), boff = lds_byte(wc * 32 + fr, fq * 8);
#define PG8_SA(b, h) (((b) * 2 + (h)) * HTB)
#define PG8_SB(b, h) ((4 + (b) * 2 + (h)) * HTB)
#define PG8_STAGE(bufoff, gbase, voff) do { _Pragma("unroll") for (int _i = 0; _i < 2; ++_i) \
        __builtin_amdgcn_global_load_lds((const unsigned*)((const char*)(gbase) + (voff)[_i]), (PG8_LAS unsigned*)(lds + (bufoff) + ldsw + _i * 8192), 16, 0, 0); } while (0)
#define PG8_LDA(dst, b, h) do { _Pragma("unroll") for (int m = 0; m < 4; ++m) _Pragma("unroll") for (int k = 0; k < 2; ++k) dst[m][k] = *(const PG8_LAS bf16x8*)(lds + PG8_SA(b, h) + aoff + m * 2048 + k * 1024); } while (0)
#define PG8_LDB(dst, b, h) do { _Pragma("unroll") for (int n = 0; n < 2; ++n) _Pragma("unroll") for (int k = 0; k < 2; ++k) dst[n][k] = *(const PG8_LAS bf16x8*)(lds + PG8_SB(b, h) + boff + n * 2048 + k * 1024); } while (0)
#define PG8_MMA(ai, bj, At, Bt) do { __builtin_amdgcn_s_setprio(1); _Pragma("unroll") for (int m = 0; m < 4; ++m) _Pragma("unroll") for (int n = 0; n < 2; ++n) _Pragma("unroll") for (int k = 0; k < 2; ++k) \
        acc[ai][bj][m][n] = __builtin_amdgcn_mfma_f32_16x16x32_bf16(Bt[n][k], At[m][k], acc[ai][bj][m][n], 0, 0, 0); __builtin_amdgcn_s_setprio(0); } while (0)
#define PG8_WAIT_V(n) asm volatile("s_waitcnt vmcnt(" #n ")" ::: "memory")
#define PG8_WAIT_L(n) asm volatile("s_waitcnt lgkmcnt(" #n ")" ::: "memory")
#define PG8_BAR __builtin_amdgcn_s_barrier()
#define PG8_SCHED __builtin_amdgcn_sched_barrier(0)
    Unit cur, nxt; int ui = 0;
    if (!S.next(0, cur)) return;
    f32x4 acc[2][2][4][2];
#pragma unroll
    for (int a = 0; a < 2; ++a)
#pragma unroll
        for (int b = 0; b < 2; ++b)
#pragma unroll
            for (int m = 0; m < 4; ++m)
#pragma unroll
                for (int n = 0; n < 2; ++n) acc[a][b][m][n] = (f32x4){0.f, 0.f, 0.f, 0.f};
    bf16x8 At[4][2], B0[2][2], B1[2][2];
    const char* cA = (const char*)g.A + (size_t)cur.pm * tstep; const char* cB = (const char*)g.Bt + (size_t)cur.pn * tstep;
    S.a_ready(cur);
    if constexpr (SP2) {
        PG8_STAGE(PG8_SB(0, 0), cB, voffB); PG8_STAGE(PG8_SB(0, 1), cB + hstep, voffB); PG8_STAGE(PG8_SA(0, 0), cA, voffA); PG8_STAGE(PG8_SA(0, 1), cA + hstep, voffA);
        if (wr == 1) PG8_BAR;
        PG8_WAIT_V(2); PG8_BAR;
        PG8_STAGE(PG8_SB(1, 0), cB + kstep, voffB); PG8_STAGE(PG8_SA(1, 0), cA + kstep, voffA); PG8_STAGE(PG8_SB(1, 1), cB + hstep + kstep, voffB);
        PG8_WAIT_V(6); PG8_BAR;
    } else {
        PG8_STAGE(PG8_SB(0, 0), cB, voffB); PG8_STAGE(PG8_SA(0, 0), cA, voffA); PG8_STAGE(PG8_SB(0, 1), cB + hstep, voffB); PG8_STAGE(PG8_SA(0, 1), cA + hstep, voffA);
        if (wr == 1) PG8_BAR;
        PG8_WAIT_V(4); PG8_BAR;
        PG8_STAGE(PG8_SB(1, 0), cB + kstep, voffB); PG8_STAGE(PG8_SA(1, 0), cA + kstep, voffA); PG8_STAGE(PG8_SB(1, 1), cB + hstep + kstep, voffB);
        PG8_WAIT_V(6); PG8_BAR;
    }
    for (;;) {
        const bool has_next = S.next(ui + 1, nxt);
        const char* nA = has_next ? (const char*)g.A + (size_t)nxt.pm * tstep : cA; const char* nB = has_next ? (const char*)g.Bt + (size_t)nxt.pn * tstep : cB;
        for (int t = 0; t < nt; t += 2) {
            const bool last = (t == nt - 2);
            const char* a1 = cA + (size_t)(t + 1) * kstep;
            const char* a2 = last ? nA : cA + (size_t)(t + 2) * kstep; const char* b2 = last ? nB : cB + (size_t)(t + 2) * kstep;
            const char* a3 = a2 + kstep; const char* b3 = b2 + kstep;
            if (last && has_next) S.a_ready(nxt);
            if constexpr (SP2) {
            PG8_LDB(B0, 0, 0); PG8_LDB(B1, 0, 1); PG8_SCHED; PG8_LDA(At, 0, 0); PG8_STAGE(PG8_SA(1, 1), a1 + hstep, voffA);
            PG8_WAIT_V(8); PG8_WAIT_L(0); PG8_BAR; PG8_MMA(0, 0, At, B0); PG8_MMA(0, 1, At, B1); PG8_BAR; PG8_SCHED;
            PG8_LDA(At, 0, 1); PG8_STAGE(PG8_SB(0, 0), b2, voffB); PG8_STAGE(PG8_SB(0, 1), b2 + hstep, voffB); PG8_STAGE(PG8_SA(0, 0), a2, voffA);
            PG8_WAIT_V(8); PG8_WAIT_L(0); PG8_BAR; PG8_MMA(1, 0, At, B0); PG8_MMA(1, 1, At, B1); PG8_BAR; PG8_SCHED;
            PG8_LDB(B0, 1, 0); PG8_LDB(B1, 1, 1); PG8_SCHED; PG8_LDA(At, 1, 0); PG8_STAGE(PG8_SA(0, 1), a2 + hstep, voffA);
            PG8_WAIT_V(8); PG8_WAIT_L(0); PG8_BAR; PG8_MMA(0, 0, At, B0); PG8_MMA(0, 1, At, B1); PG8_BAR; PG8_SCHED;
            PG8_LDA(At, 1, 1); PG8_STAGE(PG8_SB(1, 0), b3, voffB); PG8_STAGE(PG8_SB(1, 1), b3 + hstep, voffB); PG8_STAGE(PG8_SA(1, 0), a3, voffA);
            PG8_WAIT_V(8); PG8_WAIT_L(0); PG8_BAR; PG8_MMA(1, 0, At, B0); PG8_MMA(1, 1, At, B1); PG8_BAR; PG8_SCHED;
            } else {
            PG8_LDB(B0, 0, 0); PG8_SCHED; PG8_LDA(At, 0, 0); PG8_STAGE(PG8_SA(1, 1), a1 + hstep, voffA);
            PG8_WAIT_L(8); PG8_BAR; PG8_WAIT_L(0); PG8_MMA(0, 0, At, B0); PG8_BAR; PG8_SCHED;
            PG8_LDB(B1, 0, 1); PG8_STAGE(PG8_SB(0, 0), b2, voffB);
            PG8_BAR; PG8_WAIT_L(0); PG8_MMA(0, 1, At, B1); PG8_BAR;
            PG8_LDA(At, 0, 1); PG8_STAGE(PG8_SA(0, 0), a2, voffA);
            PG8_BAR; PG8_WAIT_L(0); PG8_MMA(1, 0, At, B0); PG8_BAR; PG8_SCHED;
            PG8_STAGE(PG8_SB(0, 1), b2 + hstep, voffB);
            PG8_WAIT_V(6); PG8_BAR; PG8_MMA(1, 1, At, B1); PG8_BAR;
            PG8_LDB(B0, 1, 0); PG8_SCHED; PG8_LDA(At, 1, 0); PG8_STAGE(PG8_SA(0, 1), a2 + hstep, voffA);
            PG8_WAIT_L(8); PG8_BAR; PG8_WAIT_L(0); PG8_MMA(0, 0, At, B0); PG8_BAR; PG8_SCHED;
            PG8_LDB(B1, 1, 1); PG8_STAGE(PG8_SB(1, 0), b3, voffB);
            PG8_BAR; PG8_WAIT_L(0); PG8_MMA(0, 1, At, B1); PG8_BAR;
            PG8_LDA(At, 1, 1); PG8_STAGE(PG8_SA(1, 0), a3, voffA);
            PG8_BAR; PG8_WAIT_L(0); PG8_MMA(1, 0, At, B0); PG8_BAR; PG8_SCHED;
            PG8_STAGE(PG8_SB(1, 1), b3 + hstep, voffB);
            PG8_WAIT_V(6); PG8_BAR; PG8_MMA(1, 1, At, B1); PG8_BAR;
            }
        }
        if constexpr (ALIGN_EPI) { if (wr == 0) PG8_BAR; }
        if constexpr (!Epi::AFTER_DRAIN) { E(acc, cur, wr, wc, fr, fq); S.done(cur); }
        if (!has_next) break;
#pragma unroll
        for (int a = 0; a < 2; ++a)
#pragma unroll
            for (int b = 0; b < 2; ++b)
#pragma unroll
                for (int m = 0; m < 4; ++m)
#pragma unroll
                    for (int n = 0; n < 2; ++n) acc[a][b][m][n] = (f32x4){0.f, 0.f, 0.f, 0.f};
        cur = nxt; cA = nA; cB = nB; ++ui;
        if constexpr (ALIGN_EPI) { if (wr == 1) PG8_BAR; }
    }
    PG8_WAIT_V(0);
    if constexpr (!ALIGN_EPI) { if (wr == 0) PG8_BAR; }
    PG8_BAR;
    if constexpr (Epi::AFTER_DRAIN) { E.fused(acc, cur, wr, wc, fr, fq, lds, wid, lane); S.done(cur); }
#undef PG8_SA
#undef PG8_SB
#undef PG8_STAGE
#undef PG8_LDA
#undef PG8_LDB
#undef PG8_MMA
#undef PG8_WAIT_V
#undef PG8_WAIT_L
#undef PG8_BAR
#undef PG8_SCHED
}
}
#define XB_TMO      128
#define XB_XCNT(j)  (256  + 64 * (j))
#define XB_XSUB(j)  (1280 + 64 * (j))
#define XB_XGEN(j)  (2304 + 64 * (j))
#define XB_TOP      3328
#define XB_TOPGEN   3392
#define XCD_BAR_WORDS 3456
#define XB_SPIN_CAP (1u << 18)

__device__ __forceinline__ unsigned xb_ld(unsigned* p)              { return __hip_atomic_load(p, __ATOMIC_RELAXED, __HIP_MEMORY_SCOPE_AGENT); }
__device__ __forceinline__ unsigned xb_add(unsigned* p, unsigned v) { return __hip_atomic_fetch_add(p, v, __ATOMIC_RELAXED, __HIP_MEMORY_SCOPE_AGENT); }
__device__ __forceinline__ unsigned xb_xcc_id() { return (unsigned)__builtin_amdgcn_s_getreg((3 << 11) | 20) & 0xFu; }
#define XB_SPIN(cond, bar) do { unsigned _sp = 0; while (cond) { __builtin_amdgcn_s_sleep(1); \
    if ((++_sp & 255u) == 0u) { if (xb_ld(&(bar)[XB_TMO])) break; if (_sp > XB_SPIN_CAP) { atomicAdd(&(bar)[XB_TMO], 1u); break; } } } } while (0)

struct XcdBarrier {
    unsigned* bar; unsigned x;
    volatile LAS unsigned* st;
};

__device__ __forceinline__ XcdBarrier xcd_barrier_post(unsigned* bar, volatile LAS unsigned* st) {
    XcdBarrier b; b.bar = bar; b.x = xb_xcc_id(); b.st = st;
    if (threadIdx.x == 0) (void)xb_add(&bar[XB_XCNT(b.x)], 1u);
    return b;
}
__device__ __forceinline__ void xcd_barrier_complete(unsigned* bar, unsigned x, unsigned& nloc, unsigned& nx) {
    const unsigned G = gridDim.x * gridDim.y * gridDim.z;
    unsigned sum, cnt, mine, sp = 0u;
    for (;;) {
        sum = 0u; cnt = 0u; mine = 0u;
#pragma unroll
        for (unsigned j = 0; j < 16; ++j) { const unsigned c = xb_ld(&bar[XB_XCNT(j)]); sum += c; cnt += (c > 0u) ? 1u : 0u; mine = (j == x) ? c : mine; }
        if (sum == G) break;
        __builtin_amdgcn_s_sleep(1);
        if ((++sp & 255u) == 0u) { if (xb_ld(&bar[XB_TMO])) break; if (sp > XB_SPIN_CAP) { atomicAdd(&bar[XB_TMO], 1u); break; } }
    }
    nloc = mine > 0u ? mine : 1u; nx = cnt > 0u ? cnt : 1u;
}

__device__ __forceinline__ void xcd_barrier(const XcdBarrier& b) {
    asm volatile("s_waitcnt vmcnt(0)" ::: "memory");
    __syncthreads();
    if (threadIdx.x == 0) {
        unsigned* bar = b.bar;
        __builtin_amdgcn_s_waitcnt(0);
        unsigned nloc = b.st[0], nx = b.st[1];
        if (nloc == 0u) { xcd_barrier_complete(bar, b.x, nloc, nx); b.st[0] = nloc; b.st[1] = nx; }
        const unsigned old = xb_add(&bar[XB_XSUB(b.x)], 1u);
        const unsigned gen = old / nloc;
        if (old + 1u == (gen + 1u) * nloc) {
            __builtin_amdgcn_fence(__ATOMIC_RELEASE, "agent");
            asm volatile("s_waitcnt vmcnt(0)" ::: "memory");
            const unsigned og = xb_add(&bar[XB_TOP], 1u);
            const unsigned tg = og / nx;
            if (og + 1u == (tg + 1u) * nx) xb_add(&bar[XB_TOPGEN], 1u);
            else XB_SPIN(xb_ld(&bar[XB_TOPGEN]) == tg, bar);
            __builtin_amdgcn_fence(__ATOMIC_ACQUIRE, "agent");
            xb_add(&bar[XB_XGEN(b.x)], 1u);
            asm volatile("s_waitcnt vmcnt(0)" ::: "memory");
        } else {
            XB_SPIN(xb_ld(&bar[XB_XGEN(b.x)]) == gen, bar);
            __builtin_amdgcn_fence(__ATOMIC_ACQUIRE, "agent");
            asm volatile("s_waitcnt vmcnt(0)" ::: "memory");
        }
    }
    __syncthreads();
}
constexpr size_t MiB = 1u << 20;
constexpr size_t WS_CTL = 0, CTL_ZERO_BYTES = 1 * MiB;
constexpr size_t WS_WAB_IN = 1 * MiB, WS_WAB_OUT = 97 * MiB, WS_WGU0 = 129 * MiB, WS_WDN0 = 301 * MiB, WS_WCD_IN = 387 * MiB, WS_WCD_OUT = 467 * MiB, WS_WGU1 = 499 * MiB, WS_WDN1 = 671 * MiB;
constexpr size_t WS_WSMALL = 757 * MiB, WS_WRG = 758 * MiB;
constexpr size_t WS_U = 760 * MiB, WS_PROJ = 824 * MiB, WS_O = 1016 * MiB, WS_H = 1080 * MiB;
constexpr size_t WS_ACT = WS_PROJ;
constexpr size_t WS_SMALL32 = 1208 * MiB, WS_CF = 1209 * MiB, WS_QT = 1210 * MiB, WS_KDT = 1226 * MiB, WS_PM = 1242 * MiB, WS_GDEC = 1246 * MiB, WS_ORAW = 1247 * MiB, WS_SSQ = 1311 * MiB;
constexpr size_t WS_END = 1313 * MiB;
constexpr int CW_BAR = 4096, CW_SSQ = 131072;

constexpr int RING_BYTES = 131072;
constexpr int LDSCTL_OFF = RING_BYTES, MISC_OFF = LDSCTL_OFF + 320;
constexpr int LDS_BYTES = 147456;
constexpr int NWAVES = 8, NTHR = 512;

struct Params {
    const float *x, *norm_mix, *norm_ffn, *ffn_w_gate, *ffn_w_up, *ffn_w_down, *ab_w_in, *gla_w_gate_up, *gla_b_gate, *gla_norm, *fox_b_f, *ab_w_out,
                *cd_w_in, *rg_conv_w, *rg_conv_b, *rg_w_x, *rg_b_x, *rg_w_a, *rg_b_a, *rg_lambda, *cd_w_out, *final_norm;
    float* out; unsigned char* ws; int ph_lo, ph_hi;
};

struct TrDesc { const float* src; bf16_t* dst; const float* gain; int ldn, K; };
__device__ __forceinline__ void tr_load(const TrDesc& d, f32x4 (&v)[8], int lane) {
    const float* sp = d.src + (size_t)(lane >> 3) * d.ldn + 4 * (lane & 7);
#pragma unroll
    for (int i = 0; i < 8; ++i) v[i] = *(const f32x4*)(sp + (size_t)(8 * i) * d.ldn);
}
__device__ __forceinline__ void tr_finish(const TrDesc& d, const f32x4 (&v)[8], LAS float* scr, int lane) {
    const int c = lane & 7;
    f32x4 g0 = {1.f, 1.f, 1.f, 1.f}, g1 = {1.f, 1.f, 1.f, 1.f};
    if (d.gain) { g0 = *(const f32x4*)(d.gain + 8 * c); g1 = *(const f32x4*)(d.gain + 8 * c + 4); }
#pragma unroll
    for (int i = 0; i < 8; ++i) { LAS float* w = scr + (8 * i + (lane >> 3)) * 33 + 4 * c; w[0] = v[i].x; w[1] = v[i].y; w[2] = v[i].z; w[3] = v[i].w; }
    LDS_WAIT(); asm volatile("" ::: "memory");
#pragma unroll
    for (int j = 0; j < 4; ++j) { const int n = (lane >> 3) + 8 * j; const LAS float* s = scr + (8 * c) * 33 + n;
        u32x4 o; o.x = cvt_pk_bf16(s[0 * 33] * g0.x, s[1 * 33] * g0.y); o.y = cvt_pk_bf16(s[2 * 33] * g0.z, s[3 * 33] * g0.w); o.z = cvt_pk_bf16(s[4 * 33] * g1.x, s[5 * 33] * g1.y); o.w = cvt_pk_bf16(s[6 * 33] * g1.z, s[7 * 33] * g1.w);
        *(u32x4*)(d.dst + (size_t)n * d.K + 8 * c) = o; }
    LDS_WAIT(); asm volatile("" ::: "memory");
}
#define TR_JOB(W_, ldn_, K_, nsrc0_, ncols_, WT_, rdst0_, gain_) { constexpr int nnb_ = (ncols_) / 32, nit_ = ((K_) / 64) * nnb_; \
    if (r < nit_) { const int kb_ = r / nnb_, nb_ = r % nnb_; const float* g_ = (gain_); \
        return TrDesc{(W_) + (size_t)(64 * kb_) * (ldn_) + (nsrc0_) + 32 * nb_, (WT_) + (size_t)((rdst0_) + 32 * nb_) * (K_) + 64 * kb_, g_ ? g_ + 64 * kb_ : nullptr, (ldn_), (K_)}; } r -= nit_; }
#define TR_JOB_GU(W_, WT_, off_, gain_) { constexpr int nnb_ = DFF / 32, nit_ = (DM / 64) * nnb_; \
    if (r < nit_) { const int kb_ = r / nnb_, nb_ = r % nnb_, c0_ = 32 * nb_; \
        return TrDesc{(W_) + (size_t)(64 * kb_) * DFF + c0_, (WT_) + (size_t)(256 * (c0_ / 128) + (c0_ % 128) + (off_)) * DM + 64 * kb_, (gain_) + 64 * kb_, DFF, DM}; } r -= nit_; }

__device__ __forceinline__ void rms_row_bf16(const float* xrow, const float* g, bf16_t* orow, int lane) {
    const f32x4* xr = (const f32x4*)xrow + lane; const f32x4* gr = (const f32x4*)g + lane;
    f32x4 v[16]; float s = 0.f;
#pragma unroll
    for (int j = 0; j < 16; ++j) { v[j] = xr[64 * j]; s += (v[j].x * v[j].x + v[j].y * v[j].y) + (v[j].z * v[j].z + v[j].w * v[j].w); }
    const float rstd = 1.0f / sqrtf(wave_sum(s) * (1.0f / DM) + EPS);
    u32x2* o8 = (u32x2*)orow + lane;
#pragma unroll
    for (int j = 0; j < 16; ++j) { const f32x4 gg = gr[64 * j]; u32x2 w; w.x = cvt_pk_bf16(v[j].x * rstd * gg.x, v[j].y * rstd * gg.y); w.y = cvt_pk_bf16(v[j].z * rstd * gg.z, v[j].w * rstd * gg.w); o8[64 * j] = w; }
}
__device__ __forceinline__ void rms_row_f32(const float* xrow, const float* g, float* orow, int lane) {
    const f32x4* xr = (const f32x4*)xrow + lane; const f32x4* gr = (const f32x4*)g + lane;
    f32x4 v[16]; float s = 0.f;
#pragma unroll
    for (int j = 0; j < 16; ++j) { v[j] = xr[64 * j]; s += (v[j].x * v[j].x + v[j].y * v[j].y) + (v[j].z * v[j].z + v[j].w * v[j].w); }
    const float rstd = 1.0f / sqrtf(wave_sum(s) * (1.0f / DM) + EPS);
    f32x4* o = (f32x4*)orow + lane;
#pragma unroll
    for (int j = 0; j < 16; ++j) { const f32x4 gg = gr[64 * j]; o[64 * j] = v[j] * rstd * gg; }
}
__device__ __forceinline__ void phase_final_norm(const bf16_t* Hb, const unsigned long long* ssq, const float* g, float* out, int gw, int ngw, int lane) {
    for (int m = gw; m < MTOK; m += ngw) { const float rstd = 1.0f / sqrtf((float)ssq[m] * (1.0f / 16777216.0f) * (1.0f / DM) + EPS);
        const u32x4* xr = (const u32x4*)(Hb + (size_t)m * DM) + lane; f32x4* o = (f32x4*)(out + (size_t)m * DM); const f32x4* gr = (const f32x4*)g;
#pragma unroll
        for (int j = 0; j < 8; ++j) { const u32x4 r = xr[64 * j]; const int c4 = 2 * (64 * j + lane);
            const f32x4 g0 = gr[c4], g1 = gr[c4 + 1];
            o[c4] = (f32x4){bflo(r.x) * rstd * g0.x, bfhi(r.x) * rstd * g0.y, bflo(r.y) * rstd * g0.z, bfhi(r.y) * rstd * g0.w};
            o[c4 + 1] = (f32x4){bflo(r.z) * rstd * g1.x, bfhi(r.z) * rstd * g1.y, bflo(r.w) * rstd * g1.z, bfhi(r.w) * rstd * g1.w}; } }
}
__device__ __forceinline__ void phase_rms_bf16(const float* src, const float* g, bf16_t* dst, int gw, int ngw, int lane) {
    for (int m = gw; m < MTOK; m += ngw) rms_row_bf16(src + (size_t)m * DM, g, dst + (size_t)m * DM, lane);
}

constexpr int P0_I_AB = (DM / 64) * (6144 / 32), P0_I_SQ = (DM / 64) * (DM / 32), P0_I_CD = (DM / 64) * (CD_IN / 32), P0_I_GU = (DM / 64) * (DFF / 32), P0_I_DN = (DFF / 64) * (DM / 32), P0_I_RG = 16 * (256 / 64) * (256 / 32);
#ifndef TAILKB
#define TAILKB 172
#endif
constexpr int P0_I_DN1 = (DFF / 64 - TAILKB) * (DM / 32), TAIL_ITEMS = TAILKB * (DM / 32);
constexpr int P0_NITEMS = 2 * P0_I_AB + 1 * P0_I_SQ + P0_I_CD + 4 * P0_I_GU + 1 * P0_I_DN + P0_I_DN1 + P0_I_RG;
__device__ __forceinline__ TrDesc p0_item(const Params& p, int it) {
    unsigned char* ws = p.ws;
    bf16_t* WAB_IN = (bf16_t*)(ws + WS_WAB_IN); bf16_t* WAB_OUT = (bf16_t*)(ws + WS_WAB_OUT); bf16_t* WGU0 = (bf16_t*)(ws + WS_WGU0); bf16_t* WDN0 = (bf16_t*)(ws + WS_WDN0);
    bf16_t* WCD_IN = (bf16_t*)(ws + WS_WCD_IN); bf16_t* WGU1 = (bf16_t*)(ws + WS_WGU1);
    bf16_t* WRG = (bf16_t*)(ws + WS_WRG);
    int r = it;
    TR_JOB(p.ab_w_in, AB_IN, DM, 0, 6144, WAB_IN, 0, (const float*)nullptr)
    TR_JOB(p.ab_w_in, AB_IN, DM, 6160, 6144, WAB_IN, 6144, (const float*)nullptr)
    TR_JOB(p.ab_w_out, DM, DM, 0, DM, WAB_OUT, 0, (const float*)nullptr)
    TR_JOB_GU(p.ffn_w_gate, WGU0, 0, p.norm_ffn)
    TR_JOB_GU(p.ffn_w_up, WGU0, 128, p.norm_ffn)
    TR_JOB(p.ffn_w_down, DM, DFF, 0, DM, WDN0, 0, (const float*)nullptr)
    TR_JOB(p.cd_w_in, CD_IN, DM, 0, CD_IN, WCD_IN, 0, p.norm_mix + DM)
    TR_JOB_GU(p.ffn_w_gate + (size_t)DM * DFF, WGU1, 0, p.norm_ffn + DM)
    TR_JOB_GU(p.ffn_w_up + (size_t)DM * DFF, WGU1, 128, p.norm_ffn + DM)
    { constexpr int nnb_ = DM / 32; if (r < P0_I_DN1) { const int kb_ = TAILKB + r / nnb_, nb_ = r % nnb_;
        return TrDesc{p.ffn_w_down + (size_t)DFF * DM + (size_t)(64 * kb_) * DM + 32 * nb_, (bf16_t*)(ws + WS_WDN1) + (size_t)(32 * nb_) * DFF + 64 * kb_, nullptr, DM, DFF}; } r -= P0_I_DN1; }
    const int mat = r / 32, rr = r % 32, kb_ = rr / 8, nb_ = rr % 8;
    const float* W = (mat < 8 ? p.rg_w_x : p.rg_w_a) + (size_t)(mat & 7) * 65536;
    return TrDesc{W + (size_t)(64 * kb_) * 256 + 32 * nb_, WRG + (size_t)mat * 65536 + (size_t)(32 * nb_) * 256 + 64 * kb_, nullptr, 256, 256};
}
template <class F> __device__ __forceinline__ void tr_run(F item, int first, int step, int n, LAS float* scr, int lane) {
    if (first >= n) return;
    TrDesc cur = item(first); f32x4 va[8], vb[8];
    tr_load(cur, va, lane);
    for (int it = first; it < n; it += 2 * step) {
        const bool h1 = it + step < n, h2 = it + 2 * step < n;
        TrDesc nx = cur; if (h1) { nx = item(it + step); tr_load(nx, vb, lane); }
        tr_finish(cur, va, scr, lane);
        if (h2) { cur = item(it + 2 * step); tr_load(cur, va, lane); }
        if (h1) tr_finish(nx, vb, scr, lane);
    }
}
struct TailItem { const float* W; bf16_t* WT; const float* W2; bf16_t* WT2;
    __device__ __forceinline__ TrDesc operator()(int r) const { constexpr int nnb = DM / 32;
        if (r < TAIL_ITEMS) { const int kb = r / nnb, nb = r % nnb; return TrDesc{W + (size_t)(64 * kb) * DM + 32 * nb, WT + (size_t)(32 * nb) * DFF + 64 * kb, nullptr, DM, DFF}; }
        r -= TAIL_ITEMS; const int kb = r / nnb, nb = r % nnb; return TrDesc{W2 + (size_t)(64 * kb) * DM + 32 * nb, WT2 + (size_t)(32 * nb) * DM + 64 * kb, nullptr, DM, DM}; } };
struct P0Item { const Params* p; __device__ __forceinline__ TrDesc operator()(int r) const { return p0_item(*p, r); } };
__device__ __forceinline__ void tail_convert(const Params& p, LAS unsigned char* lds, int tw, int ntw, int wave, int lane) {
    TailItem ti{p.ffn_w_down + (size_t)DFF * DM, (bf16_t*)(p.ws + WS_WDN1), p.cd_w_out, (bf16_t*)(p.ws + WS_WCD_OUT)};
    tr_run(ti, tw, ntw, TAIL_ITEMS + P0_I_SQ, (LAS float*)(lds + wave * 8704), lane);
}
__device__ __forceinline__ void phase_p0(const Params& p, LAS unsigned char* lds, int gw, int ngw, int wave, int lane) {
    unsigned char* ws = p.ws;
    LAS float* scr = (LAS float*)(lds + wave * 8704);
    { P0Item pi{&p}; tr_run(pi, gw, ngw, P0_NITEMS, scr, lane); }
    { bf16_t* WS_ = (bf16_t*)(ws + WS_WSMALL);
      for (int i = gw * 64 + lane; i < 32 * DM; i += ngw * 64) { const int c = i & 31, k = i >> 5; const int sc = c < 16 ? 6144 + c : 12304 + (c - 16);
          WS_[(size_t)c * DM + k] = f2bf(p.ab_w_in[(size_t)k * AB_IN + sc]); } }
    phase_rms_bf16(p.x, p.norm_mix, (bf16_t*)(ws + WS_U), gw, ngw, lane);
}

__device__ __forceinline__ void phase_small32(const Params& p, LAS unsigned char* lds, int wave, int lane) {
    const bf16_t* U = (const bf16_t*)(p.ws + WS_U); const bf16_t* WS_ = (const bf16_t*)(p.ws + WS_WSMALL); float* S32 = (float*)(p.ws + WS_SMALL32);
    LAS float* red = (LAS float*)lds;
    const int h = lane >> 5, c = lane & 31;
    for (int unit = blockIdx.x; unit < MTOK / 32; unit += gridDim.x) {
        const int row0 = unit * 32, kbase = wave * 512;
        f32x16 acc; for (int i = 0; i < 16; ++i) acc[i] = 0.f;
        const bf16_t* ap = U + (size_t)(row0 + c) * DM + kbase + 8 * h; const bf16_t* bp = WS_ + (size_t)c * DM + kbase + 8 * h;
#pragma unroll 8
        for (int s = 0; s < 32; ++s) { const bf16x8 a = *(const bf16x8*)(ap + 16 * s), b = *(const bf16x8*)(bp + 16 * s); acc = MFMA32(a, b, acc); }
#pragma unroll
        for (int r = 0; r < 16; ++r) red[(wave * 32 + crow(r, h)) * 33 + c] = acc[r];
        __syncthreads();
        for (int i = threadIdx.x; i < 1024; i += NTHR) { const int t = i >> 5, cc = i & 31; float s = 0.f;
#pragma unroll
            for (int w = 0; w < 8; ++w) s += red[(w * 32 + t) * 33 + cc];
            S32[(size_t)(row0 + t) * 32 + cc] = s; }
        __syncthreads();
    }
}

__device__ __forceinline__ void phase_fox_cumsum(const Params& p, int gw, int ngw, int lane) {
    const float* S32 = (const float*)(p.ws + WS_SMALL32); float* CF = (float*)(p.ws + WS_CF);
    for (int u = gw; u < NB * 16; u += ngw) { const int b = u >> 4, hd = u & 15; const float bias = p.fox_b_f[hd];
        float v[32]; float run = 0.f;
#pragma unroll
        for (int i = 0; i < 32; ++i) { const int t = 32 * lane + i; run += log_sigmoid_acc(S32[(size_t)(b * SEQ + t) * 32 + 16 + hd] + bias); v[i] = run; }
        float incl = run;
#pragma unroll
        for (int o = 1; o < 64; o <<= 1) { const float t = __shfl_up(incl, o); if (lane >= o) incl += t; }
        const float off = incl - run;
#pragma unroll
        for (int i = 0; i < 32; ++i) CF[(size_t)u * SEQ + 32 * lane + i] = v[i] + off;
    }
}

constexpr int GP_PITCH = 528;
__device__ __forceinline__ void phase_gla_pre(const Params& p, LAS unsigned char* lds, int wave, int lane) {
    const unsigned char* ws = p.ws;
    const bf16_t* PROJ = (const bf16_t*)(ws + WS_PROJ); const float* S32 = (const float*)(ws + WS_SMALL32);
    bf16_t* QT = (bf16_t*)(ws + WS_QT); bf16_t* KDT = (bf16_t*)(ws + WS_KDT); bf16_t* PM = (bf16_t*)(ws + WS_PM); float* GDEC = (float*)(ws + WS_GDEC);
    LAS float* G = (LAS float*)lds;
    LAS float* TOT = (LAS float*)(lds + 4096);
    LAS unsigned char* QTl = lds + 8192;
    LAS unsigned char* KTl = lds + 8192 + 64 * GP_PITCH;
    const int tid = threadIdx.x, k = tid & 255, th = tid >> 8, h = lane >> 5;
    for (int unit = blockIdx.x; unit < NB * 4 * 32; unit += gridDim.x) {
        const int b = unit >> 7, hd = (unit >> 5) & 3, c = unit & 31, R0 = b * SEQ + 64 * c;
        for (int i = tid; i < 1024; i += NTHR) G[i] = S32[(size_t)(R0 + (i >> 4)) * 32 + (i & 15)];
        float w[16];
#pragma unroll
        for (int r = 0; r < 16; ++r) w[r] = p.gla_w_gate_up[r * 1024 + hd * 256 + k];
        const float bias = p.gla_b_gate[hd * 256 + k];
        __syncthreads();
        float bc[32]; float run = 0.f;
#pragma unroll
        for (int tt = 0; tt < 32; ++tt) { const LAS f32x4* g4 = (const LAS f32x4*)(G + (32 * th + tt) * 16); float xx = bias;
#pragma unroll
            for (int q4 = 0; q4 < 4; ++q4) { const f32x4 gv = g4[q4]; xx += gv.x * w[4 * q4] + gv.y * w[4 * q4 + 1] + gv.z * w[4 * q4 + 2] + gv.w * w[4 * q4 + 3]; }
            run += log_sigmoid_acc(xx) * (1.0f / 16.0f); bc[tt] = run; }
        TOT[th * 256 + k] = run;
        __syncthreads();
        const float t0 = TOT[k], t1 = TOT[256 + k], blast = t0 + t1, boff = th ? t0 : 0.f;
        if (th == 0) GDEC[(size_t)unit * 256 + k] = expf(blast);
        const bf16_t* qp = PROJ + (size_t)(R0 + 32 * th) * AB_MAIN + PJ_GQ + hd * 256 + k; const bf16_t* kp = PROJ + (size_t)(R0 + 32 * th) * AB_MAIN + PJ_GK + hd * 256 + k;
        bf16_t* qto = QT + (size_t)(R0 + 32 * th) * 1024 + hd * 256 + k;
        bf16_t* kdo = KDT + ((size_t)unit * 256 + k) * 64 + 32 * th;
#pragma unroll
        for (int t8 = 0; t8 < 4; ++t8) { float kd[8];
#pragma unroll
            for (int i = 0; i < 8; ++i) { const int tt = 8 * t8 + i; const float bb = bc[tt] + boff;
                const float qv = bf2f(qp[(size_t)tt * AB_MAIN]), kv = bf2f(kp[(size_t)tt * AB_MAIN]);
                const float qt = qv * 0.0625f * expf(bb), kt = kv * expf(-bb); kd[i] = kv * expf(blast - bb);
                const bf16_t qb = f2bf(qt);
                *(LAS bf16_t*)(QTl + (32 * th + tt) * GP_PITCH + 2 * k) = qb; *(LAS bf16_t*)(KTl + (32 * th + tt) * GP_PITCH + 2 * k) = f2bf(kt);
                qto[(size_t)tt * 1024] = qb; }
            u32x4 o; o.x = cvt_pk_bf16(kd[0], kd[1]); o.y = cvt_pk_bf16(kd[2], kd[3]); o.z = cvt_pk_bf16(kd[4], kd[5]); o.w = cvt_pk_bf16(kd[6], kd[7]);
            *(u32x4*)(kdo + 8 * t8) = o; }
        __syncthreads();
        if (wave < 4) { const int ti = wave & 1, si = wave >> 1;
            f32x16 acc; for (int i = 0; i < 16; ++i) acc[i] = 0.f;
            const LAS unsigned char* ap = QTl + (32 * ti + (lane & 31)) * GP_PITCH + 16 * h; const LAS unsigned char* bp = KTl + (32 * si + (lane & 31)) * GP_PITCH + 16 * h;
#pragma unroll
            for (int s = 0; s < 16; ++s) { const bf16x8 a = *(const LAS bf16x8*)(ap + 32 * s), bb = *(const LAS bf16x8*)(bp + 32 * s); acc = MFMA32(a, bb, acc); }
            const int sc = 32 * si + (lane & 31);
#pragma unroll
            for (int r = 0; r < 16; ++r) { const int t = 32 * ti + crow(r, h); PM[(size_t)unit * 4096 + t * 64 + sc] = f2bf(sc <= t ? acc[r] : 0.f); }
        }
        __syncthreads();
    }
}

constexpr int VT_PITCH = 144;
struct GlaChunk { u32x2 vraw; bf16x8 qa00, qa01, qa10, qa11, kd0, kd1, kd2, kd3, pa; f32x4 gd0, gd1, gd2, gd3; };
__device__ __forceinline__ void gla_load_chunk(GlaChunk& r, const bf16_t* PROJ, const bf16_t* QT, const bf16_t* KDT, const bf16_t* PM, const float* GDEC, int b, int hd, int v0, int c, int wave, int tid, int h, int l31) {
    const int R0 = b * SEQ + 64 * c, cu = (b * 4 + hd) * 32 + c;
    { const int s = tid >> 3, v4 = (tid & 7) * 4; r.vraw = *(const u32x2*)(PROJ + (size_t)(R0 + s) * AB_MAIN + PJ_GV + hd * 512 + v0 + v4); }
    { const bf16_t* q0 = QT + (size_t)(R0 + l31) * 1024 + hd * 256 + 32 * wave + 4 * h; const bf16_t* q1 = q0 + (size_t)32 * 1024;
      r.qa00 = cat4(*(const s16x4*)q0, *(const s16x4*)(q0 + 8)); r.qa01 = cat4(*(const s16x4*)(q0 + 16), *(const s16x4*)(q0 + 24));
      r.qa10 = cat4(*(const s16x4*)q1, *(const s16x4*)(q1 + 8)); r.qa11 = cat4(*(const s16x4*)(q1 + 16), *(const s16x4*)(q1 + 24)); }
    { const bf16_t* kp = KDT + ((size_t)cu * 256 + 32 * wave + l31) * 64 + 8 * h;
      r.kd0 = *(const bf16x8*)kp; r.kd1 = *(const bf16x8*)(kp + 16); r.kd2 = *(const bf16x8*)(kp + 32); r.kd3 = *(const bf16x8*)(kp + 48); }
    r.pa = *(const bf16x8*)(PM + (size_t)cu * 4096 + (32 * (wave & 1) + l31) * 64 + 16 * (wave >> 1) + 8 * h);
    { const float* gp = GDEC + (size_t)cu * 256 + 32 * wave + 4 * h; r.gd0 = *(const f32x4*)gp; r.gd1 = *(const f32x4*)(gp + 8); r.gd2 = *(const f32x4*)(gp + 16); r.gd3 = *(const f32x4*)(gp + 24); }
}
__device__ __forceinline__ void phase_gla_seq(const Params& p, LAS unsigned char* lds, int wave, int lane) {
    const unsigned char* ws = p.ws;
    const bf16_t* PROJ = (const bf16_t*)(ws + WS_PROJ); const bf16_t* QT = (const bf16_t*)(ws + WS_QT); const bf16_t* KDT = (const bf16_t*)(ws + WS_KDT); const bf16_t* PM = (const bf16_t*)(ws + WS_PM);
    const float* GDEC = (const float*)(ws + WS_GDEC); float* ORAW = (float*)(p.ws + WS_ORAW); float* SSQ = (float*)(p.ws + WS_SSQ);
    LAS float* RED = (LAS float*)lds;
    LAS unsigned char* VT = lds + 65536;
    const int tid = threadIdx.x, h = lane >> 5, l31 = lane & 31;
    for (int unit = blockIdx.x; unit < NB * 4 * 16; unit += gridDim.x) {
        const int b = unit >> 6, hd = (unit >> 4) & 3, vs = unit & 15, v0 = 32 * vs;
        f32x16 S; for (int i = 0; i < 16; ++i) S[i] = 0.f;
        GlaChunk cur, nxt;
        gla_load_chunk(cur, PROJ, QT, KDT, PM, GDEC, b, hd, v0, 0, wave, tid, h, l31);
        nxt = cur;
        for (int c = 0; c < 32; ++c) {
            const int R0 = b * SEQ + 64 * c;
            LAS unsigned char* vt = VT + (c & 1) * (32 * VT_PITCH);
            { const int s = tid >> 3, v4 = (tid & 7) * 4; const u32x2 raw = cur.vraw;
              *(LAS bf16_t*)(vt + (v4 + 0) * VT_PITCH + 2 * s) = (bf16_t)(raw.x & 0xffffu); *(LAS bf16_t*)(vt + (v4 + 1) * VT_PITCH + 2 * s) = (bf16_t)(raw.x >> 16);
              *(LAS bf16_t*)(vt + (v4 + 2) * VT_PITCH + 2 * s) = (bf16_t)(raw.y & 0xffffu); *(LAS bf16_t*)(vt + (v4 + 3) * VT_PITCH + 2 * s) = (bf16_t)(raw.y >> 16); }
            if (c + 1 < 32) gla_load_chunk(nxt, PROJ, QT, KDT, PM, GDEC, b, hd, v0, c + 1, wave, tid, h, l31);
            __syncthreads();
            const int tip = wave & 1, ssp = wave >> 1;
            f32x16 oacc[2];
#pragma unroll
            for (int ti = 0; ti < 2; ++ti) for (int i = 0; i < 16; ++i) oacc[ti][i] = 0.f;
            const bf16x8 sb0 = pack8(S[0], S[1], S[2], S[3], S[4], S[5], S[6], S[7]), sb1 = pack8(S[8], S[9], S[10], S[11], S[12], S[13], S[14], S[15]);
            oacc[0] = MFMA32(cur.qa00, sb0, oacc[0]); oacc[0] = MFMA32(cur.qa01, sb1, oacc[0]);
            oacc[1] = MFMA32(cur.qa10, sb0, oacc[1]); oacc[1] = MFMA32(cur.qa11, sb1, oacc[1]);
            bf16x8 vb[4];
#pragma unroll
            for (int ss = 0; ss < 4; ++ss) vb[ss] = *(const LAS bf16x8*)(vt + l31 * VT_PITCH + 32 * ss + 16 * h);
            { const bf16x8 vbp = ssp == 0 ? vb[0] : ssp == 1 ? vb[1] : ssp == 2 ? vb[2] : vb[3];
              if (tip == 0) oacc[0] = MFMA32(cur.pa, vbp, oacc[0]); else oacc[1] = MFMA32(cur.pa, vbp, oacc[1]); }
#pragma unroll
            for (int i = 0; i < 4; ++i) { S[i] *= cur.gd0[i]; S[4 + i] *= cur.gd1[i]; S[8 + i] *= cur.gd2[i]; S[12 + i] *= cur.gd3[i]; }
            S = MFMA32(cur.kd0, vb[0], S); S = MFMA32(cur.kd1, vb[1], S); S = MFMA32(cur.kd2, vb[2], S); S = MFMA32(cur.kd3, vb[3], S);
#pragma unroll
            for (int ti = 0; ti < 2; ++ti)
#pragma unroll
                for (int r = 0; r < 16; ++r) RED[(wave * 64 + 32 * ti + crow(r, h)) * 32 + l31] = oacc[ti][r];
            __syncthreads();
            { const int t = tid >> 3, v4 = (tid & 7) * 4; f32x4 o = {0.f, 0.f, 0.f, 0.f};
#pragma unroll
              for (int w = 0; w < 8; ++w) o += *(const LAS f32x4*)(RED + (w * 64 + t) * 32 + v4);
              *(f32x4*)(ORAW + (size_t)(R0 + t) * 2048 + hd * 512 + v0 + v4) = o;
              float q = (o.x * o.x + o.y * o.y) + (o.z * o.z + o.w * o.w);
              q += __shfl_xor(q, 1); q += __shfl_xor(q, 2); q += __shfl_xor(q, 4);
              if ((tid & 7) == 0) SSQ[(size_t)(R0 + t) * 64 + hd * 16 + vs] = q; }
            cur = nxt;
        }
        __syncthreads();
    }
}

__device__ __forceinline__ void phase_gla_post(const Params& p, int gw, int ngw, int lane) {
    const bf16_t* PROJ = (const bf16_t*)(p.ws + WS_PROJ); const float* ORAW = (const float*)(p.ws + WS_ORAW); const float* SSQ = (const float*)(p.ws + WS_SSQ); bf16_t* O = (bf16_t*)(p.ws + WS_O);
    const f32x4 gn0 = *(const f32x4*)(p.gla_norm + 8 * lane), gn1 = *(const f32x4*)(p.gla_norm + 8 * lane + 4);
    for (int u = gw; u < MTOK * 4; u += ngw) { const int row = u >> 2, hd = u & 3;
        float ss = 0.f;
#pragma unroll
        for (int i = 0; i < 4; ++i) { const f32x4 s4 = *(const f32x4*)(SSQ + (size_t)row * 64 + hd * 16 + 4 * i); ss += (s4.x + s4.y) + (s4.z + s4.w); }
        const float rstd = 1.0f / sqrtf(ss * (1.0f / 512.0f) + EPS);
        const f32x4 o0 = *(const f32x4*)(ORAW + (size_t)row * 2048 + hd * 512 + 8 * lane), o1 = *(const f32x4*)(ORAW + (size_t)row * 2048 + hd * 512 + 8 * lane + 4);
        const u32x4 gr = *(const u32x4*)(PROJ + (size_t)row * AB_MAIN + PJ_GG + hd * 512 + 8 * lane);
        float g[8] = {bflo(gr.x), bfhi(gr.x), bflo(gr.y), bfhi(gr.y), bflo(gr.z), bfhi(gr.z), bflo(gr.w), bfhi(gr.w)};
        float o[8] = {o0.x * gn0.x, o0.y * gn0.y, o0.z * gn0.z, o0.w * gn0.w, o1.x * gn1.x, o1.y * gn1.y, o1.z * gn1.z, o1.w * gn1.w};
#pragma unroll
        for (int i = 0; i < 8; ++i) o[i] = o[i] * rstd * g[i] / (1.0f + __expf(-g[i]));
        u32x4 w; w.x = cvt_pk_bf16(o[0], o[1]); w.y = cvt_pk_bf16(o[2], o[3]); w.z = cvt_pk_bf16(o[4], o[5]); w.w = cvt_pk_bf16(o[6], o[7]);
        *(u32x4*)(O + (size_t)row * DM + hd * 512 + 8 * lane) = w; }
}

constexpr int AK_PITCH = 272, AV_PITCH = 320;
constexpr int AK_BYTES = 64 * AK_PITCH, AV_BYTES = 64 * AV_PITCH;
constexpr int A_KOFF = 0, A_VOFF = 2 * AK_BYTES, A_COFF = A_VOFF + 2 * AV_BYTES, A_FLAGS = A_COFF + 512;
constexpr float ATT_SCALE = 0.08838834764831845f;
constexpr float LOG2E = 1.4426950408889634f;

struct AttnIO { const bf16_t* Q; const bf16_t* K; const bf16_t* V; int ld; bf16_t* O; int ldo; };

__device__ __forceinline__ void attn_stage_load(const AttnIO& io, size_t rowbase, int hd, int key0, u32x4 (&kr)[2], u32x4 (&vr)[2], int tid) {
#pragma unroll
    for (int i = 0; i < 2; ++i) { const int idx = tid + NTHR * i, r = idx >> 4, ch = idx & 15; const size_t off = (rowbase + key0 + r) * (size_t)io.ld + hd * 128 + ch * 8;
        kr[i] = *(const u32x4*)(io.K + off); vr[i] = *(const u32x4*)(io.V + off); }
}
__device__ __forceinline__ void attn_stage_store(LAS unsigned char* lds, int buf, const u32x4 (&kr)[2], const u32x4 (&vr)[2], int tid) {
#pragma unroll
    for (int i = 0; i < 2; ++i) { const int idx = tid + NTHR * i, r = idx >> 4, ch = idx & 15;
        *(LAS u32x4*)(lds + A_KOFF + buf * AK_BYTES + r * AK_PITCH + ch * 16) = kr[i]; *(LAS u32x4*)(lds + A_VOFF + buf * AV_BYTES + r * AV_PITCH + ch * 16) = vr[i]; }
}
__device__ __forceinline__ void attn_qk(LAS unsigned char* lds, int buf, const bf16x8 (&qf)[8], f32x16& s0, f32x16& s1, int lane) {
    const LAS unsigned char* kp = lds + A_KOFF + buf * AK_BYTES + (lane & 31) * AK_PITCH + (lane >> 5) * 16;
    for (int i = 0; i < 16; ++i) { s0[i] = 0.f; s1[i] = 0.f; }
#pragma unroll
    for (int s = 0; s < 8; ++s) { const bf16x8 a0 = *(const LAS bf16x8*)(kp + 32 * s), a1 = *(const LAS bf16x8*)(kp + 32 * AK_PITCH + 32 * s);
        s0 = MFMA32(a0, qf[s], s0); s1 = MFMA32(a1, qf[s], s1); }
}
__device__ __forceinline__ void attn_pv(LAS unsigned char* lds, int buf, const f32x16& p0, const f32x16& p1, f32x16 (&o)[4], int lane) {
    const lds_cptr vp = (lds_cptr)(lds + A_VOFF + buf * AV_BYTES + (4 * (lane >> 5) + ((lane & 15) >> 2)) * AV_PITCH + (((lane >> 4) & 1) * 16 + (lane & 3) * 4) * 2);
    const bf16x8 pf00 = pack8(p0[0], p0[1], p0[2], p0[3], p0[4], p0[5], p0[6], p0[7]), pf01 = pack8(p0[8], p0[9], p0[10], p0[11], p0[12], p0[13], p0[14], p0[15]);
    const bf16x8 pf10 = pack8(p1[0], p1[1], p1[2], p1[3], p1[4], p1[5], p1[6], p1[7]), pf11 = pack8(p1[8], p1[9], p1[10], p1[11], p1[12], p1[13], p1[14], p1[15]);
#pragma unroll
    for (int dt = 0; dt < 4; ++dt) {
        const bf16x8 a00 = cat4(vtr(vp + (0) * AV_PITCH + dt * 64), vtr(vp + (8) * AV_PITCH + dt * 64));
        const bf16x8 a01 = cat4(vtr(vp + (16) * AV_PITCH + dt * 64), vtr(vp + (24) * AV_PITCH + dt * 64));
        const bf16x8 a10 = cat4(vtr(vp + (32) * AV_PITCH + dt * 64), vtr(vp + (40) * AV_PITCH + dt * 64));
        const bf16x8 a11 = cat4(vtr(vp + (48) * AV_PITCH + dt * 64), vtr(vp + (56) * AV_PITCH + dt * 64));
        o[dt] = MFMA32(a00, pf00, o[dt]); o[dt] = MFMA32(a01, pf01, o[dt]); o[dt] = MFMA32(a10, pf10, o[dt]); o[dt] = MFMA32(a11, pf11, o[dt]);
    }
}
__device__ __forceinline__ void attn_store_o(const AttnIO& io, size_t row, int hd, const f32x16 (&o)[4], float scl, int lane) {
    bf16_t* op = io.O + row * (size_t)io.ldo + hd * 128 + 4 * (lane >> 5);
#pragma unroll
    for (int dt = 0; dt < 4; ++dt)
#pragma unroll
        for (int g = 0; g < 4; ++g) { u32x2 w; w.x = cvt_pk_bf16(o[dt][4 * g] * scl, o[dt][4 * g + 1] * scl); w.y = cvt_pk_bf16(o[dt][4 * g + 2] * scl, o[dt][4 * g + 3] * scl);
            *(u32x2*)(op + 32 * dt + 8 * g) = w; }
}

__device__ __forceinline__ void fox_unit(const AttnIO& io, const float* CF, LAS unsigned char* lds, int b, int hd, int qb, int wave, int lane) {
    const int tid = threadIdx.x, h = lane >> 5, l31 = lane & 31;
    const size_t rowbase = (size_t)b * SEQ; const int q0w = 256 * qb + 32 * wave, qpos = q0w + l31;
    const float* cf = CF + (size_t)(b * 16 + hd) * SEQ;
    bf16x8 qf[8];
#pragma unroll
    for (int s = 0; s < 8; ++s) qf[s] = *(const bf16x8*)(io.Q + (rowbase + qpos) * (size_t)io.ld + hd * 128 + 16 * s + 8 * h);
    const float cq = cf[qpos] * LOG2E;
    f32x16 o[4];
#pragma unroll
    for (int dt = 0; dt < 4; ++dt) for (int i = 0; i < 16; ++i) o[dt][i] = 0.f;
    float m = -1e30f, l = 0.f;
    const int ntiles = 4 * qb + 4;
    u32x4 kr[2], vr[2];
    LAS float* cks = (LAS float*)(lds + A_COFF);
    attn_stage_load(io, rowbase, hd, 64 * (ntiles - 1), kr, vr, tid);
    attn_stage_store(lds, 0, kr, vr, tid);
    if (tid < 64) cks[tid] = cf[64 * (ntiles - 1) + tid] * LOG2E;
    __syncthreads();
    for (int jj = 0; jj < ntiles; ++jj) {
        const int j = ntiles - 1 - jj, buf = jj & 1; const bool more = jj + 1 < ntiles;
        float cnext = 0.f;
        if (more) { attn_stage_load(io, rowbase, hd, 64 * (j - 1), kr, vr, tid); if (tid < 64) cnext = cf[64 * (j - 1) + tid] * LOG2E; }
        if (64 * j <= q0w + 31) {
            f32x16 s0, s1; attn_qk(lds, buf, qf, s0, s1, lane);
            const LAS float* ck = cks + buf * 64;
            const bool diag = 64 * j + 63 > q0w;
            float mx = -__builtin_inff();
#pragma unroll
            for (int g = 0; g < 4; ++g) { const f32x4 c0 = *(const LAS f32x4*)(ck + 8 * g + 4 * h), c1 = *(const LAS f32x4*)(ck + 32 + 8 * g + 4 * h);
#pragma unroll
                for (int i = 0; i < 4; ++i) { const int r = 4 * g + i, key = 64 * j + 8 * g + 4 * h + i;
                    float y0 = s0[r] * (ATT_SCALE * LOG2E) + (cq - c0[i]), y1 = s1[r] * (ATT_SCALE * LOG2E) + (cq - c1[i]);
                    if (diag) { y0 = key <= qpos ? y0 : -__builtin_inff(); y1 = key + 32 <= qpos ? y1 : -__builtin_inff(); }
                    s0[r] = y0; s1[r] = y1; mx = fmaxf(mx, fmaxf(y0, y1)); } }
            mx = fmaxf(mx, __shfl_xor(mx, 32));
            if (!__all(mx - m <= 8.0f)) {
                const float mn = fmaxf(m, mx), alpha = __builtin_amdgcn_exp2f(m - mn); m = mn; l *= alpha;
#pragma unroll
                for (int dt = 0; dt < 4; ++dt) for (int i = 0; i < 16; ++i) o[dt][i] *= alpha;
            }
            float ps = 0.f;
#pragma unroll
            for (int r = 0; r < 16; ++r) { s0[r] = __builtin_amdgcn_exp2f(s0[r] - m); s1[r] = __builtin_amdgcn_exp2f(s1[r] - m); ps += s0[r] + s1[r]; }
            l += ps;
            attn_pv(lds, buf, s0, s1, o, lane);
        }
        if (more) { attn_stage_store(lds, buf ^ 1, kr, vr, tid); if (tid < 64) cks[(buf ^ 1) * 64 + tid] = cnext; }
        __syncthreads();
    }
    l += __shfl_xor(l, 32);
    attn_store_o(io, rowbase + qpos, hd, o, 1.0f / l, lane);
}

__device__ __forceinline__ void sb_subtile(f32x16& s, int keybase, int qpos, int h, float& P, bool diag) {
    float be[16], om[16];
#pragma unroll
    for (int r = 0; r < 16; ++r) { const float z2 = s[r] * (ATT_SCALE * LOG2E); const float t = __builtin_amdgcn_exp2f(-fabsf(z2)); const float rr = __builtin_amdgcn_rcpf(1.0f + t), tr = t * rr;
        const bool pos = z2 >= 0.f; be[r] = pos ? rr : tr; om[r] = pos ? tr : rr;
        if (diag) { const bool valid = keybase + crow(r, h) < qpos; be[r] = valid ? be[r] : 0.f; om[r] = valid ? om[r] : 1.0f; } }
    float T[4], Tp[4];
#pragma unroll
    for (int g = 0; g < 4; ++g) { T[g] = (om[4 * g] * om[4 * g + 1]) * (om[4 * g + 2] * om[4 * g + 3]); Tp[g] = __shfl_xor(T[g], 32); }
    float run = P;
#pragma unroll
    for (int g = 3; g >= 0; --g) {
        const float off = h ? run : run * Tp[g];
        const float sf2 = om[4 * g + 3], sf1 = sf2 * om[4 * g + 2], sf0 = sf1 * om[4 * g + 1];
        s[4 * g + 3] = be[4 * g + 3] * off; s[4 * g + 2] = be[4 * g + 2] * (off * sf2); s[4 * g + 1] = be[4 * g + 1] * (off * sf1); s[4 * g] = be[4 * g] * (off * sf0);
        run *= T[g] * Tp[g];
    }
    P = run;
}
__device__ __forceinline__ void sb_unit(const AttnIO& io, LAS unsigned char* lds, int b, int hd, int qb, int wave, int lane) {
    const int tid = threadIdx.x, h = lane >> 5, l31 = lane & 31;
    const size_t rowbase = (size_t)b * SEQ; const int qpos = 256 * qb + 32 * wave + l31;
    bf16x8 qf[8];
#pragma unroll
    for (int s = 0; s < 8; ++s) qf[s] = *(const bf16x8*)(io.Q + (rowbase + qpos) * (size_t)io.ld + hd * 128 + 16 * s + 8 * h);
    f32x16 o[4];
#pragma unroll
    for (int dt = 0; dt < 4; ++dt) for (int i = 0; i < 16; ++i) o[dt][i] = 0.f;
    float R = 1.0f;
    bool wdone = false;
    const int ntiles = 4 * qb + 4;
    u32x4 kr[2], vr[2];
    LAS unsigned* flags = (LAS unsigned*)(lds + A_FLAGS);
    attn_stage_load(io, rowbase, hd, 64 * (ntiles - 1), kr, vr, tid);
    attn_stage_store(lds, 0, kr, vr, tid);
    __syncthreads();
    for (int jj = 0; jj < ntiles; ++jj) {
        const int j = ntiles - 1 - jj, buf = jj & 1; const bool more = jj + 1 < ntiles;
        if (more) attn_stage_load(io, rowbase, hd, 64 * (j - 1), kr, vr, tid);
        if (!wdone && 64 * j < 256 * qb + 32 * wave + 31) {
            f32x16 s0, s1; attn_qk(lds, buf, qf, s0, s1, lane);
            const bool diag = 64 * j + 63 >= 256 * qb + 32 * wave;
            sb_subtile(s1, 64 * j + 32, qpos, h, R, diag);
            sb_subtile(s0, 64 * j, qpos, h, R, diag);
            attn_pv(lds, buf, s0, s1, o, lane);
            wdone = __all(R == 0.0f);
        }
        if (more) attn_stage_store(lds, buf ^ 1, kr, vr, tid);
        if (lane == 0) flags[buf * 8 + wave] = wdone ? 1u : 0u;
        __syncthreads();
        { const u32x4 f0 = *(const LAS u32x4*)(flags + buf * 8), f1 = *(const LAS u32x4*)(flags + buf * 8 + 4);
          if ((f0.x & f0.y & f0.z & f0.w & f1.x & f1.y & f1.z & f1.w) != 0u) break; }
    }
    attn_store_o(io, rowbase + qpos, hd, o, 1.0f, lane);
}

constexpr int RG_XPITCH = 528;
constexpr int RG_XC = 0, RG_GX = 128 * RG_XPITCH, RG_GA = RG_GX + 128 * 32 * 4, RG_HB = RG_GA + 128 * 32 * 4, RG_CW = RG_HB + 128 * 32 * 4, RG_SPL = RG_CW + 5 * 256 * 4;
__device__ __forceinline__ float gelu_tanh(float x) { const float u = 0.7978845608028654f * (x + 0.044715f * x * x * x); const float e = __expf(2.0f * u); const float th = 1.0f - 2.0f * __builtin_amdgcn_rcpf(e + 1.0f); return 0.5f * x * (1.0f + th); }
__device__ __forceinline__ void rg_load_raw(const bf16_t* PROJ, size_t rowb, int T0, int tg, int cb, int cc, u32x4 (&raw)[11]) {
    const bf16_t* base = PROJ + (rowb + T0 + 8 * tg) * CD_IN + PJ_RX + cb + 8 * cc;
#pragma unroll
    for (int i = 0; i < 11; ++i) { const int t = T0 + 8 * tg - 3 + i; if (t >= 0) raw[i] = *(const u32x4*)(base + (ptrdiff_t)(i - 3) * CD_IN); else raw[i] = (u32x4){0u, 0u, 0u, 0u}; }
}
__device__ __forceinline__ void phase_rg(const Params& p, LAS unsigned char* lds, int wave, int lane) {
    const unsigned char* ws = p.ws;
    const bf16_t* PROJ = (const bf16_t*)(ws + WS_PROJ); const bf16_t* WRG = (const bf16_t*)(ws + WS_WRG); bf16_t* O = (bf16_t*)(p.ws + WS_O);
    const int tid = threadIdx.x, h = lane >> 5, l31 = lane & 31;
    LAS float* GX = (LAS float*)(lds + RG_GX); LAS float* GA = (LAS float*)(lds + RG_GA); LAS float* HB = (LAS float*)(lds + RG_HB); LAS float* CW = (LAS float*)(lds + RG_CW); LAS float* SPL = (LAS float*)(lds + RG_SPL);
    const int cc = tid & 31, tg = tid >> 5;
    const int et = tid >> 2, ej = (tid & 3) * 8;
    for (int unit = blockIdx.x; unit < NB * 8 * 8; unit += gridDim.x) {
        const int b = unit >> 6, g = (unit >> 3) & 7, js = unit & 7, cb = 256 * g, c0 = cb + 32 * js;
        const size_t rowb = (size_t)b * SEQ;
        const int gate = wave >> 2, ti = wave & 3;
        bf16x8 wf[16];
        { const bf16_t* wp = WRG + ((size_t)(gate * 8 + g) * 256 + 32 * js + l31) * 256 + 8 * h;
#pragma unroll
          for (int s = 0; s < 16; ++s) wf[s] = *(const bf16x8*)(wp + 16 * s); }
        const float gbias = (gate ? p.rg_b_a : p.rg_b_x)[c0 + l31];
        for (int i = tid; i < 5 * 256; i += NTHR) { const int j = i >> 8, c = i & 255; CW[i] = j < 4 ? p.rg_conv_w[j * 2048 + cb + c] : p.rg_conv_b[cb + c]; }
        if (tid < 32) { const float lam = p.rg_lambda[c0 + tid]; SPL[tid] = -8.0f * LOG2E * (fmaxf(-lam, 0.f) + log1pf(expf(-fabsf(lam)))); }
        u32x4 raw[11];
        rg_load_raw(PROJ, rowb, 0, tg, cb, cc, raw);
        float hstate = 0.f;
        __syncthreads();
        for (int tt = 0; tt < SEQ / 128; ++tt) {
            const int T0 = 128 * tt; const size_t R0 = rowb + T0;
            const u32x4 ryraw = *(const u32x4*)(PROJ + (R0 + et) * CD_IN + PJ_RY + c0 + ej);
            { float w0[8], w1[8], w2[8], w3[8], bb[8];
#pragma unroll
              for (int q = 0; q < 2; ++q) { const f32x4 a0 = *(const LAS f32x4*)(CW + 0 * 256 + 8 * cc + 4 * q), a1 = *(const LAS f32x4*)(CW + 1 * 256 + 8 * cc + 4 * q), a2 = *(const LAS f32x4*)(CW + 2 * 256 + 8 * cc + 4 * q),
                                                          a3 = *(const LAS f32x4*)(CW + 3 * 256 + 8 * cc + 4 * q), a4 = *(const LAS f32x4*)(CW + 4 * 256 + 8 * cc + 4 * q);
#pragma unroll
                  for (int e = 0; e < 4; ++e) { w0[4 * q + e] = a0[e]; w1[4 * q + e] = a1[e]; w2[4 * q + e] = a2[e]; w3[4 * q + e] = a3[e]; bb[4 * q + e] = a4[e]; } }
#pragma unroll
              for (int i = 0; i < 8; ++i) { float xo[8];
#pragma unroll
                  for (int e2 = 0; e2 < 4; ++e2) { const unsigned r0 = raw[i][e2], r1 = raw[i + 1][e2], r2 = raw[i + 2][e2], r3 = raw[i + 3][e2];
                      xo[2 * e2] = bb[2 * e2] + w0[2 * e2] * bflo(r0) + w1[2 * e2] * bflo(r1) + w2[2 * e2] * bflo(r2) + w3[2 * e2] * bflo(r3);
                      xo[2 * e2 + 1] = bb[2 * e2 + 1] + w0[2 * e2 + 1] * bfhi(r0) + w1[2 * e2 + 1] * bfhi(r1) + w2[2 * e2 + 1] * bfhi(r2) + w3[2 * e2 + 1] * bfhi(r3); }
                  u32x4 o; o.x = cvt_pk_bf16(xo[0], xo[1]); o.y = cvt_pk_bf16(xo[2], xo[3]); o.z = cvt_pk_bf16(xo[4], xo[5]); o.w = cvt_pk_bf16(xo[6], xo[7]);
                  *(LAS u32x4*)(lds + RG_XC + (8 * tg + i) * RG_XPITCH + 16 * cc) = o; } }
            if (tt + 1 < SEQ / 128) rg_load_raw(PROJ, rowb, T0 + 128, tg, cb, cc, raw);
            __syncthreads();
            { f32x16 acc; for (int i = 0; i < 16; ++i) acc[i] = 0.f;
              const LAS unsigned char* ap = lds + RG_XC + (32 * ti + l31) * RG_XPITCH + 16 * h;
#pragma unroll
              for (int s = 0; s < 16; ++s) { const bf16x8 a = *(const LAS bf16x8*)(ap + 32 * s); acc = MFMA32(a, wf[s], acc); }
              LAS float* gout = gate ? GA : GX;
#pragma unroll
              for (int r = 0; r < 16; ++r) { const float v = acc[r] + gbias; gout[(32 * ti + crow(r, h)) * 32 + l31] = __builtin_amdgcn_rcpf(1.0f + __expf(-v)); } }
            __syncthreads();
            { const u32x4 xr = *(const LAS u32x4*)(lds + RG_XC + et * RG_XPITCH + 2 * (32 * js + ej));
              const float xc[8] = {bflo(xr.x), bfhi(xr.x), bflo(xr.y), bfhi(xr.y), bflo(xr.z), bfhi(xr.z), bflo(xr.w), bfhi(xr.w)};
#pragma unroll
              for (int q = 0; q < 2; ++q) { f32x4 ga = *(const LAS f32x4*)(GA + et * 32 + ej + 4 * q), gx = *(const LAS f32x4*)(GX + et * 32 + ej + 4 * q); const f32x4 sp = *(const LAS f32x4*)(SPL + ej + 4 * q);
#pragma unroll
                  for (int e = 0; e < 4; ++e) { const float a = __builtin_amdgcn_exp2f(ga[e] * sp[e]); const float mult = sqrtf(fmaxf(1.0f - a * a, 0.f)); ga[e] = a; gx[e] = mult * gx[e] * xc[4 * q + e]; }
                  *(LAS f32x4*)(GA + et * 32 + ej + 4 * q) = ga; *(LAS f32x4*)(GX + et * 32 + ej + 4 * q) = gx; } }
            __syncthreads();
            if (wave == 0 && lane < 32) {
#pragma unroll 16
                for (int t = 0; t < 128; ++t) { hstate = GA[t * 32 + lane] * hstate + GX[t * 32 + lane]; HB[t * 32 + lane] = hstate; } }
            __syncthreads();
            { const float ry[8] = {bflo(ryraw.x), bfhi(ryraw.x), bflo(ryraw.y), bfhi(ryraw.y), bflo(ryraw.z), bfhi(ryraw.z), bflo(ryraw.w), bfhi(ryraw.w)};
              const f32x4 h0 = *(const LAS f32x4*)(HB + et * 32 + ej), h1 = *(const LAS f32x4*)(HB + et * 32 + ej + 4);
              u32x4 o; o.x = cvt_pk_bf16(h0.x * gelu_tanh(ry[0]), h0.y * gelu_tanh(ry[1])); o.y = cvt_pk_bf16(h0.z * gelu_tanh(ry[2]), h0.w * gelu_tanh(ry[3]));
              o.z = cvt_pk_bf16(h1.x * gelu_tanh(ry[4]), h1.y * gelu_tanh(ry[5])); o.w = cvt_pk_bf16(h1.z * gelu_tanh(ry[6]), h1.w * gelu_tanh(ry[7]));
              *(u32x4*)(O + (R0 + et) * DM + c0 + ej) = o; }
        }
        __syncthreads();
    }
}

#ifndef REP_P0
#define REP_P0 1
#endif
#ifndef REP_GEMM
#define REP_GEMM 1
#endif
#ifndef REP_MIX0
#define REP_MIX0 1
#endif
#ifndef REP_MIX1
#define REP_MIX1 1
#endif
#ifndef REP_RES
#define REP_RES 1
#endif
#ifndef REP_RMS
#define REP_RMS 1
#endif
#ifndef MK_N_LAUNCHES
#define MK_N_LAUNCHES 1
#endif
constexpr int N_PHASES = 16;
struct Args { Params p; int li, pad; };

__device__ __forceinline__ void attn_phase_fox(const Params& p, LAS unsigned char* lds, int wave, int lane) {
    const bf16_t* PROJ = (const bf16_t*)(p.ws + WS_PROJ);
    const AttnIO io{PROJ + PJ_FQ, PROJ + PJ_FK, PROJ + PJ_FV, AB_MAIN, (bf16_t*)(p.ws + WS_O) + 2048, DM};
    const float* CF = (const float*)(p.ws + WS_CF);
    for (int pr = blockIdx.x; pr < 256; pr += gridDim.x) { const int b = pr >> 6, hd = (pr >> 2) & 15, x = pr & 3;
        fox_unit(io, CF, lds, b, hd, 7 - x, wave, lane);
        fox_unit(io, CF, lds, b, hd, x, wave, lane); }
}
__device__ __forceinline__ void attn_phase_sb(const Params& p, LAS unsigned char* lds, int wave, int lane) {
    const bf16_t* PROJ = (const bf16_t*)(p.ws + WS_PROJ);
    const AttnIO io{PROJ + PJ_SQ, PROJ + PJ_SK, PROJ + PJ_SV, CD_IN, (bf16_t*)(p.ws + WS_O) + 2048, DM};
    for (int pr = blockIdx.x; pr < 256; pr += gridDim.x) { const int b = pr >> 6, hd = (pr >> 2) & 15, x = pr & 3;
        sb_unit(io, lds, b, hd, 7 - x, wave, lane);
        sb_unit(io, lds, b, hd, x, wave, lane); }
}

template <int layer>
__device__ __forceinline__ void layer_phases(const Params& p, LAS unsigned char* lds, const XcdBarrier& bar, int lo, int hi, int G, int gw, int ngw, int wave, int lane) {
    unsigned char* ws = p.ws;
    bf16_t* U = (bf16_t*)(ws + WS_U); bf16_t* PROJ = (bf16_t*)(ws + WS_PROJ); bf16_t* O = (bf16_t*)(ws + WS_O); bf16_t* ACT = (bf16_t*)(ws + WS_ACT); pg8::ssq_t* SSQ = (pg8::ssq_t*)((unsigned*)(ws + WS_CTL) + CW_SSQ);
#define IN(k) (lo <= (k) && (k) < hi)
#define SEAM(k) do { if ((k) + 1 < hi) xcd_barrier(bar); } while (0)
        constexpr int kb = 1 + 7 * layer;
        if (IN(kb)) {
            if (layer == 0) {
                pg8::Gemm g{U, (const bf16_t*)(ws + WS_WAB_IN), MTOK, AB_MAIN, DM}; pg8::StaticOrder S; S.init(MTOK, AB_MAIN, G, (int)blockIdx.x);
                pg8::EpiBf16<false> E{PROJ, AB_MAIN, nullptr};
                for (int rep = 0; rep < REP_GEMM; ++rep) { pg8::gemm_phase<pg8::EpiBf16<false>, pg8::StaticOrder, true, true>(lds, g, S, E); __syncthreads(); }
                phase_small32(p, lds, wave, lane);
            } else {
                pg8::Gemm g{U, (const bf16_t*)(ws + WS_WCD_IN), MTOK, CD_IN, DM}; pg8::StaticOrder S; S.init(MTOK, CD_IN, G, (int)blockIdx.x);
                pg8::EpiBf16<true> E{PROJ, CD_IN, SSQ + 1 * MTOK};
                for (int rep = 0; rep < REP_GEMM; ++rep) { pg8::gemm_phase<pg8::EpiBf16<true>, pg8::StaticOrder, true, true>(lds, g, S, E); __syncthreads(); }
            }
            SEAM(kb);
        }
        if (layer == 0 && IN(kb + 1)) { for (int rep = 0; rep < (REP_MIX0 == 5 ? 2 : 1); ++rep) { phase_fox_cumsum(p, gw, ngw, lane); phase_gla_pre(p, lds, wave, lane); } SEAM(kb + 1); }
        if (IN(kb + 2)) {
            if (layer == 0) { phase_gla_seq(p, lds, wave, lane); __syncthreads(); attn_phase_fox(p, lds, wave, lane); __syncthreads();
#if REP_MIX0 == 3
 attn_phase_fox(p, lds, wave, lane); __syncthreads();
#endif
#if REP_MIX0 == 4
 phase_gla_seq(p, lds, wave, lane); __syncthreads();
#endif
 }
            else { phase_rg(p, lds, wave, lane); __syncthreads(); attn_phase_sb(p, lds, wave, lane); __syncthreads();
#if REP_MIX1 == 2
 phase_rg(p, lds, wave, lane); __syncthreads(); attn_phase_sb(p, lds, wave, lane); __syncthreads();
#endif
#if REP_MIX1 == 3
 phase_rg(p, lds, wave, lane); __syncthreads();
#endif
 }
            SEAM(kb + 2);
        }
        if (layer == 0 && IN(kb + 3)) { for (int rep = 0; rep < (REP_MIX0 == 6 ? 2 : 1); ++rep) phase_gla_post(p, gw, ngw, lane); SEAM(kb + 3); }
        if (IN(kb + 4)) {
            pg8::Gemm g{O, (const bf16_t*)(ws + (layer ? WS_WCD_OUT : WS_WAB_OUT)), MTOK, DM, DM}; pg8::StaticOrder S; S.init(MTOK, DM, G, (int)blockIdx.x);
#if REP_RES == 2
            { pg8::EpiRes<false> E{U, (bf16_t*)(ws + WS_ORAW), DM, (pg8::ssq_t*)(ws + WS_SSQ)}; pg8::gemm_phase<pg8::EpiRes<false>, pg8::StaticOrder, true, true>(lds, g, S, E); __syncthreads(); }
#endif
            if (layer == 0) { pg8::EpiRes<true> E{p.x, U, DM, SSQ + (2 * layer) * MTOK}; pg8::gemm_phase<pg8::EpiRes<true>, pg8::StaticOrder, true, true>(lds, g, S, E); }
            else { pg8::EpiRes<false> E{U, U, DM, SSQ + (2 * layer) * MTOK}; pg8::gemm_phase<pg8::EpiRes<false>, pg8::StaticOrder, true, true>(lds, g, S, E); }
            SEAM(kb + 4);
        }
        if (IN(kb + 5)) {
            pg8::Gemm g{U, (const bf16_t*)(ws + (layer ? WS_WGU1 : WS_WGU0)), MTOK, 2 * DFF, DM}; pg8::StaticOrder S; S.init(MTOK, 2 * DFF, G, (int)blockIdx.x);
            pg8::EpiSwiGLU E{ACT, DFF, SSQ + (2 * layer) * MTOK};
            for (int rep = 0; rep < REP_GEMM; ++rep) { pg8::gemm_phase<pg8::EpiSwiGLU, pg8::StaticOrder, true, true>(lds, g, S, E); __syncthreads(); }
            if (layer == 0) { const int rem = (MTOK / 256) * (2 * DFF / 256) % G, c = (int)blockIdx.x;
                if (rem == 0) tail_convert(p, lds, c * NWAVES + wave, G * NWAVES, wave, lane); else if (c >= rem) tail_convert(p, lds, (c - rem) * NWAVES + wave, (G - rem) * NWAVES, wave, lane); }
            SEAM(kb + 5);
        }
        if (IN(kb + 6)) {
            pg8::Gemm g{ACT, (const bf16_t*)(ws + (layer ? WS_WDN1 : WS_WDN0)), MTOK, DM, DFF}; pg8::StaticOrder S; S.init(MTOK, DM, G, (int)blockIdx.x);
#if REP_RES == 2
            { pg8::EpiRes<false> E{U, (bf16_t*)(ws + WS_ORAW), DM, (pg8::ssq_t*)(ws + WS_SSQ)}; pg8::gemm_phase<pg8::EpiRes<false>, pg8::StaticOrder, true, true>(lds, g, S, E); __syncthreads(); }
#endif
            pg8::EpiRes<false> E{U, U, DM, SSQ + (2 * layer + 1) * MTOK};
            pg8::gemm_phase<pg8::EpiRes<false>, pg8::StaticOrder, true, true>(lds, g, S, E);
            SEAM(kb + 6);
        }
#undef IN
#undef SEAM
}

__global__ void __launch_bounds__(NTHR, 2) hybrid_fwd(Args args) {
    extern __shared__ __attribute__((aligned(16))) unsigned char lds_raw[];
    LAS unsigned char* lds = (LAS unsigned char*)lds_raw;
    const Params& p = args.p;
    const int tid = threadIdx.x, lane = tid & 63, wave = __builtin_amdgcn_readfirstlane(tid >> 6);
    const int G = gridDim.x, gw = blockIdx.x * NWAVES + wave, ngw = G * NWAVES;
    for (int u = tid; u < (LDS_BYTES - LDSCTL_OFF) / 4; u += NTHR) ((LAS unsigned*)(lds + LDSCTL_OFF))[u] = 0u;
    __syncthreads();
    unsigned* ctl = (unsigned*)(p.ws + WS_CTL);
    XcdBarrier bar = xcd_barrier_post(ctl + CW_BAR + args.li * XCD_BAR_WORDS, (volatile LAS unsigned*)(lds + MISC_OFF) + 8);
    const int lo = p.ph_lo, hi = p.ph_hi;
#define IN(k) (lo <= (k) && (k) < hi)
#define SEAM(k) do { if ((k) + 1 < hi) xcd_barrier(bar); } while (0)
    if (IN(0)) { for (int rep = 0; rep < REP_P0; ++rep) { phase_p0(p, lds, gw, ngw, wave, lane); __syncthreads(); } SEAM(0); }

    layer_phases<0>(p, lds, bar, lo, hi, G, gw, ngw, wave, lane);
    layer_phases<1>(p, lds, bar, lo, hi, G, gw, ngw, wave, lane);
    if (IN(15)) phase_final_norm((const bf16_t*)(p.ws + WS_U), (const unsigned long long*)((const unsigned*)(p.ws + WS_CTL) + CW_SSQ) + 3 * MTOK, p.final_norm, p.out, gw, ngw, lane);
#undef IN
#undef SEAM
}

extern "C" void kernel_launch(void* const* d_in, const int* in_sizes, int n_in, void* d_out, int out_size, void* d_ws, size_t ws_size, hipStream_t stream) {
    static int grid = 0;
    if (grid == 0) {
        if (n_in != 22 || in_sizes[0] != MTOK * DM || out_size != MTOK * DM || ws_size < WS_END) {
            fprintf(stderr, "kernel_launch: unexpected problem (n_in %d, in0 %d, out %d, ws %zu, need %zu); nothing launched\n", n_in, n_in > 0 ? in_sizes[0] : -1, out_size, ws_size, (size_t)WS_END); grid = -1; return; }
        int dev = 0, cus = 0, per_cu = 0;
        if (hipGetDevice(&dev) != hipSuccess || hipDeviceGetAttribute(&cus, hipDeviceAttributeMultiprocessorCount, dev) != hipSuccess) { fprintf(stderr, "kernel_launch: device query failed\n"); grid = -1; return; }
        if (hipFuncSetAttribute((const void*)hybrid_fwd, hipFuncAttributeMaxDynamicSharedMemorySize, LDS_BYTES) != hipSuccess) { fprintf(stderr, "kernel_launch: hipFuncSetAttribute failed\n"); grid = -1; return; }
        if (hipOccupancyMaxActiveBlocksPerMultiprocessor(&per_cu, (const void*)hybrid_fwd, NTHR, LDS_BYTES) != hipSuccess || per_cu < 1) {
            fprintf(stderr, "kernel_launch: occupancy query reports %d workgroups per CU; nothing launched\n", per_cu); (void)hipGetLastError(); grid = -1; return; }
        grid = cus;
    }
    if (grid < 0) return;
    if (hipMemsetAsync((char*)d_ws + WS_CTL, 0, CTL_ZERO_BYTES, stream) != hipSuccess) { fprintf(stderr, "kernel_launch: memset failed\n"); return; }
    Args a{};
    const float** pp = (const float**)&a.p;
    for (int i = 0; i < 22; ++i) pp[i] = (const float*)d_in[i];
    a.p.out = (float*)d_out; a.p.ws = (unsigned char*)d_ws;
#if MK_N_LAUNCHES == 1
    a.p.ph_lo = 0; a.p.ph_hi = N_PHASES; a.li = 0; a.pad = 0;
    hipLaunchKernelGGL(hybrid_fwd, dim3(grid), dim3(NTHR), LDS_BYTES, stream, a);
    { const hipError_t le = hipPeekAtLastError(); if (le != hipSuccess) fprintf(stderr, "kernel_launch: launch failed: %s\n", hipGetErrorName(le)); }
#else
    for (int k = 0; k < N_PHASES; ++k) { a.p.ph_lo = k; a.p.ph_hi = k + 1; a.li = k; a.pad = 0;
        hipLaunchKernelGGL(hybrid_fwd, dim3(grid), dim3(NTHR), LDS_BYTES, stream, a);
        const hipError_t le = hipPeekAtLastError(); if (le != hipSuccess) { fprintf(stderr, "kernel_launch: launch %d failed: %s\n", k, hipGetErrorName(le)); break; } }
#endif
}
```

```cpp
#include <hip/hip_runtime.h>
#include <cstdio>
#include <cstdint>

#define LAS __attribute__((address_space(3)))
#define GAS __attribute__((address_space(1)))
typedef unsigned short bf16_t;
typedef short bf16x8 __attribute__((ext_vector_type(8)));
typedef short s16x4 __attribute__((ext_vector_type(4)));
typedef float f32x4 __attribute__((ext_vector_type(4)));
typedef float f32x2 __attribute__((ext_vector_type(2)));
typedef float f32x16 __attribute__((ext_vector_type(16)));
typedef unsigned u32x4 __attribute__((ext_vector_type(4)));
typedef unsigned u32x2 __attribute__((ext_vector_type(2)));

constexpr int DM = 4096, NB = 4, SEQ = 2048, MTOK = NB * SEQ;
constexpr int DFF = 11008;
constexpr int AB_MAIN = 12288;
constexpr int AB_IN = 12320, CD_IN = 10240;
constexpr int PJ_GQ = 0, PJ_GK = 1024, PJ_GV = 2048, PJ_GG = 4096, PJ_FQ = 6144, PJ_FK = 8192, PJ_FV = 10240;
constexpr int PJ_RY = 0, PJ_RX = 2048, PJ_SQ = 4096, PJ_SK = 6144, PJ_SV = 8192;
constexpr float EPS = 1e-6f, LOG2E_F = 1.4426950408889634f;

__device__ __forceinline__ unsigned cvt_pk_bf16(float lo, float hi) { unsigned r; asm volatile("v_cvt_pk_bf16_f32 %0, %1, %2" : "=v"(r) : "v"(lo), "v"(hi)); return r; }
__device__ __forceinline__ float bf2f(bf16_t v) { return __uint_as_float(((unsigned)v) << 16); }
__device__ __forceinline__ float bflo(unsigned w) { return __uint_as_float(w << 16); }
__device__ __forceinline__ float bfhi(unsigned w) { return __uint_as_float(w & 0xffff0000u); }
__device__ __forceinline__ bf16_t f2bf(float f) { return (bf16_t)(cvt_pk_bf16(f, 0.f) & 0xffffu); }
__device__ __forceinline__ int crow(int r, int hi) { return (r & 3) + 8 * (r >> 2) + 4 * hi; }
__device__ __forceinline__ bf16x8 pack8(float a0, float a1, float a2, float a3, float a4, float a5, float a6, float a7) {
    u32x4 w = {cvt_pk_bf16(a0, a1), cvt_pk_bf16(a2, a3), cvt_pk_bf16(a4, a5), cvt_pk_bf16(a6, a7)}; return __builtin_bit_cast(bf16x8, w); }
__device__ __forceinline__ float wave_sum(float v) {
#pragma unroll
    for (int o = 1; o < 64; o <<= 1) v += __shfl_xor(v, o);
    return v; }
__device__ __forceinline__ float log_sigmoid_acc(float x) { return fminf(x, 0.f) - log1pf(expf(-fabsf(x))); }
__device__ __forceinline__ float log_sigmoid_fast(float x) { return fminf(x, 0.f) - __logf(1.0f + __expf(-fabsf(x))); }
#define LDS_WAIT() asm volatile("s_waitcnt lgkmcnt(0)" ::: "memory")
#define VM_WAIT() asm volatile("s_waitcnt vmcnt(0)" ::: "memory")
#define LDS_BARRIER() do { asm volatile("s_waitcnt lgkmcnt(0)" ::: "memory"); __builtin_amdgcn_s_barrier(); asm volatile("" ::: "memory"); } while (0)
#define MFMA32(a, b, c) __builtin_amdgcn_mfma_f32_32x32x16_bf16((a), (b), (c), 0, 0, 0)
__device__ __forceinline__ int xcd_swz(int i, int n) { return (n % 8 == 0) ? (i & 7) * (n / 8) + (i >> 3) : i; }
typedef LAS const char* lds_cptr;
__device__ __forceinline__ s16x4 vtr(lds_cptr p) { return __builtin_bit_cast(s16x4, __builtin_amdgcn_ds_read_tr16_b64_v4i16((LAS s16x4*)p)); }
__device__ __forceinline__ bf16x8 cat4(s16x4 lo, s16x4 hi) { bf16x8 r; r[0] = lo[0]; r[1] = lo[1]; r[2] = lo[2]; r[3] = lo[3]; r[4] = hi[0]; r[5] = hi[1]; r[6] = hi[2]; r[7] = hi[3]; return r; }

namespace pg8 {
#define PG8_LAS __attribute__((address_space(3)))
typedef unsigned short bf16_t;
typedef short bf16x8 __attribute__((ext_vector_type(8)));
typedef float f32x4 __attribute__((ext_vector_type(4)));
typedef unsigned u32x4 __attribute__((ext_vector_type(4)));
constexpr int BM = 256, BK = 64, HALF = 128, HTB = HALF * BK * 2  , STAGE_BYTES = 8 * HTB, NXCD = 8, WGM = 8;

__host__ __device__ __forceinline__ int lds_byte(int r, int c) { const int st = (r >> 4) * 2 + (c >> 5), rr = r & 15, cc = c & 31, ob = rr * 64 + cc * 2; return st * 1024 + (ob ^ (((ob >> 9) & 1) << 5)); }
__host__ __device__ __forceinline__ void stage_rc(int b, int& R, int& C) { const int st = b / 1024, sb = b % 1024, swz = sb ^ (((sb >> 9) & 1) << 5); R = (st >> 1) * 16 + swz / 64; C = (st & 1) * 32 + (swz % 64) / 2; }
__host__ __device__ __forceinline__ int perm32(int rho) { const int n = rho >> 4, i = rho & 15; return 8 * (i >> 2) + 4 * n + (i & 3); }

struct Unit { int pm, pn; };
struct Gemm { const bf16_t* A; const bf16_t* Bt; int M, N, K; };

struct StaticOrder {
    int nM, nN, nwg, G, c;
    __host__ __device__ void init(int M, int N, int G_, int c_) { nM = M / BM; nN = N / BM; nwg = nM * nN; G = G_; c = c_; }
    __host__ __device__ bool next(int i, Unit& u) const {
        const long L = (long)i * G + c; if (L >= nwg) return false;
        int wgid = (int)L; { const int q = nwg / NXCD, r = nwg % NXCD, xcd = wgid % NXCD, off = wgid / NXCD; wgid = (xcd < r ? xcd * (q + 1) : r * (q + 1) + (xcd - r) * q) + off; }
        const int nig = WGM * nN, gid = wgid / nig, fm = gid * WGM, gsz = (nM - fm) < WGM ? (nM - fm) : WGM;
        u.pm = fm + ((wgid % nig) % gsz); u.pn = (wgid % nig) / gsz; return true;
    }
    __device__ __forceinline__ void a_ready(const Unit&) const {}
    __device__ __forceinline__ void done(const Unit&) const {}
};
__device__ __forceinline__ unsigned cvt_pk_bf16(float lo, float hi) { unsigned r; asm volatile("v_cvt_pk_bf16_f32 %0, %1, %2" : "=v"(r) : "v"(lo), "v"(hi)); return r; }
constexpr float RMS_EPS = 1e-6f, RMS_INV_D = 1.0f / 4096.0f, SSQ_FIX = 16777216.0f, SSQ_UNFIX = 1.0f / 16777216.0f;
typedef unsigned long long ssq_t;
__device__ __forceinline__ float ssq_rstd(const ssq_t* ssq, int row) { return __builtin_amdgcn_rsqf((float)ssq[row] * (SSQ_UNFIX * RMS_INV_D) + RMS_EPS); }

template <bool SCALE> struct EpiBf16 {
    static constexpr bool PERM = true, AFTER_DRAIN = false;
    bf16_t* O; int ldc; const ssq_t* ssq;
    __device__ __forceinline__ void operator()(const f32x4 (&acc)[2][2][4][2], const Unit& u, int wr, int wc, int fr, int fq) const {
        const int row0 = u.pm * BM + wr * 64 + fr, col0 = u.pn * BM + wc * 32 + 8 * fq;
        float rs[2][4];
#pragma unroll
        for (int ai = 0; ai < 2; ++ai)
#pragma unroll
            for (int m = 0; m < 4; ++m) rs[ai][m] = SCALE ? ssq_rstd(ssq, row0 + ai * HALF + m * 16) : 1.0f;
#pragma unroll
        for (int ai = 0; ai < 2; ++ai)
#pragma unroll
            for (int m = 0; m < 4; ++m) { const int row = row0 + ai * HALF + m * 16; bf16_t* rowp = O + (size_t)row * ldc + col0;
#pragma unroll
                for (int bj = 0; bj < 2; ++bj) { const f32x4 v0 = acc[ai][bj][m][0] * rs[ai][m], v1 = acc[ai][bj][m][1] * rs[ai][m];
                    u32x4 w; w.x = cvt_pk_bf16(v0[0], v0[1]); w.y = cvt_pk_bf16(v0[2], v0[3]); w.z = cvt_pk_bf16(v1[0], v1[1]); w.w = cvt_pk_bf16(v1[2], v1[3]);
                    *(u32x4*)(rowp + bj * HALF) = w; } }
    }
};
template <bool BASE_F32> struct EpiRes {
    static constexpr bool PERM = true, AFTER_DRAIN = false;
    const void* base; bf16_t* out; int ldc; ssq_t* ssq;
    __device__ __forceinline__ void operator()(const f32x4 (&acc)[2][2][4][2], const Unit& u, int wr, int wc, int fr, int fq) const {
        const int row0 = u.pm * BM + wr * 64 + fr, col0 = u.pn * BM + wc * 32 + 8 * fq;
#pragma unroll
        for (int ai = 0; ai < 2; ++ai) {
            f32x4 b0[4][2], b1[4][2];
#pragma unroll
            for (int m = 0; m < 4; ++m)
#pragma unroll
                for (int bj = 0; bj < 2; ++bj) { const size_t off = (size_t)(row0 + ai * HALF + m * 16) * ldc + col0 + bj * HALF;
                    if (BASE_F32) { const float* bp = (const float*)base + off; b0[m][bj] = *(const f32x4*)bp; b1[m][bj] = *(const f32x4*)(bp + 4); }
                    else { const u32x4 r = *(const u32x4*)((const bf16_t*)base + off);
                        b0[m][bj] = (f32x4){__uint_as_float(r.x << 16), __uint_as_float(r.x & 0xffff0000u), __uint_as_float(r.y << 16), __uint_as_float(r.y & 0xffff0000u)};
                        b1[m][bj] = (f32x4){__uint_as_float(r.z << 16), __uint_as_float(r.z & 0xffff0000u), __uint_as_float(r.w << 16), __uint_as_float(r.w & 0xffff0000u)}; } }
#pragma unroll
            for (int m = 0; m < 4; ++m) { const int row = row0 + ai * HALF + m * 16; const size_t off = (size_t)row * ldc + col0; float q = 0.f;
#pragma unroll
                for (int bj = 0; bj < 2; ++bj) { const f32x4 v0 = acc[ai][bj][m][0] + b0[m][bj], v1 = acc[ai][bj][m][1] + b1[m][bj];
                    q += ((v0[0] * v0[0] + v0[1] * v0[1]) + (v0[2] * v0[2] + v0[3] * v0[3])) + ((v1[0] * v1[0] + v1[1] * v1[1]) + (v1[2] * v1[2] + v1[3] * v1[3]));
                    u32x4 w; w.x = cvt_pk_bf16(v0[0], v0[1]); w.y = cvt_pk_bf16(v0[2], v0[3]); w.z = cvt_pk_bf16(v1[0], v1[1]); w.w = cvt_pk_bf16(v1[2], v1[3]);
                    *(u32x4*)(out + off + bj * HALF) = w; }
                q += __shfl_xor(q, 16); q += __shfl_xor(q, 32);
                if (fq == 0) atomicAdd(ssq + row, (ssq_t)(q * SSQ_FIX + 0.5f)); }
        }
    }
};
struct EpiSwiGLU {
    static constexpr bool PERM = true, AFTER_DRAIN = false;
    bf16_t* O; int ldc; const ssq_t* ssq;
    __device__ __forceinline__ void operator()(const f32x4 (&acc)[2][2][4][2], const Unit& u, int wr, int wc, int fr, int fq) const {
        const int row0 = u.pm * BM + wr * 64 + fr, col0 = u.pn * HALF + wc * 32 + 8 * fq;
        float rs[2][4];
#pragma unroll
        for (int ai = 0; ai < 2; ++ai)
#pragma unroll
            for (int m = 0; m < 4; ++m) rs[ai][m] = ssq_rstd(ssq, row0 + ai * HALF + m * 16);
#pragma unroll
        for (int ai = 0; ai < 2; ++ai)
#pragma unroll
            for (int m = 0; m < 4; ++m) { const int row = row0 + ai * HALF + m * 16; bf16_t* rowp = O + (size_t)row * ldc + col0; float a[8];
#pragma unroll
                for (int n = 0; n < 2; ++n)
#pragma unroll
                    for (int i = 0; i < 4; i += 2) {
                        const f32x2 r2 = {rs[ai][m], rs[ai][m]};
                        const f32x2 g = (f32x2){acc[ai][0][m][n][i], acc[ai][0][m][n][i + 1]} * r2, up = (f32x2){acc[ai][1][m][n][i], acc[ai][1][m][n][i + 1]} * r2;
                        const f32x2 t = g * (f32x2){-1.4426950408889634f, -1.4426950408889634f};
                        const f32x2 d = (f32x2){__builtin_amdgcn_exp2f(t.x), __builtin_amdgcn_exp2f(t.y)} + (f32x2){1.0f, 1.0f};
                        const f32x2 o2 = (g * up) * (f32x2){__builtin_amdgcn_rcpf(d.x), __builtin_amdgcn_rcpf(d.y)};
                        a[4 * n + i] = o2.x; a[4 * n + i + 1] = o2.y; }
                u32x4 w; w.x = cvt_pk_bf16(a[0], a[1]); w.y = cvt_pk_bf16(a[2], a[3]); w.z = cvt_pk_bf16(a[4], a[5]); w.w = cvt_pk_bf16(a[6], a[7]);
                *(u32x4*)rowp = w; }
    }
};

template <class Epi, class Sched, bool ALIGN_EPI = false, bool SP2 = false>
__device__ __forceinline__ void gemm_phase(PG8_LAS unsigned char* lds, const Gemm g, const Sched& S, const Epi& E) {
    const int tid = threadIdx.x, wid = __builtin_amdgcn_readfirstlane(tid >> 6), lane = tid & 63, wr = wid >> 2, wc = wid & 3, fr = lane & 15, fq = lane >> 4;
    const int K = g.K, nt = K / BK;
    unsigned voffA[2], voffB[2];
#pragma unroll
    for (int i = 0; i < 2; ++i) { int R, C; stage_rc(tid * 16 + i * 8192, R, C); const int Rb = Epi::PERM ? ((R & ~31) + perm32(R & 31)) : R;
        voffA[i] = (unsigned)(R * K + C) * 2u; voffB[i] = (unsigned)(Rb * K + C) * 2u; }
    const size_t kstep = (size_t)(BK * 2);
    const size_t hstep = (size_t)HALF * K * 2;
    const size_t tstep = 2 * hstep;
    const unsigned ldsw = (unsigned)wid * 1024u;
    const int aoff = lds_byte(wr * 64 + fr, fq * 8), boff = lds_byte(wc * 32 + fr, fq * 8);
#define PG8_SA(b, h) (((b) * 2 + (h)) * HTB)
#define PG8_SB(b, h) ((4 + (b) * 2 + (h)) * HTB)
#define PG8_STAGE(bufoff, gbase, voff) do { _Pragma("unroll") for (int _i = 0; _i < 2; ++_i) \
        __builtin_amdgcn_global_load_lds((const unsigned*)((const char*)(gbase) + (voff)[_i]), (PG8_LAS unsigned*)(lds + (bufoff) + ldsw + _i * 8192), 16, 0, 0); } while (0)
#define PG8_LDA(dst, b, h) do { _Pragma("unroll") for (int m = 0; m < 4; ++m) _Pragma("unroll") for (int k = 0; k < 2; ++k) dst[m][k] = *(const PG8_LAS bf16x8*)(lds + PG8_SA(b, h) + aoff + m * 2048 + k * 1024); } while (0)
#define PG8_LDB(dst, b, h) do { _Pragma("unroll") for (int n = 0; n < 2; ++n) _Pragma("unroll") for (int k = 0; k < 2; ++k) dst[n][k] = *(const PG8_LAS bf16x8*)(lds + PG8_SB(b, h) + boff + n * 2048 + k * 1024); } while (0)
#define PG8_MMA(ai, bj, At, Bt) do { __builtin_amdgcn_s_setprio(1); _Pragma("unroll") for (int m = 0; m < 4; ++m) _Pragma("unroll") for (int n = 0; n < 2; ++n) _Pragma("unroll") for (int k = 0; k < 2; ++k) \
        acc[ai][bj][m][n] = __builtin_amdgcn_mfma_f32_16x16x32_bf16(Bt[n][k], At[m][k], acc[ai][bj][m][n], 0, 0, 0); __builtin_amdgcn_s_setprio(0); } while (0)
#define PG8_WAIT_V(n) asm volatile("s_waitcnt vmcnt(" #n ")" ::: "memory")
#define PG8_WAIT_L(n) asm volatile("s_waitcnt lgkmcnt(" #n ")" ::: "memory")
#define PG8_BAR __builtin_amdgcn_s_barrier()
#define PG8_SCHED __builtin_amdgcn_sched_barrier(0)
    Unit cur, nxt; int ui = 0;
    if (!S.next(0, cur)) return;
    f32x4 acc[2][2][4][2];
#pragma unroll
    for (int a = 0; a < 2; ++a)
#pragma unroll
        for (int b = 0; b < 2; ++b)
#pragma unroll
            for (int m = 0; m < 4; ++m)
#pragma unroll
                for (int n = 0; n < 2; ++n) acc[a][b][m][n] = (f32x4){0.f, 0.f, 0.f, 0.f};
    bf16x8 At[4][2], B0[2][2], B1[2][2];
    const char* cA = (const char*)g.A + (size_t)cur.pm * tstep; const char* cB = (const char*)g.Bt + (size_t)cur.pn * tstep;
    S.a_ready(cur);
    if constexpr (SP2) {
        PG8_STAGE(PG8_SB(0, 0), cB, voffB); PG8_STAGE(PG8_SB(0, 1), cB + hstep, voffB); PG8_STAGE(PG8_SA(0, 0), cA, voffA); PG8_STAGE(PG8_SA(0, 1), cA + hstep, voffA);
        if (wr == 1) PG8_BAR;
        PG8_WAIT_V(2); PG8_BAR;
        PG8_STAGE(PG8_SB(1, 0), cB + kstep, voffB); PG8_STAGE(PG8_SA(1, 0), cA + kstep, voffA); PG8_STAGE(PG8_SB(1, 1), cB + hstep + kstep, voffB);
        PG8_WAIT_V(6); PG8_BAR;
    } else {
        PG8_STAGE(PG8_SB(0, 0), cB, voffB); PG8_STAGE(PG8_SA(0, 0), cA, voffA); PG8_STAGE(PG8_SB(0, 1), cB + hstep, voffB); PG8_STAGE(PG8_SA(0, 1), cA + hstep, voffA);
        if (wr == 1) PG8_BAR;
        PG8_WAIT_V(4); PG8_BAR;
        PG8_STAGE(PG8_SB(1, 0), cB + kstep, voffB); PG8_STAGE(PG8_SA(1, 0), cA + kstep, voffA); PG8_STAGE(PG8_SB(1, 1), cB + hstep + kstep, voffB);
        PG8_WAIT_V(6); PG8_BAR;
    }
    for (;;) {
        const bool has_next = S.next(ui + 1, nxt);
        const char* nA = has_next ? (const char*)g.A + (size_t)nxt.pm * tstep : cA; const char* nB = has_next ? (const char*)g.Bt + (size_t)nxt.pn * tstep : cB;
        for (int t = 0; t < nt; t += 2) {
            const bool last = (t == nt - 2);
            const char* a1 = cA + (size_t)(t + 1) * kstep;
            const char* a2 = last ? nA : cA + (size_t)(t + 2) * kstep; const char* b2 = last ? nB : cB + (size_t)(t + 2) * kstep;
            const char* a3 = a2 + kstep; const char* b3 = b2 + kstep;
            if (last && has_next) S.a_ready(nxt);
            if constexpr (SP2) {
            PG8_LDB(B0, 0, 0); PG8_LDB(B1, 0, 1); PG8_SCHED; PG8_LDA(At, 0, 0); PG8_STAGE(PG8_SA(1, 1), a1 + hstep, voffA);
            PG8_WAIT_V(8); PG8_WAIT_L(0); PG8_BAR; PG8_MMA(0, 0, At, B0); PG8_MMA(0, 1, At, B1); PG8_BAR; PG8_SCHED;
            PG8_LDA(At, 0, 1); PG8_STAGE(PG8_SB(0, 0), b2, voffB); PG8_STAGE(PG8_SB(0, 1), b2 + hstep, voffB); PG8_STAGE(PG8_SA(0, 0), a2, voffA);
            PG8_WAIT_V(8); PG8_WAIT_L(0); PG8_BAR; PG8_MMA(1, 0, At, B0); PG8_MMA(1, 1, At, B1); PG8_BAR; PG8_SCHED;
            PG8_LDB(B0, 1, 0); PG8_LDB(B1, 1, 1); PG8_SCHED; PG8_LDA(At, 1, 0); PG8_STAGE(PG8_SA(0, 1), a2 + hstep, voffA);
            PG8_WAIT_V(8); PG8_WAIT_L(0); PG8_BAR; PG8_MMA(0, 0, At, B0); PG8_MMA(0, 1, At, B1); PG8_BAR; PG8_SCHED;
            PG8_LDA(At, 1, 1); PG8_STAGE(PG8_SB(1, 0), b3, voffB); PG8_STAGE(PG8_SB(1, 1), b3 + hstep, voffB); PG8_STAGE(PG8_SA(1, 0), a3, voffA);
            PG8_WAIT_V(8); PG8_WAIT_L(0); PG8_BAR; PG8_MMA(1, 0, At, B0); PG8_MMA(1, 1, At, B1); PG8_BAR; PG8_SCHED;
            } else {
            PG8_LDB(B0, 0, 0); PG8_SCHED; PG8_LDA(At, 0, 0); PG8_STAGE(PG8_SA(1, 1), a1 + hstep, voffA);
            PG8_WAIT_L(8); PG8_BAR; PG8_WAIT_L(0); PG8_MMA(0, 0, At, B0); PG8_BAR; PG8_SCHED;
            PG8_LDB(B1, 0, 1); PG8_STAGE(PG8_SB(0, 0), b2, voffB);
            PG8_BAR; PG8_WAIT_L(0); PG8_MMA(0, 1, At, B1); PG8_BAR;
            PG8_LDA(At, 0, 1); PG8_STAGE(PG8_SA(0, 0), a2, voffA);
            PG8_BAR; PG8_WAIT_L(0); PG8_MMA(1, 0, At, B0); PG8_BAR; PG8_SCHED;
            PG8_STAGE(PG8_SB(0, 1), b2 + hstep, voffB);
            PG8_WAIT_V(6); PG8_BAR; PG8_MMA(1, 1, At, B1); PG8_BAR;
            PG8_LDB(B0, 1, 0); PG8_SCHED; PG8_LDA(At, 1, 0); PG8_STAGE(PG8_SA(0, 1), a2 + hstep, voffA);
            PG8_WAIT_L(8); PG8_BAR; PG8_WAIT_L(0); PG8_MMA(0, 0, At, B0); PG8_BAR; PG8_SCHED;
            PG8_LDB(B1, 1, 1); PG8_STAGE(PG8_SB(1, 0), b3, voffB);
            PG8_BAR; PG8_WAIT_L(0); PG8_MMA(0, 1, At, B1); PG8_BAR;
            PG8_LDA(At, 1, 1); PG8_STAGE(PG8_SA(1, 0), a3, voffA);
            PG8_BAR; PG8_WAIT_L(0); PG8_MMA(1, 0, At, B0); PG8_BAR; PG8_SCHED;
            PG8_STAGE(PG8_SB(1, 1), b3 + hstep, voffB);
            PG8_WAIT_V(6); PG8_BAR; PG8_MMA(1, 1, At, B1); PG8_BAR;
            }
        }
        if constexpr (ALIGN_EPI) { if (wr == 0) PG8_BAR; }
        if constexpr (!Epi::AFTER_DRAIN) { E(acc, cur, wr, wc, fr, fq); S.done(cur); }
        if (!has_next) break;
#pragma unroll
        for (int a = 0; a < 2; ++a)
#pragma unroll
            for (int b = 0; b < 2; ++b)
#pragma unroll
                for (int m = 0; m < 4; ++m)
#pragma unroll
                    for (int n = 0; n < 2; ++n) acc[a][b][m][n] = (f32x4){0.f, 0.f, 0.f, 0.f};
        cur = nxt; cA = nA; cB = nB; ++ui;
        if constexpr (ALIGN_EPI) { if (wr == 1) PG8_BAR; }
    }
    PG8_WAIT_V(0);
    if constexpr (!ALIGN_EPI) { if (wr == 0) PG8_BAR; }
    PG8_BAR;
    if constexpr (Epi::AFTER_DRAIN) { E.fused(acc, cur, wr, wc, fr, fq, lds, wid, lane); S.done(cur); }
#undef PG8_SA
#undef PG8_SB
#undef PG8_STAGE
#undef PG8_LDA
#undef PG8_LDB
#undef PG8_MMA
#undef PG8_WAIT_V
#undef PG8_WAIT_L
#undef PG8_BAR
#undef PG8_SCHED
}
}
#define XB_TMO      128
#define XB_XCNT(j)  (256  + 64 * (j))
#define XB_XSUB(j)  (1280 + 64 * (j))
#define XB_XGEN(j)  (2304 + 64 * (j))
#define XB_TOP      3328
#define XB_TOPGEN   3392
#define XCD_BAR_WORDS 3456
#define XB_SPIN_CAP (1u << 18)

__device__ __forceinline__ unsigned xb_ld(unsigned* p)              { return __hip_atomic_load(p, __ATOMIC_RELAXED, __HIP_MEMORY_SCOPE_AGENT); }
__device__ __forceinline__ unsigned xb_add(unsigned* p, unsigned v) { return __hip_atomic_fetch_add(p, v, __ATOMIC_RELAXED, __HIP_MEMORY_SCOPE_AGENT); }
__device__ __forceinline__ unsigned xb_xcc_id() { return (unsigned)__builtin_amdgcn_s_getreg((3 << 11) | 20) & 0xFu; }
#define XB_SPIN(cond, bar) do { unsigned _sp = 0; while (cond) { __builtin_amdgcn_s_sleep(1); \
    if ((++_sp & 255u) == 0u) { if (xb_ld(&(bar)[XB_TMO])) break; if (_sp > XB_SPIN_CAP) { atomicAdd(&(bar)[XB_TMO], 1u); break; } } } } while (0)

struct XcdBarrier {
    unsigned* bar; unsigned x;
    volatile LAS unsigned* st;
};

__device__ __forceinline__ XcdBarrier xcd_barrier_post(unsigned* bar, volatile LAS unsigned* st) {
    XcdBarrier b; b.bar = bar; b.x = xb_xcc_id(); b.st = st;
    if (threadIdx.x == 0) (void)xb_add(&bar[XB_XCNT(b.x)], 1u);
    return b;
}
__device__ __forceinline__ void xcd_barrier_complete(unsigned* bar, unsigned x, unsigned& nloc, unsigned& nx) {
    const unsigned G = gridDim.x * gridDim.y * gridDim.z;
    unsigned sum, cnt, mine, sp = 0u;
    for (;;) {
        sum = 0u; cnt = 0u; mine = 0u;
#pragma unroll
        for (unsigned j = 0; j < 16; ++j) { const unsigned c = xb_ld(&bar[XB_XCNT(j)]); sum += c; cnt += (c > 0u) ? 1u : 0u; mine = (j == x) ? c : mine; }
        if (sum == G) break;
        __builtin_amdgcn_s_sleep(1);
        if ((++sp & 255u) == 0u) { if (xb_ld(&bar[XB_TMO])) break; if (sp > XB_SPIN_CAP) { atomicAdd(&bar[XB_TMO], 1u); break; } }
    }
    nloc = mine > 0u ? mine : 1u; nx = cnt > 0u ? cnt : 1u;
}

__device__ __forceinline__ void xcd_barrier(const XcdBarrier& b) {
    asm volatile("s_waitcnt vmcnt(0)" ::: "memory");
    __syncthreads();
    if (threadIdx.x == 0) {
        unsigned* bar = b.bar;
        __builtin_amdgcn_s_waitcnt(0);
        unsigned nloc = b.st[0], nx = b.st[1];
        if (nloc == 0u) { xcd_barrier_complete(bar, b.x, nloc, nx); b.st[0] = nloc; b.st[1] = nx; }
        const unsigned old = xb_add(&bar[XB_XSUB(b.x)], 1u);
        const unsigned gen = old / nloc;
        if (old + 1u == (gen + 1u) * nloc) {
            __builtin_amdgcn_fence(__ATOMIC_RELEASE, "agent");
            asm volatile("s_waitcnt vmcnt(0)" ::: "memory");
            const unsigned og = xb_add(&bar[XB_TOP], 1u);
            const unsigned tg = og / nx;
            if (og + 1u == (tg + 1u) * nx) xb_add(&bar[XB_TOPGEN], 1u);
            else XB_SPIN(xb_ld(&bar[XB_TOPGEN]) == tg, bar);
            __builtin_amdgcn_fence(__ATOMIC_ACQUIRE, "agent");
            xb_add(&bar[XB_XGEN(b.x)], 1u);
            asm volatile("s_waitcnt vmcnt(0)" ::: "memory");
        } else {
            XB_SPIN(xb_ld(&bar[XB_XGEN(b.x)]) == gen, bar);
            __builtin_amdgcn_fence(__ATOMIC_ACQUIRE, "agent");
            asm volatile("s_waitcnt vmcnt(0)" ::: "memory");
        }
    }
    __syncthreads();
}
constexpr size_t MiB = 1u << 20;
constexpr size_t WS_CTL = 0, CTL_ZERO_BYTES = 1 * MiB;
constexpr size_t WS_WAB_IN = 1 * MiB, WS_WAB_OUT = 97 * MiB, WS_WGU0 = 129 * MiB, WS_WDN0 = 301 * MiB, WS_WCD_IN = 387 * MiB, WS_WCD_OUT = 467 * MiB, WS_WGU1 = 499 * MiB, WS_WDN1 = 671 * MiB;
constexpr size_t WS_WSMALL = 757 * MiB, WS_WRG = 758 * MiB;
constexpr size_t WS_U = 760 * MiB, WS_PROJ = 824 * MiB, WS_O = 1016 * MiB, WS_H = 1080 * MiB;
constexpr size_t WS_ACT = WS_PROJ;
constexpr size_t WS_SMALL32 = 1208 * MiB, WS_CF = 1209 * MiB, WS_QT = 1210 * MiB, WS_KDT = 1226 * MiB, WS_PM = 1242 * MiB, WS_GDEC = 1246 * MiB, WS_ORAW = 1247 * MiB, WS_SSQ = 1311 * MiB;
constexpr size_t WS_END = 1313 * MiB;
constexpr int CW_BAR = 4096, CW_SSQ = 131072;

constexpr int RING_BYTES = 131072;
constexpr int LDSCTL_OFF = RING_BYTES, MISC_OFF = LDSCTL_OFF + 320;
constexpr int LDS_BYTES = 147456;
constexpr int NWAVES = 8, NTHR = 512;

struct Params {
    const float *x, *norm_mix, *norm_ffn, *ffn_w_gate, *ffn_w_up, *ffn_w_down, *ab_w_in, *gla_w_gate_up, *gla_b_gate, *gla_norm, *fox_b_f, *ab_w_out,
                *cd_w_in, *rg_conv_w, *rg_conv_b, *rg_w_x, *rg_b_x, *rg_w_a, *rg_b_a, *rg_lambda, *cd_w_out, *final_norm;
    float* out; unsigned char* ws; int ph_lo, ph_hi;
};

struct TrDesc { const float* src; bf16_t* dst; const float* gain; int ldn, K; };
__device__ __forceinline__ void tr_load(const TrDesc& d, f32x4 (&v)[8], int lane) {
    const float* sp = d.src + (size_t)(lane >> 3) * d.ldn + 4 * (lane & 7);
#pragma unroll
    for (int i = 0; i < 8; ++i) v[i] = __builtin_nontemporal_load((const f32x4*)(sp + (size_t)(8 * i) * d.ldn));
}
__device__ __forceinline__ void tr_finish(const TrDesc& d, const f32x4 (&v)[8], LAS float* scr, int lane) {
    const int c = lane & 7;
    f32x4 g0 = {1.f, 1.f, 1.f, 1.f}, g1 = {1.f, 1.f, 1.f, 1.f};
    if (d.gain) { g0 = *(const f32x4*)(d.gain + 8 * c); g1 = *(const f32x4*)(d.gain + 8 * c + 4); }
#pragma unroll
    for (int i = 0; i < 8; ++i) { LAS float* w = scr + (8 * i + (lane >> 3)) * 33 + 4 * c; w[0] = v[i].x; w[1] = v[i].y; w[2] = v[i].z; w[3] = v[i].w; }
    LDS_WAIT(); asm volatile("" ::: "memory");
#pragma unroll
    for (int j = 0; j < 4; ++j) { const int n = (lane >> 3) + 8 * j; const LAS float* s = scr + (8 * c) * 33 + n;
        u32x4 o; o.x = cvt_pk_bf16(s[0 * 33] * g0.x, s[1 * 33] * g0.y); o.y = cvt_pk_bf16(s[2 * 33] * g0.z, s[3 * 33] * g0.w); o.z = cvt_pk_bf16(s[4 * 33] * g1.x, s[5 * 33] * g1.y); o.w = cvt_pk_bf16(s[6 * 33] * g1.z, s[7 * 33] * g1.w);
        __builtin_nontemporal_store(o, (u32x4*)(d.dst + (size_t)n * d.K + 8 * c)); }
    LDS_WAIT(); asm volatile("" ::: "memory");
}
#define TR_JOB(W_, ldn_, K_, nsrc0_, ncols_, WT_, rdst0_, gain_) { constexpr int nnb_ = (ncols_) / 32, nit_ = ((K_) / 64) * nnb_; \
    if (r < nit_) { const int kb_ = r / nnb_, nb_ = r % nnb_; const float* g_ = (gain_); \
        return TrDesc{(W_) + (size_t)(64 * kb_) * (ldn_) + (nsrc0_) + 32 * nb_, (WT_) + (size_t)((rdst0_) + 32 * nb_) * (K_) + 64 * kb_, g_ ? g_ + 64 * kb_ : nullptr, (ldn_), (K_)}; } r -= nit_; }
#define TR_JOB_GU(W_, WT_, off_, gain_) { constexpr int nnb_ = DFF / 32, nit_ = (DM / 64) * nnb_; \
    if (r < nit_) { const int kb_ = r / nnb_, nb_ = r % nnb_, c0_ = 32 * nb_; \
        return TrDesc{(W_) + (size_t)(64 * kb_) * DFF + c0_, (WT_) + (size_t)(256 * (c0_ / 128) + (c0_ % 128) + (off_)) * DM + 64 * kb_, (gain_) + 64 * kb_, DFF, DM}; } r -= nit_; }

__device__ __forceinline__ void rms_row_bf16(const float* xrow, const float* g, bf16_t* orow, int lane) {
    const f32x4* xr = (const f32x4*)xrow + lane; const f32x4* gr = (const f32x4*)g + lane;
    f32x4 v[16]; float s = 0.f;
#pragma unroll
    for (int j = 0; j < 16; ++j) { v[j] = xr[64 * j]; s += (v[j].x * v[j].x + v[j].y * v[j].y) + (v[j].z * v[j].z + v[j].w * v[j].w); }
    const float rstd = 1.0f / sqrtf(wave_sum(s) * (1.0f / DM) + EPS);
    u32x2* o8 = (u32x2*)orow + lane;
#pragma unroll
    for (int j = 0; j < 16; ++j) { const f32x4 gg = gr[64 * j]; u32x2 w; w.x = cvt_pk_bf16(v[j].x * rstd * gg.x, v[j].y * rstd * gg.y); w.y = cvt_pk_bf16(v[j].z * rstd * gg.z, v[j].w * rstd * gg.w); o8[64 * j] = w; }
}
__device__ __forceinline__ void rms_row_f32(const float* xrow, const float* g, float* orow, int lane) {
    const f32x4* xr = (const f32x4*)xrow + lane; const f32x4* gr = (const f32x4*)g + lane;
    f32x4 v[16]; float s = 0.f;
#pragma unroll
    for (int j = 0; j < 16; ++j) { v[j] = xr[64 * j]; s += (v[j].x * v[j].x + v[j].y * v[j].y) + (v[j].z * v[j].z + v[j].w * v[j].w); }
    const float rstd = 1.0f / sqrtf(wave_sum(s) * (1.0f / DM) + EPS);
    f32x4* o = (f32x4*)orow + lane;
#pragma unroll
    for (int j = 0; j < 16; ++j) { const f32x4 gg = gr[64 * j]; o[64 * j] = v[j] * rstd * gg; }
}
__device__ __forceinline__ void phase_final_norm(const bf16_t* Hb, const unsigned long long* ssq, const float* g, float* out, int gw, int ngw, int lane, float scale) {
    for (int m = gw; m < MTOK; m += ngw) { const float rstd = scale / sqrtf((float)ssq[m] * (1.0f / 16777216.0f) * (1.0f / DM) + EPS);
        const u32x4* xr = (const u32x4*)(Hb + (size_t)m * DM) + lane; f32x4* o = (f32x4*)(out + (size_t)m * DM); const f32x4* gr = (const f32x4*)g;
#pragma unroll
        for (int j = 0; j < 8; ++j) { const u32x4 r = xr[64 * j]; const int c4 = 2 * (64 * j + lane);
            const f32x4 g0 = gr[c4], g1 = gr[c4 + 1];
            o[c4] = (f32x4){bflo(r.x) * rstd * g0.x, bfhi(r.x) * rstd * g0.y, bflo(r.y) * rstd * g0.z, bfhi(r.y) * rstd * g0.w};
            o[c4 + 1] = (f32x4){bflo(r.z) * rstd * g1.x, bfhi(r.z) * rstd * g1.y, bflo(r.w) * rstd * g1.z, bfhi(r.w) * rstd * g1.w}; } }
}
__device__ __forceinline__ void phase_rms_bf16(const float* src, const float* g, bf16_t* dst, int gw, int ngw, int lane) {
    for (int m = gw; m < MTOK; m += ngw) rms_row_bf16(src + (size_t)m * DM, g, dst + (size_t)m * DM, lane);
}

constexpr int P0_I_AB = (DM / 64) * (6144 / 32), P0_I_SQ = (DM / 64) * (DM / 32), P0_I_CD = (DM / 64) * (CD_IN / 32), P0_I_GU = (DM / 64) * (DFF / 32), P0_I_DN = (DFF / 64) * (DM / 32), P0_I_RG = 16 * (256 / 64) * (256 / 32);
#ifndef TAILKB
#define TAILKB 128
#endif
constexpr int P0_I_DN1 = (DFF / 64 - TAILKB) * (DM / 32), TAIL_ITEMS = TAILKB * (DM / 32);
constexpr int P0_NITEMS = 2 * P0_I_AB + 2 * P0_I_SQ + P0_I_CD + 4 * P0_I_GU + 1 * P0_I_DN + P0_I_RG;
__device__ __forceinline__ TrDesc p0_item(const Params& p, int it) {
    unsigned char* ws = p.ws;
    bf16_t* WAB_IN = (bf16_t*)(ws + WS_WAB_IN); bf16_t* WAB_OUT = (bf16_t*)(ws + WS_WAB_OUT); bf16_t* WGU0 = (bf16_t*)(ws + WS_WGU0); bf16_t* WDN0 = (bf16_t*)(ws + WS_WDN0);
    bf16_t* WCD_IN = (bf16_t*)(ws + WS_WCD_IN); bf16_t* WGU1 = (bf16_t*)(ws + WS_WGU1);
    bf16_t* WRG = (bf16_t*)(ws + WS_WRG);
    int r = it;
    TR_JOB(p.ab_w_in, AB_IN, DM, 0, 6144, WAB_IN, 0, (const float*)nullptr)
    TR_JOB(p.ab_w_in, AB_IN, DM, 6160, 6144, WAB_IN, 6144, (const float*)nullptr)
    TR_JOB(p.ab_w_out, DM, DM, 0, DM, WAB_OUT, 0, (const float*)nullptr)
    TR_JOB_GU(p.ffn_w_gate, WGU0, 0, p.norm_ffn)
    TR_JOB_GU(p.ffn_w_up, WGU0, 128, p.norm_ffn)
    TR_JOB(p.ffn_w_down, DM, DFF, 0, DM, WDN0, 0, (const float*)nullptr)
    TR_JOB(p.cd_w_in, CD_IN, DM, 0, CD_IN, WCD_IN, 0, p.norm_mix + DM)
    TR_JOB_GU(p.ffn_w_gate + (size_t)DM * DFF, WGU1, 0, p.norm_ffn + DM)
    TR_JOB_GU(p.ffn_w_up + (size_t)DM * DFF, WGU1, 128, p.norm_ffn + DM)
    TR_JOB(p.cd_w_out, DM, DM, 0, DM, (bf16_t*)(ws + WS_WCD_OUT), 0, (const float*)nullptr)
    const int mat = r / 32, rr = r % 32, kb_ = rr / 8, nb_ = rr % 8;
    const float* W = (mat < 8 ? p.rg_w_x : p.rg_w_a) + (size_t)(mat & 7) * 65536;
    return TrDesc{W + (size_t)(64 * kb_) * 256 + 32 * nb_, WRG + (size_t)mat * 65536 + (size_t)(32 * nb_) * 256 + 64 * kb_, nullptr, 256, 256};
}
template <class F> __device__ __forceinline__ void tr_run(F item, int first, int step, int n, LAS float* scr, int lane) {
    if (first >= n) return;
    TrDesc da = item(first), db = da, dc = da; f32x4 va[8], vb[8], vc[8];
    tr_load(da, va, lane);
    if (first + step < n) { db = item(first + step); tr_load(db, vb, lane); }
    for (int it = first; it < n; it += 3 * step) {
        const bool h1 = it + step < n, h2 = it + 2 * step < n, h3 = it + 3 * step < n, h4 = it + 4 * step < n;
        if (h2) { dc = item(it + 2 * step); tr_load(dc, vc, lane); }
        tr_finish(da, va, scr, lane);
        if (h3) { da = item(it + 3 * step); tr_load(da, va, lane); }
        if (h1) tr_finish(db, vb, scr, lane);
        if (h4) { db = item(it + 4 * step); tr_load(db, vb, lane); }
        if (h2) tr_finish(dc, vc, scr, lane);
    }
}
struct TailItem { const float* W; bf16_t* WT; const float* W2; bf16_t* WT2;
    __device__ __forceinline__ TrDesc operator()(int r) const { constexpr int nnb = DM / 32;
        if (r < TAIL_ITEMS) { const int kb = r / nnb, nb = r % nnb; return TrDesc{W + (size_t)(64 * kb) * DM + 32 * nb, WT + (size_t)(32 * nb) * DFF + 64 * kb, nullptr, DM, DFF}; }
        r -= TAIL_ITEMS; const int kb = r / nnb, nb = r % nnb; return TrDesc{W2 + (size_t)(64 * kb) * DM + 32 * nb, WT2 + (size_t)(32 * nb) * DM + 64 * kb, nullptr, DM, DM}; } };
struct P0Item { const Params* p; int off; __device__ __forceinline__ TrDesc operator()(int r) const { return p0_item(*p, r + off); } };
constexpr int P0A_ITEMS = 2 * P0_I_AB;
__device__ __forceinline__ void p0b_convert(const Params& p, LAS unsigned char* lds, int tw, int ntw, int wave, int lane) {
    P0Item pi{&p, P0A_ITEMS}; tr_run(pi, tw, ntw, P0_NITEMS - P0A_ITEMS, (LAS float*)(lds + wave * 8704), lane);
}
struct Tail1Item { const float* W; bf16_t* WT;
    __device__ __forceinline__ TrDesc operator()(int r) const { constexpr int nnb = DM / 32; const int kb = TAILKB + r / nnb, nb = r % nnb;
        return TrDesc{W + (size_t)(64 * kb) * DM + 32 * nb, WT + (size_t)(32 * nb) * DFF + 64 * kb, nullptr, DM, DFF}; } };
__device__ __forceinline__ void tail1_convert(const Params& p, LAS unsigned char* lds, int tw, int ntw, int wave, int lane) {
    Tail1Item ti{p.ffn_w_down + (size_t)DFF * DM, (bf16_t*)(p.ws + WS_WDN1)};
    tr_run(ti, tw, ntw, P0_I_DN1, (LAS float*)(lds + wave * 8704), lane);
}
__device__ __forceinline__ void tail_convert(const Params& p, LAS unsigned char* lds, int tw, int ntw, int wave, int lane) {
    TailItem ti{p.ffn_w_down + (size_t)DFF * DM, (bf16_t*)(p.ws + WS_WDN1), p.cd_w_out, (bf16_t*)(p.ws + WS_WCD_OUT)};
    tr_run(ti, tw, ntw, TAIL_ITEMS, (LAS float*)(lds + wave * 8704), lane);
}
__device__ __forceinline__ void phase_p0(const Params& p, LAS unsigned char* lds, int gw, int ngw, int wave, int lane) {
    unsigned char* ws = p.ws;
    LAS float* scr = (LAS float*)(lds + wave * 8704);
    { P0Item pi{&p, 0}; tr_run(pi, gw, ngw, P0A_ITEMS, scr, lane); }
    { bf16_t* WS_ = (bf16_t*)(ws + WS_WSMALL);
      for (int i = gw * 64 + lane; i < 32 * DM; i += ngw * 64) { const int c = i & 31, k = i >> 5; const int sc = c < 16 ? 6144 + c : 12304 + (c - 16);
          WS_[(size_t)c * DM + k] = f2bf(p.ab_w_in[(size_t)k * AB_IN + sc]); } }
    phase_rms_bf16(p.x, p.norm_mix, (bf16_t*)(ws + WS_U), gw, ngw, lane);
}

__device__ __forceinline__ void phase_small32(const Params& p, LAS unsigned char* lds, int wave, int lane) {
    const bf16_t* U = (const bf16_t*)(p.ws + WS_U); const bf16_t* WS_ = (const bf16_t*)(p.ws + WS_WSMALL); float* S32 = (float*)(p.ws + WS_SMALL32);
    LAS float* red = (LAS float*)lds;
    const int h = lane >> 5, c = lane & 31;
    for (int unit = blockIdx.x; unit < MTOK / 32; unit += gridDim.x) {
        const int row0 = unit * 32, kbase = wave * 512;
        f32x16 acc; for (int i = 0; i < 16; ++i) acc[i] = 0.f;
        const bf16_t* ap = U + (size_t)(row0 + c) * DM + kbase + 8 * h; const bf16_t* bp = WS_ + (size_t)c * DM + kbase + 8 * h;
#pragma unroll 8
        for (int s = 0; s < 32; ++s) { const bf16x8 a = *(const bf16x8*)(ap + 16 * s), b = *(const bf16x8*)(bp + 16 * s); acc = MFMA32(a, b, acc); }
#pragma unroll
        for (int r = 0; r < 16; ++r) red[(wave * 32 + crow(r, h)) * 33 + c] = acc[r];
        __syncthreads();
        for (int i = threadIdx.x; i < 1024; i += NTHR) { const int t = i >> 5, cc = i & 31; float s = 0.f;
#pragma unroll
            for (int w = 0; w < 8; ++w) s += red[(w * 32 + t) * 33 + cc];
            S32[(size_t)(row0 + t) * 32 + cc] = s; }
        __syncthreads();
    }
}

__device__ __forceinline__ void phase_fox_cumsum(const Params& p, LAS unsigned char* lds, int wave, int lane) {
    const float* S32 = (const float*)(p.ws + WS_SMALL32); float* CF = (float*)(p.ws + WS_CF);
    LAS float* WT = (LAS float*)(lds + 90112);
    const int tid = threadIdx.x;
    for (int u = blockIdx.x; u < NB * 16; u += gridDim.x) { const int b = u >> 4, hd = u & 15; const float bias = p.fox_b_f[hd];
        float v[4];
#pragma unroll
        for (int i = 0; i < 4; ++i) v[i] = log_sigmoid_acc(S32[(size_t)(b * SEQ + 4 * tid + i) * 32 + 16 + hd] + bias);
        v[1] += v[0]; v[2] += v[1]; v[3] += v[2];
        const float tot = v[3]; float incl = tot;
#pragma unroll
        for (int o = 1; o < 64; o <<= 1) { const float t = __shfl_up(incl, o); if (lane >= o) incl += t; }
        if (lane == 63) WT[wave] = incl;
        __syncthreads();
        float off = incl - tot;
#pragma unroll
        for (int w = 0; w < 7; ++w) off += w < wave ? WT[w] : 0.f;
        *(f32x4*)(CF + (size_t)u * SEQ + 4 * tid) = (f32x4){v[0] + off, v[1] + off, v[2] + off, v[3] + off};
        __syncthreads();
    }
}

constexpr int GP_PITCH = 528;
__device__ __forceinline__ void phase_gla_pre(const Params& p, LAS unsigned char* lds, int wave, int lane) {
    const unsigned char* ws = p.ws;
    const bf16_t* PROJ = (const bf16_t*)(ws + WS_PROJ); const float* S32 = (const float*)(ws + WS_SMALL32);
    bf16_t* QT = (bf16_t*)(ws + WS_QT); bf16_t* KDT = (bf16_t*)(ws + WS_KDT); bf16_t* PM = (bf16_t*)(ws + WS_PM); float* GDEC = (float*)(ws + WS_GDEC);
    LAS float* G = (LAS float*)lds;
    LAS float* TOT = (LAS float*)(lds + 4096);
    LAS unsigned char* QTl = lds + 8192;
    LAS unsigned char* KTl = lds + 8192 + 64 * GP_PITCH;
    LAS unsigned char* PL = lds + 8192 + 128 * GP_PITCH;
    const int tid = threadIdx.x, k = tid & 255, th = tid >> 8, h = lane >> 5, l31 = lane & 31;
    for (int unit = blockIdx.x; unit < NB * 4 * 32; unit += gridDim.x) {
        const int b = unit >> 7, hd = (unit >> 5) & 3, c = unit & 31, R0 = b * SEQ + 64 * c;
        const bf16_t* qp = PROJ + (size_t)(R0 + 32 * th) * AB_MAIN + PJ_GQ + hd * 256 + k; const bf16_t* kp = PROJ + (size_t)(R0 + 32 * th) * AB_MAIN + PJ_GK + hd * 256 + k;
        bf16_t qraw[32], kraw[32];
#pragma unroll
        for (int tt = 0; tt < 32; ++tt) { qraw[tt] = qp[(size_t)tt * AB_MAIN]; kraw[tt] = kp[(size_t)tt * AB_MAIN]; }
        for (int i = tid; i < 1024; i += NTHR) G[i] = S32[(size_t)(R0 + (i >> 4)) * 32 + (i & 15)];
        float w[16];
#pragma unroll
        for (int r = 0; r < 16; ++r) w[r] = p.gla_w_gate_up[r * 1024 + hd * 256 + k];
        const float bias = p.gla_b_gate[hd * 256 + k];
        __syncthreads();
        float bc[32]; float run = 0.f;
#pragma unroll
        for (int tt = 0; tt < 32; ++tt) { const LAS f32x4* g4 = (const LAS f32x4*)(G + (32 * th + tt) * 16); float xx = bias;
#pragma unroll
            for (int q4 = 0; q4 < 4; ++q4) { const f32x4 gv = g4[q4]; xx += gv.x * w[4 * q4] + gv.y * w[4 * q4 + 1] + gv.z * w[4 * q4 + 2] + gv.w * w[4 * q4 + 3]; }
            run += log_sigmoid_fast(xx) * (LOG2E_F / 16.0f); bc[tt] = run; }
        TOT[th * 256 + k] = run;
        __syncthreads();
        const float t0 = TOT[k], t1 = TOT[256 + k], blast = t0 + t1, boff = th ? t0 : 0.f;
        if (th == 0) GDEC[(size_t)unit * 256 + k] = __builtin_amdgcn_exp2f(blast);
#pragma unroll
        for (int t8 = 0; t8 < 4; ++t8) { float kd[8];
#pragma unroll
            for (int i = 0; i < 8; ++i) { const int tt = 8 * t8 + i; const float bb = bc[tt] + boff;
                const float qv = bf2f(qraw[tt]), kv = bf2f(kraw[tt]);
                const float qt = qv * 0.0625f * __builtin_amdgcn_exp2f(bb), kt = kv * __builtin_amdgcn_exp2f(-bb); kd[i] = kv * __builtin_amdgcn_exp2f(blast - bb);
                const bf16_t qb = f2bf(qt);
                *(LAS bf16_t*)(QTl + (32 * th + tt) * GP_PITCH + 2 * k) = qb; *(LAS bf16_t*)(KTl + (32 * th + tt) * GP_PITCH + 2 * k) = f2bf(kt);
                }
            u32x4 o; o.x = cvt_pk_bf16(kd[0], kd[1]); o.y = cvt_pk_bf16(kd[2], kd[3]); o.z = cvt_pk_bf16(kd[4], kd[5]); o.w = cvt_pk_bf16(kd[6], kd[7]);
            *(u32x4*)(KDT + (((size_t)unit * 8 + (k >> 5)) * 4 + 2 * th + (t8 >> 1)) * 512 + ((k & 31) + 32 * (t8 & 1)) * 8) = o; }
        __syncthreads();
#pragma unroll
        for (int f = 0; f < 4; ++f) { const int ti = f >> 1, s2 = f & 1; const LAS unsigned char* qp8 = QTl + (32 * ti + l31) * GP_PITCH + (32 * wave + 16 * s2 + 4 * h) * 2;
            const s16x4 lo = *(const LAS s16x4*)qp8, hi = *(const LAS s16x4*)(qp8 + 16);
            *(bf16x8*)(QT + (((size_t)unit * 8 + wave) * 4 + f) * 512 + lane * 8) = cat4(lo, hi); }
        if (wave < 4) { const int ti = wave & 1, si = wave >> 1;
            f32x16 acc; for (int i = 0; i < 16; ++i) acc[i] = 0.f;
            const LAS unsigned char* ap = QTl + (32 * ti + (lane & 31)) * GP_PITCH + 16 * h; const LAS unsigned char* bp = KTl + (32 * si + (lane & 31)) * GP_PITCH + 16 * h;
#pragma unroll
            for (int s = 0; s < 16; ++s) { const bf16x8 a = *(const LAS bf16x8*)(ap + 32 * s), bb = *(const LAS bf16x8*)(bp + 32 * s); acc = MFMA32(a, bb, acc); }
            const int sc = 32 * si + (lane & 31);
#pragma unroll
            for (int r = 0; r < 16; ++r) { const int t = 32 * ti + crow(r, h); *(LAS bf16_t*)(PL + t * 144 + 2 * sc) = f2bf(sc <= t ? acc[r] : 0.f); }
        }
        __syncthreads();
        { const int f = tid >> 6, tip = f >> 2, ssp = f & 3;
          *(bf16x8*)(PM + ((size_t)unit * 8 + f) * 512 + lane * 8) = *(const LAS bf16x8*)(PL + (32 * tip + l31) * 144 + (16 * ssp + 8 * h) * 2); }
        __syncthreads();
    }
}

constexpr int VT_PITCH = 144;
struct GlaChunk { u32x2 vraw; bf16x8 qa00, qa01, qa10, qa11, kd0, kd1, kd2, kd3, pa; float gdv; };
__device__ __forceinline__ void gla_load_chunk(GlaChunk& r, const bf16_t* PROJ, const bf16_t* QT, const bf16_t* KDT, const bf16_t* PM, const float* GDEC, int b, int hd, int v0, int c, int wave, int tid, int h, int l31) {
    const int R0 = b * SEQ + 64 * c, cu = (b * 4 + hd) * 32 + c;
    r.gdv = tid < 256 ? GDEC[(size_t)cu * 256 + tid] : 0.f;
    { const int s = tid >> 3, v4 = (tid & 7) * 4; r.vraw = *(const u32x2*)(PROJ + (size_t)(R0 + s) * AB_MAIN + PJ_GV + hd * 512 + v0 + v4); }
    { const bf16_t* qf = QT + (((size_t)cu * 8 + wave) * 4) * 512 + (tid & 63) * 8;
      r.qa00 = *(const bf16x8*)qf; r.qa01 = *(const bf16x8*)(qf + 512); r.qa10 = *(const bf16x8*)(qf + 1024); r.qa11 = *(const bf16x8*)(qf + 1536); }
    { const bf16_t* kf = KDT + (((size_t)cu * 8 + wave) * 4) * 512 + (tid & 63) * 8;
      r.kd0 = *(const bf16x8*)kf; r.kd1 = *(const bf16x8*)(kf + 512); r.kd2 = *(const bf16x8*)(kf + 1024); r.kd3 = *(const bf16x8*)(kf + 1536); }
    r.pa = *(const bf16x8*)(PM + ((size_t)cu * 8 + (wave & 1) * 4 + (wave >> 1)) * 512 + (tid & 63) * 8);
}
__device__ __forceinline__ void phase_gla_seq(const Params& p, LAS unsigned char* lds, int wave, int lane) {
    const unsigned char* ws = p.ws;
    const bf16_t* PROJ = (const bf16_t*)(ws + WS_PROJ); const bf16_t* QT = (const bf16_t*)(ws + WS_QT); const bf16_t* KDT = (const bf16_t*)(ws + WS_KDT); const bf16_t* PM = (const bf16_t*)(ws + WS_PM);
    const float* GDEC = (const float*)(ws + WS_GDEC); float* ORAW = (float*)(p.ws + WS_ORAW); float* SSQ = (float*)(p.ws + WS_SSQ);
    LAS float* RED = (LAS float*)lds;
    LAS unsigned char* VT = lds + 65536;
    LAS float* GD = (LAS float*)(lds + 65536 + 2 * 32 * VT_PITCH);
    const int tid = threadIdx.x, h = lane >> 5, l31 = lane & 31;
    for (int u0 = blockIdx.x; u0 < NB * 4 * 16; u0 += gridDim.x) {
        const int unit = xcd_swz(u0, NB * 4 * 16);
        const int b = unit >> 6, hd = (unit >> 4) & 3, vs = unit & 15, v0 = 32 * vs;
        f32x16 S; for (int i = 0; i < 16; ++i) S[i] = 0.f;
        GlaChunk cA, cB;
        gla_load_chunk(cA, PROJ, QT, KDT, PM, GDEC, b, hd, v0, 0, wave, tid, h, l31);
        auto chunk = [&](const int c, GlaChunk& cur, GlaChunk& nxt) __attribute__((always_inline)) {
            const int R0 = b * SEQ + 64 * c;
            LAS unsigned char* vt = VT + (c & 1) * (32 * VT_PITCH);
            { const int s = tid >> 3, v4 = (tid & 7) * 4; const u32x2 raw = cur.vraw;
              *(LAS bf16_t*)(vt + (v4 + 0) * VT_PITCH + 2 * s) = (bf16_t)(raw.x & 0xffffu); *(LAS bf16_t*)(vt + (v4 + 1) * VT_PITCH + 2 * s) = (bf16_t)(raw.x >> 16);
              *(LAS bf16_t*)(vt + (v4 + 2) * VT_PITCH + 2 * s) = (bf16_t)(raw.y & 0xffffu); *(LAS bf16_t*)(vt + (v4 + 3) * VT_PITCH + 2 * s) = (bf16_t)(raw.y >> 16); }
            if (tid < 256) GD[(c & 1) * 256 + tid] = cur.gdv;
            if (c + 1 < 32) gla_load_chunk(nxt, PROJ, QT, KDT, PM, GDEC, b, hd, v0, c + 1, wave, tid, h, l31);
            LDS_BARRIER();
            const int tip = wave & 1, ssp = wave >> 1;
            f32x16 oacc[2];
#pragma unroll
            for (int ti = 0; ti < 2; ++ti) for (int i = 0; i < 16; ++i) oacc[ti][i] = 0.f;
            const bf16x8 sb0 = pack8(S[0], S[1], S[2], S[3], S[4], S[5], S[6], S[7]), sb1 = pack8(S[8], S[9], S[10], S[11], S[12], S[13], S[14], S[15]);
            oacc[0] = MFMA32(cur.qa00, sb0, oacc[0]); oacc[0] = MFMA32(cur.qa01, sb1, oacc[0]);
            oacc[1] = MFMA32(cur.qa10, sb0, oacc[1]); oacc[1] = MFMA32(cur.qa11, sb1, oacc[1]);
            bf16x8 vb[4];
#pragma unroll
            for (int ss = 0; ss < 4; ++ss) vb[ss] = *(const LAS bf16x8*)(vt + l31 * VT_PITCH + 32 * ss + 16 * h);
            { const bf16x8 vbp = ssp == 0 ? vb[0] : ssp == 1 ? vb[1] : ssp == 2 ? vb[2] : vb[3];
              if (tip == 0) oacc[0] = MFMA32(cur.pa, vbp, oacc[0]); else oacc[1] = MFMA32(cur.pa, vbp, oacc[1]); }
            { const LAS float* gp = GD + (c & 1) * 256 + 32 * wave + 4 * h; const f32x4 g0 = *(const LAS f32x4*)gp, g1 = *(const LAS f32x4*)(gp + 8), g2 = *(const LAS f32x4*)(gp + 16), g3 = *(const LAS f32x4*)(gp + 24);
#pragma unroll
              for (int i = 0; i < 4; ++i) { S[i] *= g0[i]; S[4 + i] *= g1[i]; S[8 + i] *= g2[i]; S[12 + i] *= g3[i]; } }
            S = MFMA32(cur.kd0, vb[0], S); S = MFMA32(cur.kd1, vb[1], S); S = MFMA32(cur.kd2, vb[2], S); S = MFMA32(cur.kd3, vb[3], S);
#pragma unroll
            for (int ti = 0; ti < 2; ++ti)
#pragma unroll
                for (int r = 0; r < 16; ++r) RED[(wave * 64 + 32 * ti + crow(r, h)) * 32 + l31] = oacc[ti][r];
            LDS_BARRIER();
            { const int t = tid >> 3, v4 = (tid & 7) * 4; f32x4 o = {0.f, 0.f, 0.f, 0.f};
#pragma unroll
              for (int w = 0; w < 8; ++w) o += *(const LAS f32x4*)(RED + (w * 64 + t) * 32 + v4);
              *(f32x4*)(ORAW + (size_t)(R0 + t) * 2048 + hd * 512 + v0 + v4) = o;
              float q = (o.x * o.x + o.y * o.y) + (o.z * o.z + o.w * o.w);
              q += __shfl_xor(q, 1); q += __shfl_xor(q, 2); q += __shfl_xor(q, 4);
              if ((tid & 7) == 0) SSQ[(size_t)(R0 + t) * 64 + hd * 16 + vs] = q; }
        };
        for (int c = 0; c < 32; c += 2) { chunk(c, cA, cB); chunk(c + 1, cB, cA); }
        __syncthreads();
    }
}

__device__ __forceinline__ void phase_gla_post(const Params& p, int gw, int ngw, int lane) {
    const bf16_t* PROJ = (const bf16_t*)(p.ws + WS_PROJ); const float* ORAW = (const float*)(p.ws + WS_ORAW); const float* SSQ = (const float*)(p.ws + WS_SSQ); bf16_t* O = (bf16_t*)(p.ws + WS_O);
    const f32x4 gn0 = *(const f32x4*)(p.gla_norm + 8 * lane), gn1 = *(const f32x4*)(p.gla_norm + 8 * lane + 4);
    for (int u = gw; u < MTOK * 4; u += ngw) { const int row = u >> 2, hd = u & 3;
        float ss = 0.f;
#pragma unroll
        for (int i = 0; i < 4; ++i) { const f32x4 s4 = *(const f32x4*)(SSQ + (size_t)row * 64 + hd * 16 + 4 * i); ss += (s4.x + s4.y) + (s4.z + s4.w); }
        const float rstd = 1.0f / sqrtf(ss * (1.0f / 512.0f) + EPS);
        const f32x4 o0 = *(const f32x4*)(ORAW + (size_t)row * 2048 + hd * 512 + 8 * lane), o1 = *(const f32x4*)(ORAW + (size_t)row * 2048 + hd * 512 + 8 * lane + 4);
        const u32x4 gr = *(const u32x4*)(PROJ + (size_t)row * AB_MAIN + PJ_GG + hd * 512 + 8 * lane);
        float g[8] = {bflo(gr.x), bfhi(gr.x), bflo(gr.y), bfhi(gr.y), bflo(gr.z), bfhi(gr.z), bflo(gr.w), bfhi(gr.w)};
        float o[8] = {o0.x * gn0.x, o0.y * gn0.y, o0.z * gn0.z, o0.w * gn0.w, o1.x * gn1.x, o1.y * gn1.y, o1.z * gn1.z, o1.w * gn1.w};
#pragma unroll
        for (int i = 0; i < 8; ++i) o[i] = o[i] * rstd * g[i] / (1.0f + __expf(-g[i]));
        u32x4 w; w.x = cvt_pk_bf16(o[0], o[1]); w.y = cvt_pk_bf16(o[2], o[3]); w.z = cvt_pk_bf16(o[4], o[5]); w.w = cvt_pk_bf16(o[6], o[7]);
        *(u32x4*)(O + (size_t)row * DM + hd * 512 + 8 * lane) = w; }
}

constexpr int AK_PITCH = 272, AV_PITCH = 320;
constexpr int AK_BYTES = 64 * AK_PITCH, AV_BYTES = 64 * AV_PITCH;
constexpr int A_KOFF = 0, A_VOFF = 2 * AK_BYTES, A_COFF = A_VOFF + 2 * AV_BYTES, A_FLAGS = A_COFF + 512;
constexpr float ATT_SCALE = 0.08838834764831845f;
constexpr float LOG2E = 1.4426950408889634f;

struct AttnIO { const bf16_t* Q; const bf16_t* K; const bf16_t* V; int ld; bf16_t* O; int ldo; };

__device__ __forceinline__ void attn_stage_load(const AttnIO& io, size_t rowbase, int hd, int key0, u32x4 (&kr)[2], u32x4 (&vr)[2], int tid) {
#pragma unroll
    for (int i = 0; i < 2; ++i) { const int idx = tid + NTHR * i, r = idx >> 4, ch = idx & 15; const size_t off = (rowbase + key0 + r) * (size_t)io.ld + hd * 128 + ch * 8;
        kr[i] = *(const u32x4*)(io.K + off); vr[i] = *(const u32x4*)(io.V + off); }
}
__device__ __forceinline__ void attn_stage_store(LAS unsigned char* lds, int buf, const u32x4 (&kr)[2], const u32x4 (&vr)[2], int tid) {
#pragma unroll
    for (int i = 0; i < 2; ++i) { const int idx = tid + NTHR * i, r = idx >> 4, ch = idx & 15;
        *(LAS u32x4*)(lds + A_KOFF + buf * AK_BYTES + r * AK_PITCH + ch * 16) = kr[i]; *(LAS u32x4*)(lds + A_VOFF + buf * AV_BYTES + r * AV_PITCH + ch * 16) = vr[i]; }
}
__device__ __forceinline__ void attn_qk(LAS unsigned char* lds, int buf, const bf16x8 (&qf)[8], f32x16& s0, f32x16& s1, int lane) {
    const LAS unsigned char* kp = lds + A_KOFF + buf * AK_BYTES + (lane & 31) * AK_PITCH + (lane >> 5) * 16;
    for (int i = 0; i < 16; ++i) { s0[i] = 0.f; s1[i] = 0.f; }
#pragma unroll
    for (int s = 0; s < 8; ++s) { const bf16x8 a0 = *(const LAS bf16x8*)(kp + 32 * s), a1 = *(const LAS bf16x8*)(kp + 32 * AK_PITCH + 32 * s);
        s0 = MFMA32(a0, qf[s], s0); s1 = MFMA32(a1, qf[s], s1); }
}
__device__ __forceinline__ void attn_pv(LAS unsigned char* lds, int buf, const f32x16& p0, const f32x16& p1, f32x16 (&o)[4], int lane) {
    const lds_cptr vp = (lds_cptr)(lds + A_VOFF + buf * AV_BYTES + (4 * (lane >> 5) + ((lane & 15) >> 2)) * AV_PITCH + (((lane >> 4) & 1) * 16 + (lane & 3) * 4) * 2);
    const bf16x8 pf00 = pack8(p0[0], p0[1], p0[2], p0[3], p0[4], p0[5], p0[6], p0[7]), pf01 = pack8(p0[8], p0[9], p0[10], p0[11], p0[12], p0[13], p0[14], p0[15]);
    const bf16x8 pf10 = pack8(p1[0], p1[1], p1[2], p1[3], p1[4], p1[5], p1[6], p1[7]), pf11 = pack8(p1[8], p1[9], p1[10], p1[11], p1[12], p1[13], p1[14], p1[15]);
#pragma unroll
    for (int dt = 0; dt < 4; ++dt) {
        const bf16x8 a00 = cat4(vtr(vp + (0) * AV_PITCH + dt * 64), vtr(vp + (8) * AV_PITCH + dt * 64));
        const bf16x8 a01 = cat4(vtr(vp + (16) * AV_PITCH + dt * 64), vtr(vp + (24) * AV_PITCH + dt * 64));
        const bf16x8 a10 = cat4(vtr(vp + (32) * AV_PITCH + dt * 64), vtr(vp + (40) * AV_PITCH + dt * 64));
        const bf16x8 a11 = cat4(vtr(vp + (48) * AV_PITCH + dt * 64), vtr(vp + (56) * AV_PITCH + dt * 64));
        o[dt] = MFMA32(a00, pf00, o[dt]); o[dt] = MFMA32(a01, pf01, o[dt]); o[dt] = MFMA32(a10, pf10, o[dt]); o[dt] = MFMA32(a11, pf11, o[dt]);
    }
}
__device__ __forceinline__ void attn_store_o(const AttnIO& io, size_t row, int hd, const f32x16 (&o)[4], float scl, int lane) {
    bf16_t* op = io.O + row * (size_t)io.ldo + hd * 128 + 4 * (lane >> 5);
#pragma unroll
    for (int dt = 0; dt < 4; ++dt)
#pragma unroll
        for (int g = 0; g < 4; ++g) { u32x2 w; w.x = cvt_pk_bf16(o[dt][4 * g] * scl, o[dt][4 * g + 1] * scl); w.y = cvt_pk_bf16(o[dt][4 * g + 2] * scl, o[dt][4 * g + 3] * scl);
            *(u32x2*)(op + 32 * dt + 8 * g) = w; }
}

__device__ __forceinline__ void fox_unit(const AttnIO& io, const float* CF, LAS unsigned char* lds, int b, int hd, int qb, int wave, int lane) {
    const int tid = threadIdx.x, h = lane >> 5, l31 = lane & 31;
    const size_t rowbase = (size_t)b * SEQ; const int q0w = 256 * qb + 32 * wave, qpos = q0w + l31;
    const float* cf = CF + (size_t)(b * 16 + hd) * SEQ;
    bf16x8 qf[8];
#pragma unroll
    for (int s = 0; s < 8; ++s) qf[s] = *(const bf16x8*)(io.Q + (rowbase + qpos) * (size_t)io.ld + hd * 128 + 16 * s + 8 * h);
    const float cq = cf[qpos] * LOG2E;
    f32x16 o[4];
#pragma unroll
    for (int dt = 0; dt < 4; ++dt) for (int i = 0; i < 16; ++i) o[dt][i] = 0.f;
    float m = -1e30f, l = 0.f;
    const int ntiles = 4 * qb + 4;
    u32x4 kr[2], vr[2];
    LAS float* cks = (LAS float*)(lds + A_COFF);
    attn_stage_load(io, rowbase, hd, 64 * (ntiles - 1), kr, vr, tid);
    attn_stage_store(lds, 0, kr, vr, tid);
    if (tid < 64) cks[tid] = cf[64 * (ntiles - 1) + tid] * LOG2E;
    __syncthreads();
    for (int jj = 0; jj < ntiles; ++jj) {
        const int j = ntiles - 1 - jj, buf = jj & 1; const bool more = jj + 1 < ntiles;
        float cnext = 0.f;
        if (more) { attn_stage_load(io, rowbase, hd, 64 * (j - 1), kr, vr, tid); if (tid < 64) cnext = cf[64 * (j - 1) + tid] * LOG2E; }
        if (64 * j <= q0w + 31) {
            f32x16 s0, s1; attn_qk(lds, buf, qf, s0, s1, lane);
            const LAS float* ck = cks + buf * 64;
            const bool diag = 64 * j + 63 > q0w;
            float mx = -__builtin_inff();
#pragma unroll
            for (int g = 0; g < 4; ++g) { const f32x4 c0 = *(const LAS f32x4*)(ck + 8 * g + 4 * h), c1 = *(const LAS f32x4*)(ck + 32 + 8 * g + 4 * h);
#pragma unroll
                for (int i = 0; i < 4; ++i) { const int r = 4 * g + i, key = 64 * j + 8 * g + 4 * h + i;
                    float y0 = s0[r] * (ATT_SCALE * LOG2E) + (cq - c0[i]), y1 = s1[r] * (ATT_SCALE * LOG2E) + (cq - c1[i]);
                    if (diag) { y0 = key <= qpos ? y0 : -__builtin_inff(); y1 = key + 32 <= qpos ? y1 : -__builtin_inff(); }
                    s0[r] = y0; s1[r] = y1; mx = fmaxf(mx, fmaxf(y0, y1)); } }
            mx = fmaxf(mx, __shfl_xor(mx, 32));
            if (!__all(mx - m <= 8.0f)) {
                const float mn = fmaxf(m, mx), alpha = __builtin_amdgcn_exp2f(m - mn); m = mn; l *= alpha;
#pragma unroll
                for (int dt = 0; dt < 4; ++dt) for (int i = 0; i < 16; ++i) o[dt][i] *= alpha;
            }
            float ps = 0.f;
#pragma unroll
            for (int r = 0; r < 16; ++r) { s0[r] = __builtin_amdgcn_exp2f(s0[r] - m); s1[r] = __builtin_amdgcn_exp2f(s1[r] - m); ps += s0[r] + s1[r]; }
            l += ps;
            attn_pv(lds, buf, s0, s1, o, lane);
        }
        if (more) { attn_stage_store(lds, buf ^ 1, kr, vr, tid); if (tid < 64) cks[(buf ^ 1) * 64 + tid] = cnext; }
        __syncthreads();
    }
    l += __shfl_xor(l, 32);
    attn_store_o(io, rowbase + qpos, hd, o, 1.0f / l, lane);
}

__device__ __forceinline__ void sb_subtile(f32x16& s, int keybase, int qpos, int h, float& P, bool diag) {
    float be[16], om[16];
#pragma unroll
    for (int r = 0; r < 16; ++r) { const float z2 = s[r] * (ATT_SCALE * LOG2E); const float t = __builtin_amdgcn_exp2f(-fabsf(z2)); const float rr = __builtin_amdgcn_rcpf(1.0f + t), tr = t * rr;
        const bool pos = z2 >= 0.f; be[r] = pos ? rr : tr; om[r] = pos ? tr : rr;
        if (diag) { const bool valid = keybase + crow(r, h) < qpos; be[r] = valid ? be[r] : 0.f; om[r] = valid ? om[r] : 1.0f; } }
    float T[4], Tp[4];
#pragma unroll
    for (int g = 0; g < 4; ++g) { T[g] = (om[4 * g] * om[4 * g + 1]) * (om[4 * g + 2] * om[4 * g + 3]); Tp[g] = __shfl_xor(T[g], 32); }
    float run = P;
#pragma unroll
    for (int g = 3; g >= 0; --g) {
        const float off = h ? run : run * Tp[g];
        const float sf2 = om[4 * g + 3], sf1 = sf2 * om[4 * g + 2], sf0 = sf1 * om[4 * g + 1];
        s[4 * g + 3] = be[4 * g + 3] * off; s[4 * g + 2] = be[4 * g + 2] * (off * sf2); s[4 * g + 1] = be[4 * g + 1] * (off * sf1); s[4 * g] = be[4 * g] * (off * sf0);
        run *= T[g] * Tp[g];
    }
    P = run;
}
__device__ __forceinline__ void sb_unit(const AttnIO& io, LAS unsigned char* lds, int b, int hd, int qb, int wave, int lane) {
    const int tid = threadIdx.x, h = lane >> 5, l31 = lane & 31;
    const size_t rowbase = (size_t)b * SEQ; const int qpos = 256 * qb + 32 * wave + l31;
    bf16x8 qf[8];
#pragma unroll
    for (int s = 0; s < 8; ++s) qf[s] = *(const bf16x8*)(io.Q + (rowbase + qpos) * (size_t)io.ld + hd * 128 + 16 * s + 8 * h);
    f32x16 o[4];
#pragma unroll
    for (int dt = 0; dt < 4; ++dt) for (int i = 0; i < 16; ++i) o[dt][i] = 0.f;
    float R = 1.0f;
    bool wdone = false;
    const int ntiles = 4 * qb + 4;
    u32x4 kr[2], vr[2];
    LAS unsigned* flags = (LAS unsigned*)(lds + A_FLAGS);
    attn_stage_load(io, rowbase, hd, 64 * (ntiles - 1), kr, vr, tid);
    attn_stage_store(lds, 0, kr, vr, tid);
    __syncthreads();
    for (int jj = 0; jj < ntiles; ++jj) {
        const int j = ntiles - 1 - jj, buf = jj & 1; const bool more = jj + 1 < ntiles;
        if (more) attn_stage_load(io, rowbase, hd, 64 * (j - 1), kr, vr, tid);
        if (!wdone && 64 * j < 256 * qb + 32 * wave + 31) {
            f32x16 s0, s1; attn_qk(lds, buf, qf, s0, s1, lane);
            const bool diag = 64 * j + 63 >= 256 * qb + 32 * wave;
            sb_subtile(s1, 64 * j + 32, qpos, h, R, diag);
            sb_subtile(s0, 64 * j, qpos, h, R, diag);
            attn_pv(lds, buf, s0, s1, o, lane);
            wdone = __all(R == 0.0f);
        }
        if (more) attn_stage_store(lds, buf ^ 1, kr, vr, tid);
        if (lane == 0) flags[buf * 8 + wave] = wdone ? 1u : 0u;
        __syncthreads();
        { const u32x4 f0 = *(const LAS u32x4*)(flags + buf * 8), f1 = *(const LAS u32x4*)(flags + buf * 8 + 4);
          if ((f0.x & f0.y & f0.z & f0.w & f1.x & f1.y & f1.z & f1.w) != 0u) break; }
    }
    attn_store_o(io, rowbase + qpos, hd, o, 1.0f, lane);
}

constexpr int RG_XPITCH = 528;
constexpr int RG_XC = 0, RG_GX = 128 * RG_XPITCH, RG_GA = RG_GX + 128 * 32 * 4, RG_HB = RG_GA + 128 * 32 * 4, RG_CW = RG_HB + 128 * 32 * 4, RG_SPL = RG_CW + 5 * 256 * 4, RG_SA = RG_SPL + 128, RG_SB = RG_SA + 2048, RG_HS = RG_SB + 2048, RG_HIN = RG_HS + 256;
__device__ __forceinline__ float gelu_tanh(float x) { const float u = 0.7978845608028654f * (x + 0.044715f * x * x * x); const float e = __expf(2.0f * u); const float th = 1.0f - 2.0f * __builtin_amdgcn_rcpf(e + 1.0f); return 0.5f * x * (1.0f + th); }
__device__ __forceinline__ void rg_load_raw(const bf16_t* PROJ, size_t rowb, int T0, int tg, int cb, int cc, u32x4 (&raw)[11]) {
    const bf16_t* base = PROJ + (rowb + T0 + 8 * tg) * CD_IN + PJ_RX + cb + 8 * cc;
#pragma unroll
    for (int i = 0; i < 11; ++i) { const int t = T0 + 8 * tg - 3 + i; if (t >= 0) raw[i] = *(const u32x4*)(base + (ptrdiff_t)(i - 3) * CD_IN); else raw[i] = (u32x4){0u, 0u, 0u, 0u}; }
}
__device__ __forceinline__ void phase_rg(const Params& p, LAS unsigned char* lds, int wave, int lane) {
    const unsigned char* ws = p.ws;
    const bf16_t* PROJ = (const bf16_t*)(ws + WS_PROJ); const bf16_t* WRG = (const bf16_t*)(ws + WS_WRG); bf16_t* O = (bf16_t*)(p.ws + WS_O);
    const int tid = threadIdx.x, h = lane >> 5, l31 = lane & 31;
    LAS float* GX = (LAS float*)(lds + RG_GX); LAS float* GA = (LAS float*)(lds + RG_GA); LAS float* HB = (LAS float*)(lds + RG_HB); LAS float* CW = (LAS float*)(lds + RG_CW); LAS float* SPL = (LAS float*)(lds + RG_SPL); LAS float* SA = (LAS float*)(lds + RG_SA); LAS float* SB = (LAS float*)(lds + RG_SB); LAS float* HS = (LAS float*)(lds + RG_HS); LAS float* HIN = (LAS float*)(lds + RG_HIN);
    const int cc = tid & 31, tg = tid >> 5;
    const int et = tid >> 2, ej = (tid & 3) * 8;
    for (int u0 = blockIdx.x; u0 < NB * 8 * 8; u0 += gridDim.x) {
        const int unit = xcd_swz(u0, NB * 8 * 8);
        const int b = unit >> 6, g = (unit >> 3) & 7, js = unit & 7, cb = 256 * g, c0 = cb + 32 * js;
        const size_t rowb = (size_t)b * SEQ;
        const int gate = wave >> 2, ti = wave & 3;
        bf16x8 wf[16];
        { const bf16_t* wp = WRG + ((size_t)(gate * 8 + g) * 256 + 32 * js + l31) * 256 + 8 * h;
#pragma unroll
          for (int s = 0; s < 16; ++s) wf[s] = *(const bf16x8*)(wp + 16 * s); }
        const float gbias = (gate ? p.rg_b_a : p.rg_b_x)[c0 + l31];
        for (int i = tid; i < 5 * 256; i += NTHR) { const int j = i >> 8, c = i & 255; CW[i] = j < 4 ? p.rg_conv_w[j * 2048 + cb + c] : p.rg_conv_b[cb + c]; }
        if (tid < 32) { const float lam = p.rg_lambda[c0 + tid]; SPL[tid] = -8.0f * LOG2E * (fmaxf(-lam, 0.f) + log1pf(expf(-fabsf(lam)))); }
        u32x4 raw[11];
        rg_load_raw(PROJ, rowb, 0, tg, cb, cc, raw);
        if (tid < 32) HS[tid] = 0.f;
        __syncthreads();
        for (int tt = 0; tt < SEQ / 128; ++tt) {
            const int T0 = 128 * tt; const size_t R0 = rowb + T0;
            const u32x4 ryraw = *(const u32x4*)(PROJ + (R0 + et) * CD_IN + PJ_RY + c0 + ej);
            { float w0[8], w1[8], w2[8], w3[8], bb[8];
#pragma unroll
              for (int q = 0; q < 2; ++q) { const f32x4 a0 = *(const LAS f32x4*)(CW + 0 * 256 + 8 * cc + 4 * q), a1 = *(const LAS f32x4*)(CW + 1 * 256 + 8 * cc + 4 * q), a2 = *(const LAS f32x4*)(CW + 2 * 256 + 8 * cc + 4 * q),
                                                          a3 = *(const LAS f32x4*)(CW + 3 * 256 + 8 * cc + 4 * q), a4 = *(const LAS f32x4*)(CW + 4 * 256 + 8 * cc + 4 * q);
#pragma unroll
                  for (int e = 0; e < 4; ++e) { w0[4 * q + e] = a0[e]; w1[4 * q + e] = a1[e]; w2[4 * q + e] = a2[e]; w3[4 * q + e] = a3[e]; bb[4 * q + e] = a4[e]; } }
#pragma unroll
              for (int i = 0; i < 8; ++i) { float xo[8];
#pragma unroll
                  for (int e2 = 0; e2 < 4; ++e2) { const unsigned r0 = raw[i][e2], r1 = raw[i + 1][e2], r2 = raw[i + 2][e2], r3 = raw[i + 3][e2];
                      f32x2 a2 = (f32x2){bb[2 * e2], bb[2 * e2 + 1]};
                      a2 = (f32x2){w0[2 * e2], w0[2 * e2 + 1]} * (f32x2){bflo(r0), bfhi(r0)} + a2; a2 = (f32x2){w1[2 * e2], w1[2 * e2 + 1]} * (f32x2){bflo(r1), bfhi(r1)} + a2;
                      a2 = (f32x2){w2[2 * e2], w2[2 * e2 + 1]} * (f32x2){bflo(r2), bfhi(r2)} + a2; a2 = (f32x2){w3[2 * e2], w3[2 * e2 + 1]} * (f32x2){bflo(r3), bfhi(r3)} + a2;
                      xo[2 * e2] = a2.x; xo[2 * e2 + 1] = a2.y; }
                  u32x4 o; o.x = cvt_pk_bf16(xo[0], xo[1]); o.y = cvt_pk_bf16(xo[2], xo[3]); o.z = cvt_pk_bf16(xo[4], xo[5]); o.w = cvt_pk_bf16(xo[6], xo[7]);
                  *(LAS u32x4*)(lds + RG_XC + (8 * tg + i) * RG_XPITCH + 16 * cc) = o; } }
            if (tt + 1 < SEQ / 128) rg_load_raw(PROJ, rowb, T0 + 128, tg, cb, cc, raw);
            LDS_BARRIER();
            { f32x16 acc; for (int i = 0; i < 16; ++i) acc[i] = 0.f;
              const LAS unsigned char* ap = lds + RG_XC + (32 * ti + l31) * RG_XPITCH + 16 * h;
#pragma unroll
              for (int s = 0; s < 16; ++s) { const bf16x8 a = *(const LAS bf16x8*)(ap + 32 * s); acc = MFMA32(a, wf[s], acc); }
              LAS float* gout = gate ? GA : GX;
#pragma unroll
              for (int r = 0; r < 16; ++r) { const float v = acc[r] + gbias; gout[(32 * ti + crow(r, h)) * 32 + l31] = __builtin_amdgcn_rcpf(1.0f + __expf(-v)); } }
            LDS_BARRIER();
            { const u32x4 xr = *(const LAS u32x4*)(lds + RG_XC + et * RG_XPITCH + 2 * (32 * js + ej));
              const float xc[8] = {bflo(xr.x), bfhi(xr.x), bflo(xr.y), bfhi(xr.y), bflo(xr.z), bfhi(xr.z), bflo(xr.w), bfhi(xr.w)};
#pragma unroll
              for (int q = 0; q < 2; ++q) { f32x4 ga = *(const LAS f32x4*)(GA + et * 32 + ej + 4 * q), gx = *(const LAS f32x4*)(GX + et * 32 + ej + 4 * q); const f32x4 sp = *(const LAS f32x4*)(SPL + ej + 4 * q);
#pragma unroll
                  for (int e = 0; e < 4; ++e) { const float a = __builtin_amdgcn_exp2f(ga[e] * sp[e]); const float mult = sqrtf(fmaxf(1.0f - a * a, 0.f)); ga[e] = a; gx[e] = mult * gx[e] * xc[4 * q + e]; }
                  *(LAS f32x4*)(GA + et * 32 + ej + 4 * q) = ga; *(LAS f32x4*)(GX + et * 32 + ej + 4 * q) = gx; } }
            LDS_BARRIER();
            { int tq = tid; asm volatile("" : "+v"(tq));
              const int sg = tq >> 5, sc = tq & 31; float A = 1.0f, Bv = 0.f;
              { float av[8], uv[8];
#pragma unroll
                for (int i = 0; i < 8; ++i) { av[i] = GA[(8 * sg + i) * 32 + sc]; uv[i] = GX[(8 * sg + i) * 32 + sc]; }
#pragma unroll
                for (int i = 0; i < 8; ++i) { Bv = av[i] * Bv + uv[i]; A *= av[i]; } }
              SA[sg * 32 + sc] = A; SB[sg * 32 + sc] = Bv;
              LDS_BARRIER();
              if (tq < 32) {
                  float ga[16], gb[16]; float hc = HS[(tt & 1) * 32 + tq];
#pragma unroll
                  for (int gg = 0; gg < 16; ++gg) { ga[gg] = SA[gg * 32 + tq]; gb[gg] = SB[gg * 32 + tq]; }
#pragma unroll
                  for (int gg = 0; gg < 16; ++gg) { const float t = hc; hc = ga[gg] * hc + gb[gg]; ga[gg] = t; }
#pragma unroll
                  for (int gg = 0; gg < 16; ++gg) HIN[gg * 32 + tq] = ga[gg];
                  HS[((tt + 1) & 1) * 32 + tq] = hc; }
              LDS_BARRIER();
              float hin = HIN[sg * 32 + sc];
              { float av[8], uv[8];
#pragma unroll
                for (int i = 0; i < 8; ++i) { av[i] = GA[(8 * sg + i) * 32 + sc]; uv[i] = GX[(8 * sg + i) * 32 + sc]; }
#pragma unroll
                for (int i = 0; i < 8; ++i) { hin = av[i] * hin + uv[i]; av[i] = hin; }
#pragma unroll
                for (int i = 0; i < 8; ++i) HB[(8 * sg + i) * 32 + sc] = av[i]; }
            }
            LDS_BARRIER();
            { const float ry[8] = {bflo(ryraw.x), bfhi(ryraw.x), bflo(ryraw.y), bfhi(ryraw.y), bflo(ryraw.z), bfhi(ryraw.z), bflo(ryraw.w), bfhi(ryraw.w)};
              const f32x4 h0 = *(const LAS f32x4*)(HB + et * 32 + ej), h1 = *(const LAS f32x4*)(HB + et * 32 + ej + 4);
              u32x4 o; o.x = cvt_pk_bf16(h0.x * gelu_tanh(ry[0]), h0.y * gelu_tanh(ry[1])); o.y = cvt_pk_bf16(h0.z * gelu_tanh(ry[2]), h0.w * gelu_tanh(ry[3]));
              o.z = cvt_pk_bf16(h1.x * gelu_tanh(ry[4]), h1.y * gelu_tanh(ry[5])); o.w = cvt_pk_bf16(h1.z * gelu_tanh(ry[6]), h1.w * gelu_tanh(ry[7]));
              *(u32x4*)(O + (R0 + et) * DM + c0 + ej) = o; }
        }
        __syncthreads();
    }
}

#ifndef REP_P0
#define REP_P0 1
#endif
#ifndef REP_GEMM
#define REP_GEMM 1
#endif
#ifndef REP_MIX0
#define REP_MIX0 1
#endif
#ifndef REP_MIX1
#define REP_MIX1 1
#endif
#ifndef REP_RES
#define REP_RES 1
#endif
#ifndef REP_RMS
#define REP_RMS 1
#endif
#ifndef MK_N_LAUNCHES
#define MK_N_LAUNCHES 1
#endif
constexpr int N_PHASES = 16;
struct Args { Params p; int li, pad; };

__device__ __forceinline__ void attn_phase_fox(const Params& p, LAS unsigned char* lds, int wave, int lane) {
    const bf16_t* PROJ = (const bf16_t*)(p.ws + WS_PROJ);
    const AttnIO io{PROJ + PJ_FQ, PROJ + PJ_FK, PROJ + PJ_FV, AB_MAIN, (bf16_t*)(p.ws + WS_O) + 2048, DM};
    const float* CF = (const float*)(p.ws + WS_CF);
    for (int p0 = blockIdx.x; p0 < 256; p0 += gridDim.x) { const int pr = xcd_swz(p0, 256), b = pr >> 6, hd = (pr >> 2) & 15, x = pr & 3;
        fox_unit(io, CF, lds, b, hd, 7 - x, wave, lane);
        fox_unit(io, CF, lds, b, hd, x, wave, lane); }
}
__device__ __forceinline__ void attn_phase_sb(const Params& p, LAS unsigned char* lds, int wave, int lane) {
    const bf16_t* PROJ = (const bf16_t*)(p.ws + WS_PROJ);
    const AttnIO io{PROJ + PJ_SQ, PROJ + PJ_SK, PROJ + PJ_SV, CD_IN, (bf16_t*)(p.ws + WS_O) + 2048, DM};
    for (int p0 = blockIdx.x; p0 < 256; p0 += gridDim.x) { const int pr = xcd_swz(p0, 256), b = pr >> 6, hd = (pr >> 2) & 15, x = pr & 3;
        sb_unit(io, lds, b, hd, 7 - x, wave, lane);
        sb_unit(io, lds, b, hd, x, wave, lane); }
}

template <int layer>
__device__ __forceinline__ void layer_phases(const Params& p, LAS unsigned char* lds, const XcdBarrier& bar, int lo, int hi, int G, int gw, int ngw, int wave, int lane) {
    unsigned char* ws = p.ws;
    bf16_t* U = (bf16_t*)(ws + WS_U); bf16_t* PROJ = (bf16_t*)(ws + WS_PROJ); bf16_t* O = (bf16_t*)(ws + WS_O); bf16_t* ACT = (bf16_t*)(ws + WS_ACT); pg8::ssq_t* SSQ = (pg8::ssq_t*)((unsigned*)(ws + WS_CTL) + CW_SSQ);
#define IN(k) (lo <= (k) && (k) < hi)
#ifdef PROBE_SEL
#define SEAM(k) do { if ((k) + 1 < hi) { unsigned long long t0_ = 0; if (threadIdx.x == 0) { t0_ = __builtin_amdgcn_s_memrealtime(); if (blockIdx.x == 0) ((unsigned long long*)(p.ws + WS_CTL + 786432))[2 * (k) + 1] = t0_; } \
    xcd_barrier(bar); if (threadIdx.x == 0) { const unsigned long long t1_ = __builtin_amdgcn_s_memrealtime(); atomicAdd((unsigned*)(p.ws + WS_CTL + 790528) + (k), (unsigned)(t1_ - t0_)); if (blockIdx.x == 0) ((unsigned long long*)(p.ws + WS_CTL + 786432))[2 * (k) + 2] = t1_; } } } while (0)
#else
#define SEAM(k) do { if ((k) + 1 < hi) xcd_barrier(bar); } while (0)
#endif
        constexpr int kb = 1 + 7 * layer;
        if (IN(kb)) {
            if (layer == 0) {
                constexpr int NG = 192;
                pg8::Gemm g{U, (const bf16_t*)(ws + WS_WAB_IN), MTOK, AB_MAIN, DM}; pg8::EpiBf16<false> E{PROJ, AB_MAIN, nullptr};
                if (G == 256) {
                    if ((int)blockIdx.x < NG) { pg8::StaticOrder S; S.init(MTOK, AB_MAIN, NG, (int)blockIdx.x); pg8::gemm_phase<pg8::EpiBf16<false>, pg8::StaticOrder, true, true>(lds, g, S, E); }
                    else p0b_convert(p, lds, ((int)blockIdx.x - NG) * NWAVES + wave, (G - NG) * NWAVES, wave, lane);
                } else {
                    p0b_convert(p, lds, gw, ngw, wave, lane); __syncthreads();
                    pg8::StaticOrder S; S.init(MTOK, AB_MAIN, G, (int)blockIdx.x); pg8::gemm_phase<pg8::EpiBf16<false>, pg8::StaticOrder, true, true>(lds, g, S, E);
                }
                __syncthreads();
                phase_small32(p, lds, wave, lane);
            } else {
                pg8::Gemm g{U, (const bf16_t*)(ws + WS_WCD_IN), MTOK, CD_IN, DM}; pg8::StaticOrder S; S.init(MTOK, CD_IN, G, (int)blockIdx.x);
                pg8::EpiBf16<true> E{PROJ, CD_IN, SSQ + 1 * MTOK};
                for (int rep = 0; rep < REP_GEMM; ++rep) { pg8::gemm_phase<pg8::EpiBf16<true>, pg8::StaticOrder, true, true>(lds, g, S, E); __syncthreads(); }
            }
            SEAM(kb);
        }
        if (layer == 0 && IN(kb + 1)) { for (int rep = 0; rep < (REP_MIX0 == 5 ? 2 : 1); ++rep) { phase_fox_cumsum(p, lds, wave, lane); phase_gla_pre(p, lds, wave, lane); } SEAM(kb + 1); }
        if (IN(kb + 2)) {
            if (layer == 0) { phase_gla_seq(p, lds, wave, lane); __syncthreads();
#ifdef PROBE_SEL
                if (blockIdx.x == 0 && threadIdx.x == 0) ((unsigned long long*)(p.ws + WS_CTL + 786432))[41] = __builtin_amdgcn_s_memrealtime();
#endif
                attn_phase_fox(p, lds, wave, lane); __syncthreads();
#if REP_MIX0 == 3
 attn_phase_fox(p, lds, wave, lane); __syncthreads();
#endif
#if REP_MIX0 == 4
 phase_gla_seq(p, lds, wave, lane); __syncthreads();
#endif
 }
            else { phase_rg(p, lds, wave, lane); __syncthreads();
#ifdef PROBE_SEL
                if (blockIdx.x == 0 && threadIdx.x == 0) ((unsigned long long*)(p.ws + WS_CTL + 786432))[40] = __builtin_amdgcn_s_memrealtime();
#endif
                attn_phase_sb(p, lds, wave, lane); __syncthreads();
#if REP_MIX1 == 2
 phase_rg(p, lds, wave, lane); __syncthreads(); attn_phase_sb(p, lds, wave, lane); __syncthreads();
#endif
#if REP_MIX1 == 3
 phase_rg(p, lds, wave, lane); __syncthreads();
#endif
 }
            SEAM(kb + 2);
        }
        if (layer == 0 && IN(kb + 3)) { for (int rep = 0; rep < (REP_MIX0 == 6 ? 2 : 1); ++rep) phase_gla_post(p, gw, ngw, lane); SEAM(kb + 3); }
        if (IN(kb + 4)) {
            pg8::Gemm g{O, (const bf16_t*)(ws + (layer ? WS_WCD_OUT : WS_WAB_OUT)), MTOK, DM, DM}; pg8::StaticOrder S; S.init(MTOK, DM, G, (int)blockIdx.x);
#if REP_RES == 2
            { pg8::EpiRes<false> E{U, (bf16_t*)(ws + WS_ORAW), DM, (pg8::ssq_t*)(ws + WS_SSQ)}; pg8::gemm_phase<pg8::EpiRes<false>, pg8::StaticOrder, true, true>(lds, g, S, E); __syncthreads(); }
#endif
            if (layer == 0) { pg8::EpiRes<true> E{p.x, U, DM, SSQ + (2 * layer) * MTOK}; pg8::gemm_phase<pg8::EpiRes<true>, pg8::StaticOrder, true, true>(lds, g, S, E); }
            else { pg8::EpiRes<false> E{U, U, DM, SSQ + (2 * layer) * MTOK}; pg8::gemm_phase<pg8::EpiRes<false>, pg8::StaticOrder, true, true>(lds, g, S, E); }
            SEAM(kb + 4);
        }
        if (IN(kb + 5)) {
            pg8::Gemm g{U, (const bf16_t*)(ws + (layer ? WS_WGU1 : WS_WGU0)), MTOK, 2 * DFF, DM}; pg8::StaticOrder S; S.init(MTOK, 2 * DFF, G, (int)blockIdx.x);
            pg8::EpiSwiGLU E{ACT, DFF, SSQ + (2 * layer) * MTOK};
            for (int rep = 0; rep < REP_GEMM; ++rep) { pg8::gemm_phase<pg8::EpiSwiGLU, pg8::StaticOrder, true, true>(lds, g, S, E); __syncthreads(); }
            if (layer == 0) { const int rem = (MTOK / 256) * (2 * DFF / 256) % G, c = (int)blockIdx.x;
                if (rem == 0) tail_convert(p, lds, c * NWAVES + wave, G * NWAVES, wave, lane); else if (c >= rem) tail_convert(p, lds, (c - rem) * NWAVES + wave, (G - rem) * NWAVES, wave, lane); }
            else { const int rem = (MTOK / 256) * (2 * DFF / 256) % G, c = (int)blockIdx.x;
                if (rem == 0) tail1_convert(p, lds, c * NWAVES + wave, G * NWAVES, wave, lane); else if (c >= rem) tail1_convert(p, lds, (c - rem) * NWAVES + wave, (G - rem) * NWAVES, wave, lane); }
            SEAM(kb + 5);
        }
        if (IN(kb + 6)) {
            pg8::Gemm g{ACT, (const bf16_t*)(ws + (layer ? WS_WDN1 : WS_WDN0)), MTOK, DM, DFF}; pg8::StaticOrder S; S.init(MTOK, DM, G, (int)blockIdx.x);
#if REP_RES == 2
            { pg8::EpiRes<false> E{U, (bf16_t*)(ws + WS_ORAW), DM, (pg8::ssq_t*)(ws + WS_SSQ)}; pg8::gemm_phase<pg8::EpiRes<false>, pg8::StaticOrder, true, true>(lds, g, S, E); __syncthreads(); }
#endif
            pg8::EpiRes<false> E{U, U, DM, SSQ + (2 * layer + 1) * MTOK};
            pg8::gemm_phase<pg8::EpiRes<false>, pg8::StaticOrder, true, true>(lds, g, S, E);
            SEAM(kb + 6);
        }
#undef IN
#undef SEAM
}

__global__ void __launch_bounds__(NTHR, 2) hybrid_fwd(Args args) {
    extern __shared__ __attribute__((aligned(16))) unsigned char lds_raw[];
    LAS unsigned char* lds = (LAS unsigned char*)lds_raw;
    const Params& p = args.p;
    const int tid = threadIdx.x, lane = tid & 63, wave = __builtin_amdgcn_readfirstlane(tid >> 6);
    const int G = gridDim.x, gw = blockIdx.x * NWAVES + wave, ngw = G * NWAVES;
    for (int u = tid; u < (LDS_BYTES - LDSCTL_OFF) / 4; u += NTHR) ((LAS unsigned*)(lds + LDSCTL_OFF))[u] = 0u;
    __syncthreads();
    unsigned* ctl = (unsigned*)(p.ws + WS_CTL);
    XcdBarrier bar = xcd_barrier_post(ctl + CW_BAR + args.li * XCD_BAR_WORDS, (volatile LAS unsigned*)(lds + MISC_OFF) + 8);
    const int lo = p.ph_lo, hi = p.ph_hi;
#define IN(k) (lo <= (k) && (k) < hi)
#ifdef PROBE_SEL
#define SEAM(k) do { if ((k) + 1 < hi) { unsigned long long t0_ = 0; if (threadIdx.x == 0) { t0_ = __builtin_amdgcn_s_memrealtime(); if (blockIdx.x == 0) ((unsigned long long*)(p.ws + WS_CTL + 786432))[2 * (k) + 1] = t0_; } \
    xcd_barrier(bar); if (threadIdx.x == 0) { const unsigned long long t1_ = __builtin_amdgcn_s_memrealtime(); atomicAdd((unsigned*)(p.ws + WS_CTL + 790528) + (k), (unsigned)(t1_ - t0_)); if (blockIdx.x == 0) ((unsigned long long*)(p.ws + WS_CTL + 786432))[2 * (k) + 2] = t1_; } } } while (0)
#else
#define SEAM(k) do { if ((k) + 1 < hi) xcd_barrier(bar); } while (0)
#endif
    if (IN(0)) { for (int rep = 0; rep < REP_P0; ++rep) { phase_p0(p, lds, gw, ngw, wave, lane); __syncthreads(); } SEAM(0); }

    layer_phases<0>(p, lds, bar, lo, hi, G, gw, ngw, wave, lane);
    layer_phases<1>(p, lds, bar, lo, hi, G, gw, ngw, wave, lane);
#ifdef PROBE_SEL
    float probe_eps = 0.f;
    if (IN(15)) { const unsigned long long* ts = (const unsigned long long*)(p.ws + WS_CTL + 786432); const unsigned* wsum = (const unsigned*)(p.ws + WS_CTL + 790528); float val_us;
        if (PROBE_SEL < 100) val_us = (float)wsum[PROBE_SEL] * (0.01f / 256.0f);
        else if (PROBE_SEL == 100) { unsigned s = 0; for (int i = 0; i < 15; ++i) s += wsum[i]; val_us = (float)s * (0.01f / 256.0f); }
        else if (PROBE_SEL == 101) { const unsigned s = wsum[1] + wsum[5] + wsum[6] + wsum[7] + wsum[8] + wsum[12] + wsum[13] + wsum[14]; val_us = (float)s * (0.01f / 256.0f); }
        else if (PROBE_SEL == 400) val_us = (float)(ts[40] - ts[18]) * 0.01f;
        else if (PROBE_SEL == 401) val_us = (float)(ts[41] - ts[6]) * 0.01f;
        else if (PROBE_SEL >= 300) val_us = (float)(ts[2 * (PROBE_SEL - 300) + 2] - ts[2 * (PROBE_SEL - 300) + 1]) * 0.01f;
        else { unsigned long long st = ts[2 * (PROBE_SEL - 200)]; if (st == 0ull) st = ts[2 * (PROBE_SEL - 200) - 2]; val_us = (float)(ts[2 * (PROBE_SEL - 200) + 1] - st) * 0.01f; }
        probe_eps = sqrtf(val_us * PROBE_SCALE); }
#define FINAL_SCALE (1.0f + probe_eps)
#else
#define FINAL_SCALE 1.0f
#endif
    if (IN(15)) phase_final_norm((const bf16_t*)(p.ws + WS_U), (const unsigned long long*)((const unsigned*)(p.ws + WS_CTL) + CW_SSQ) + 3 * MTOK, p.final_norm, p.out, gw, ngw, lane, FINAL_SCALE);
#undef IN
#undef SEAM
}

extern "C" void kernel_launch(void* const* d_in, const int* in_sizes, int n_in, void* d_out, int out_size, void* d_ws, size_t ws_size, hipStream_t stream) {
    static int grid = 0;
    if (grid == 0) {
        if (n_in != 22 || in_sizes[0] != MTOK * DM || out_size != MTOK * DM || ws_size < WS_END) {
            fprintf(stderr, "kernel_launch: unexpected problem (n_in %d, in0 %d, out %d, ws %zu, need %zu); nothing launched\n", n_in, n_in > 0 ? in_sizes[0] : -1, out_size, ws_size, (size_t)WS_END); grid = -1; return; }
        int dev = 0, cus = 0, per_cu = 0;
        if (hipGetDevice(&dev) != hipSuccess || hipDeviceGetAttribute(&cus, hipDeviceAttributeMultiprocessorCount, dev) != hipSuccess) { fprintf(stderr, "kernel_launch: device query failed\n"); grid = -1; return; }
        if (hipFuncSetAttribute((const void*)hybrid_fwd, hipFuncAttributeMaxDynamicSharedMemorySize, LDS_BYTES) != hipSuccess) { fprintf(stderr, "kernel_launch: hipFuncSetAttribute failed\n"); grid = -1; return; }
        if (hipOccupancyMaxActiveBlocksPerMultiprocessor(&per_cu, (const void*)hybrid_fwd, NTHR, LDS_BYTES) != hipSuccess || per_cu < 1) {
            fprintf(stderr, "kernel_launch: occupancy query reports %d workgroups per CU; nothing launched\n", per_cu); (void)hipGetLastError(); grid = -1; return; }
        grid = cus;
    }
    if (grid < 0) return;
    if (hipMemsetAsync((char*)d_ws + WS_CTL, 0, CTL_ZERO_BYTES, stream) != hipSuccess) { fprintf(stderr, "kernel_launch: memset failed\n"); return; }
    Args a{};
    const float** pp = (const float**)&a.p;
    for (int i = 0; i < 22; ++i) pp[i] = (const float*)d_in[i];
    a.p.out = (float*)d_out; a.p.ws = (unsigned char*)d_ws;
#if MK_N_LAUNCHES == 1
    a.p.ph_lo = 0; a.p.ph_hi = N_PHASES; a.li = 0; a.pad = 0;
    hipLaunchKernelGGL(hybrid_fwd, dim3(grid), dim3(NTHR), LDS_BYTES, stream, a);
    { const hipError_t le = hipPeekAtLastError(); if (le != hipSuccess) fprintf(stderr, "kernel_launch: launch failed: %s\n", hipGetErrorName(le)); }
#else
    for (int k = 0; k < N_PHASES; ++k) { a.p.ph_lo = k; a.p.ph_hi = k + 1; a.li = k; a.pad = 0;
        hipLaunchKernelGGL(hybrid_fwd, dim3(grid), dim3(NTHR), LDS_BYTES, stream, a);
        const hipError_t le = hipPeekAtLastError(); if (le != hipSuccess) { fprintf(stderr, "kernel_launch: launch %d failed: %s\n", k, hipGetErrorName(le)); break; } }
#endif
}
```

```cpp
#include <hip/hip_runtime.h>
#include <cstdio>
#include <cstdint>

#define LAS __attribute__((address_space(3)))
#define GAS __attribute__((address_space(1)))
typedef unsigned short bf16_t;
typedef short bf16x8 __attribute__((ext_vector_type(8)));
typedef short s16x4 __attribute__((ext_vector_type(4)));
typedef float f32x4 __attribute__((ext_vector_type(4)));
typedef float f32x2 __attribute__((ext_vector_type(2)));
typedef float f32x16 __attribute__((ext_vector_type(16)));
typedef unsigned u32x4 __attribute__((ext_vector_type(4)));
typedef unsigned u32x2 __attribute__((ext_vector_type(2)));

constexpr int DM = 4096, NB = 4, SEQ = 2048, MTOK = NB * SEQ;
constexpr int DFF = 11008;
constexpr int AB_MAIN = 12288;
constexpr int AB_IN = 12320, CD_IN = 10240;
constexpr int PJ_GQ = 0, PJ_GK = 1024, PJ_GV = 2048, PJ_GG = 4096, PJ_FQ = 6144, PJ_FK = 8192, PJ_FV = 10240;
constexpr int PJ_RY = 0, PJ_RX = 2048, PJ_SQ = 4096, PJ_SK = 6144, PJ_SV = 8192;
constexpr float EPS = 1e-6f, LOG2E_F = 1.4426950408889634f;

__device__ __forceinline__ unsigned cvt_pk_bf16(float lo, float hi) { unsigned r; asm volatile("v_cvt_pk_bf16_f32 %0, %1, %2" : "=v"(r) : "v"(lo), "v"(hi)); return r; }
__device__ __forceinline__ float bf2f(bf16_t v) { return __uint_as_float(((unsigned)v) << 16); }
__device__ __forceinline__ float bflo(unsigned w) { return __uint_as_float(w << 16); }
__device__ __forceinline__ float bfhi(unsigned w) { return __uint_as_float(w & 0xffff0000u); }
__device__ __forceinline__ bf16_t f2bf(float f) { return (bf16_t)(cvt_pk_bf16(f, 0.f) & 0xffffu); }
__device__ __forceinline__ int crow(int r, int hi) { return (r & 3) + 8 * (r >> 2) + 4 * hi; }
__device__ __forceinline__ bf16x8 pack8(float a0, float a1, float a2, float a3, float a4, float a5, float a6, float a7) {
    u32x4 w = {cvt_pk_bf16(a0, a1), cvt_pk_bf16(a2, a3), cvt_pk_bf16(a4, a5), cvt_pk_bf16(a6, a7)}; return __builtin_bit_cast(bf16x8, w); }
__device__ __forceinline__ float wave_sum(float v) {
#pragma unroll
    for (int o = 1; o < 64; o <<= 1) v += __shfl_xor(v, o);
    return v; }
__device__ __forceinline__ float log_sigmoid_acc(float x) { return fminf(x, 0.f) - log1pf(expf(-fabsf(x))); }
__device__ __forceinline__ float log_sigmoid_fast(float x) { return fminf(x, 0.f) - __logf(1.0f + __expf(-fabsf(x))); }
#define LDS_WAIT() asm volatile("s_waitcnt lgkmcnt(0)" ::: "memory")
#define VM_WAIT() asm volatile("s_waitcnt vmcnt(0)" ::: "memory")
#define LDS_BARRIER() do { asm volatile("s_waitcnt lgkmcnt(0)" ::: "memory"); __builtin_amdgcn_s_barrier(); asm volatile("" ::: "memory"); } while (0)
#define MFMA32(a, b, c) __builtin_amdgcn_mfma_f32_32x32x16_bf16((a), (b), (c), 0, 0, 0)
__device__ __forceinline__ int xcd_swz(int i, int n) { return (n % 8 == 0) ? (i & 7) * (n / 8) + (i >> 3) : i; }
typedef LAS const char* lds_cptr;
__device__ __forceinline__ s16x4 vtr(lds_cptr p) { return __builtin_bit_cast(s16x4, __builtin_amdgcn_ds_read_tr16_b64_v4i16((LAS s16x4*)p)); }
__device__ __forceinline__ bf16x8 cat4(s16x4 lo, s16x4 hi) { bf16x8 r; r[0] = lo[0]; r[1] = lo[1]; r[2] = lo[2]; r[3] = lo[3]; r[4] = hi[0]; r[5] = hi[1]; r[6] = hi[2]; r[7] = hi[3]; return r; }

namespace pg8 {
#define PG8_LAS __attribute__((address_space(3)))
typedef unsigned short bf16_t;
typedef short bf16x8 __attribute__((ext_vector_type(8)));
typedef float f32x4 __attribute__((ext_vector_type(4)));
typedef unsigned u32x4 __attribute__((ext_vector_type(4)));
constexpr int BM = 256, BK = 64, HALF = 128, HTB = HALF * BK * 2  , STAGE_BYTES = 8 * HTB, NXCD = 8, WGM = 8;

__host__ __device__ __forceinline__ int lds_byte(int r, int c) { const int st = (r >> 4) * 2 + (c >> 5), rr = r & 15, cc = c & 31, ob = rr * 64 + cc * 2; return st * 1024 + (ob ^ (((ob >> 9) & 1) << 5)); }
__host__ __device__ __forceinline__ void stage_rc(int b, int& R, int& C) { const int st = b / 1024, sb = b % 1024, swz = sb ^ (((sb >> 9) & 1) << 5); R = (st >> 1) * 16 + swz / 64; C = (st & 1) * 32 + (swz % 64) / 2; }
__host__ __device__ __forceinline__ int perm32(int rho) { const int n = rho >> 4, i = rho & 15; return 8 * (i >> 2) + 4 * n + (i & 3); }

struct Unit { int pm, pn; };
struct Gemm { const bf16_t* A; const bf16_t* Bt; int M, N, K; };

struct StaticOrder {
    int nM, nN, nwg, G, c;
    __host__ __device__ void init(int M, int N, int G_, int c_) { nM = M / BM; nN = N / BM; nwg = nM * nN; G = G_; c = c_; }
    __host__ __device__ bool next(int i, Unit& u) const {
        const long L = (long)i * G + c; if (L >= nwg) return false;
        int wgid = (int)L; { const int q = nwg / NXCD, r = nwg % NXCD, xcd = wgid % NXCD, off = wgid / NXCD; wgid = (xcd < r ? xcd * (q + 1) : r * (q + 1) + (xcd - r) * q) + off; }
        const int nig = WGM * nN, gid = wgid / nig, fm = gid * WGM, gsz = (nM - fm) < WGM ? (nM - fm) : WGM;
        u.pm = fm + ((wgid % nig) % gsz); u.pn = (wgid % nig) / gsz; return true;
    }
    __device__ __forceinline__ void a_ready(const Unit&) const {}
    __device__ __forceinline__ void done(const Unit&) const {}
};
__device__ __forceinline__ unsigned cvt_pk_bf16(float lo, float hi) { unsigned r; asm volatile("v_cvt_pk_bf16_f32 %0, %1, %2" : "=v"(r) : "v"(lo), "v"(hi)); return r; }
constexpr float RMS_EPS = 1e-6f, RMS_INV_D = 1.0f / 4096.0f, SSQ_FIX = 16777216.0f, SSQ_UNFIX = 1.0f / 16777216.0f;
typedef unsigned long long ssq_t;
__device__ __forceinline__ float ssq_rstd(const ssq_t* ssq, int row) { return __builtin_amdgcn_rsqf((float)ssq[row] * (SSQ_UNFIX * RMS_INV_D) + RMS_EPS); }

template <bool SCALE> struct EpiBf16 {
    static constexpr bool PERM = true, AFTER_DRAIN = false;
    bf16_t* O; int ldc; const ssq_t* ssq;
    __device__ __forceinline__ void operator()(const f32x4 (&acc)[2][2][4][2], const Unit& u, int wr, int wc, int fr, int fq) const {
        const int row0 = u.pm * BM + wr * 64 + fr, col0 = u.pn * BM + wc * 32 + 8 * fq;
        float rs[2][4];
#pragma unroll
        for (int ai = 0; ai < 2; ++ai)
#pragma unroll
            for (int m = 0; m < 4; ++m) rs[ai][m] = SCALE ? ssq_rstd(ssq, row0 + ai * HALF + m * 16) : 1.0f;
#pragma unroll
        for (int ai = 0; ai < 2; ++ai)
#pragma unroll
            for (int m = 0; m < 4; ++m) { const int row = row0 + ai * HALF + m * 16; bf16_t* rowp = O + (size_t)row * ldc + col0;
#pragma unroll
                for (int bj = 0; bj < 2; ++bj) { const f32x4 v0 = acc[ai][bj][m][0] * rs[ai][m], v1 = acc[ai][bj][m][1] * rs[ai][m];
                    u32x4 w; w.x = cvt_pk_bf16(v0[0], v0[1]); w.y = cvt_pk_bf16(v0[2], v0[3]); w.z = cvt_pk_bf16(v1[0], v1[1]); w.w = cvt_pk_bf16(v1[2], v1[3]);
                    *(u32x4*)(rowp + bj * HALF) = w; } }
    }
};
template <bool BASE_F32> struct EpiRes {
    static constexpr bool PERM = true, AFTER_DRAIN = false;
    const void* base; bf16_t* out; int ldc; ssq_t* ssq;
    __device__ __forceinline__ void operator()(const f32x4 (&acc)[2][2][4][2], const Unit& u, int wr, int wc, int fr, int fq) const {
        const int row0 = u.pm * BM + wr * 64 + fr, col0 = u.pn * BM + wc * 32 + 8 * fq;
#pragma unroll
        for (int ai = 0; ai < 2; ++ai) {
            f32x4 b0[4][2], b1[4][2];
#pragma unroll
            for (int m = 0; m < 4; ++m)
#pragma unroll
                for (int bj = 0; bj < 2; ++bj) { const size_t off = (size_t)(row0 + ai * HALF + m * 16) * ldc + col0 + bj * HALF;
                    if (BASE_F32) { const float* bp = (const float*)base + off; b0[m][bj] = *(const f32x4*)bp; b1[m][bj] = *(const f32x4*)(bp + 4); }
                    else { const u32x4 r = *(const u32x4*)((const bf16_t*)base + off);
                        b0[m][bj] = (f32x4){__uint_as_float(r.x << 16), __uint_as_float(r.x & 0xffff0000u), __uint_as_float(r.y << 16), __uint_as_float(r.y & 0xffff0000u)};
                        b1[m][bj] = (f32x4){__uint_as_float(r.z << 16), __uint_as_float(r.z & 0xffff0000u), __uint_as_float(r.w << 16), __uint_as_float(r.w & 0xffff0000u)}; } }
#pragma unroll
            for (int m = 0; m < 4; ++m) { const int row = row0 + ai * HALF + m * 16; const size_t off = (size_t)row * ldc + col0; float q = 0.f;
#pragma unroll
                for (int bj = 0; bj < 2; ++bj) { const f32x4 v0 = acc[ai][bj][m][0] + b0[m][bj], v1 = acc[ai][bj][m][1] + b1[m][bj];
                    q += ((v0[0] * v0[0] + v0[1] * v0[1]) + (v0[2] * v0[2] + v0[3] * v0[3])) + ((v1[0] * v1[0] + v1[1] * v1[1]) + (v1[2] * v1[2] + v1[3] * v1[3]));
                    u32x4 w; w.x = cvt_pk_bf16(v0[0], v0[1]); w.y = cvt_pk_bf16(v0[2], v0[3]); w.z = cvt_pk_bf16(v1[0], v1[1]); w.w = cvt_pk_bf16(v1[2], v1[3]);
                    *(u32x4*)(out + off + bj * HALF) = w; }
                q += __shfl_xor(q, 16); q += __shfl_xor(q, 32);
                if (fq == 0) atomicAdd(ssq + row, (ssq_t)(q * SSQ_FIX + 0.5f)); }
        }
    }
};
struct EpiSwiGLU {
    static constexpr bool PERM = true, AFTER_DRAIN = false;
    bf16_t* O; int ldc; const ssq_t* ssq;
    __device__ __forceinline__ void operator()(const f32x4 (&acc)[2][2][4][2], const Unit& u, int wr, int wc, int fr, int fq) const {
        const int row0 = u.pm * BM + wr * 64 + fr, col0 = u.pn * HALF + wc * 32 + 8 * fq;
        float rs[2][4];
#pragma unroll
        for (int ai = 0; ai < 2; ++ai)
#pragma unroll
            for (int m = 0; m < 4; ++m) rs[ai][m] = ssq_rstd(ssq, row0 + ai * HALF + m * 16);
#pragma unroll
        for (int ai = 0; ai < 2; ++ai)
#pragma unroll
            for (int m = 0; m < 4; ++m) { const int row = row0 + ai * HALF + m * 16; bf16_t* rowp = O + (size_t)row * ldc + col0; float a[8];
#pragma unroll
                for (int n = 0; n < 2; ++n)
#pragma unroll
                    for (int i = 0; i < 4; i += 2) {
                        const f32x2 r2 = {rs[ai][m], rs[ai][m]};
                        const f32x2 g = (f32x2){acc[ai][0][m][n][i], acc[ai][0][m][n][i + 1]} * r2, up = (f32x2){acc[ai][1][m][n][i], acc[ai][1][m][n][i + 1]} * r2;
                        const f32x2 t = g * (f32x2){-1.4426950408889634f, -1.4426950408889634f};
                        const f32x2 d = (f32x2){__builtin_amdgcn_exp2f(t.x), __builtin_amdgcn_exp2f(t.y)} + (f32x2){1.0f, 1.0f};
                        const f32x2 o2 = (g * up) * (f32x2){__builtin_amdgcn_rcpf(d.x), __builtin_amdgcn_rcpf(d.y)};
                        a[4 * n + i] = o2.x; a[4 * n + i + 1] = o2.y; }
                u32x4 w; w.x = cvt_pk_bf16(a[0], a[1]); w.y = cvt_pk_bf16(a[2], a[3]); w.z = cvt_pk_bf16(a[4], a[5]); w.w = cvt_pk_bf16(a[6], a[7]);
                *(u32x4*)rowp = w; }
    }
};

template <class Epi, class Sched, bool ALIGN_EPI = false, bool SP2 = false>
__device__ __forceinline__ void gemm_phase(PG8_LAS unsigned char* lds, const Gemm g, const Sched& S, const Epi& E) {
    const int tid = threadIdx.x, wid = __builtin_amdgcn_readfirstlane(tid >> 6), lane = tid & 63, wr = wid >> 2, wc = wid & 3, fr = lane & 15, fq = lane >> 4;
    const int K = g.K, nt = K / BK;
    unsigned voffA[2], voffB[2];
#pragma unroll
    for (int i = 0; i < 2; ++i) { int R, C; stage_rc(tid * 16 + i * 8192, R, C); const int Rb = Epi::PERM ? ((R & ~31) + perm32(R & 31)) : R;
        voffA[i] = (unsigned)(R * K + C) * 2u; voffB[i] = (unsigned)(Rb * K + C) * 2u; }
    const size_t kstep = (size_t)(BK * 2);
    const size_t hstep = (size_t)HALF * K * 2;
    const size_t tstep = 2 * hstep;
    const unsigned ldsw = (unsigned)wid * 1024u;
    const int aoff = lds_byte(wr * 64 + fr, fq * 8), boff = lds_byte(wc * 32 + fr, fq * 8);
#define PG8_SA(b, h) (((b) * 2 + (h)) * HTB)
#define PG8_SB(b, h) ((4 + (b) * 2 + (h)) * HTB)
#define PG8_STAGE(bufoff, gbase, voff) do { _Pragma("unroll") for (int _i = 0; _i < 2; ++_i) \
        __builtin_amdgcn_global_load_lds((const unsigned*)((const char*)(gbase) + (voff)[_i]), (PG8_LAS unsigned*)(lds + (bufoff) + ldsw + _i * 8192), 16, 0, 0); } while (0)
#define PG8_LDA(dst, b, h) do { _Pragma("unroll") for (int m = 0; m < 4; ++m) _Pragma("unroll") for (int k = 0; k < 2; ++k) dst[m][k] = *(const PG8_LAS bf16x8*)(lds + PG8_SA(b, h) + aoff + m * 2048 + k * 1024); } while (0)
#define PG8_LDB(dst, b, h) do { _Pragma("unroll") for (int n = 0; n < 2; ++n) _Pragma("unroll") for (int k = 0; k < 2; ++k) dst[n][k] = *(const PG8_LAS bf16x8*)(lds + PG8_SB(b, h) + boff + n * 2048 + k * 1024); } while (0)
#define PG8_MMA(ai, bj, At, Bt) do { __builtin_amdgcn_s_setprio(1); _Pragma("unroll") for (int m = 0; m < 4; ++m) _Pragma("unroll") for (int n = 0; n < 2; ++n) _Pragma("unroll") for (int k = 0; k < 2; ++k) \
        acc[ai][bj][m][n] = __builtin_amdgcn_mfma_f32_16x16x32_bf16(Bt[n][k], At[m][k], acc[ai][bj][m][n], 0, 0, 0); __builtin_amdgcn_s_setprio(0); } while (0)
#define PG8_WAIT_V(n) asm volatile("s_waitcnt vmcnt(" #n ")" ::: "memory")
#define PG8_WAIT_L(n) asm volatile("s_waitcnt lgkmcnt(" #n ")" ::: "memory")
#define PG8_BAR __builtin_amdgcn_s_barrier()
#define PG8_SCHED __builtin_amdgcn_sched_barrier(0)
    Unit cur, nxt; int ui = 0;
    if (!S.next(0, cur)) return;
    f32x4 acc[2][2][4][2];
#pragma unroll
    for (int a = 0; a < 2; ++a)
#pragma unroll
        for (int b = 0; b < 2; ++b)
#pragma unroll
            for (int m = 0; m < 4; ++m)
#pragma unroll
                for (int n = 0; n < 2; ++n) acc[a][b][m][n] = (f32x4){0.f, 0.f, 0.f, 0.f};
    bf16x8 At[4][2], B0[2][2], B1[2][2];
    const char* cA = (const char*)g.A + (size_t)cur.pm * tstep; const char* cB = (const char*)g.Bt + (size_t)cur.pn * tstep;
    S.a_ready(cur);
    if constexpr (SP2) {
        PG8_STAGE(PG8_SB(0, 0), cB, voffB); PG8_STAGE(PG8_SB(0, 1), cB + hstep, voffB); PG8_STAGE(PG8_SA(0, 0), cA, voffA); PG8_STAGE(PG8_SA(0, 1), cA + hstep, voffA);
        if (wr == 1) PG8_BAR;
        PG8_WAIT_V(2); PG8_BAR;
        PG8_STAGE(PG8_SB(1, 0), cB + kstep, voffB); PG8_STAGE(PG8_SA(1, 0), cA + kstep, voffA); PG8_STAGE(PG8_SB(1, 1), cB + hstep + kstep, voffB);
        PG8_WAIT_V(6); PG8_BAR;
    } else {
        PG8_STAGE(PG8_SB(0, 0), cB, voffB); PG8_STAGE(PG8_SA(0, 0), cA, voffA); PG8_STAGE(PG8_SB(0, 1), cB + hstep, voffB); PG8_STAGE(PG8_SA(0, 1), cA + hstep, voffA);
        if (wr == 1) PG8_BAR;
        PG8_WAIT_V(4); PG8_BAR;
        PG8_STAGE(PG8_SB(1, 0), cB + kstep, voffB); PG8_STAGE(PG8_SA(1, 0), cA + kstep, voffA); PG8_STAGE(PG8_SB(1, 1), cB + hstep + kstep, voffB);
        PG8_WAIT_V(6); PG8_BAR;
    }
    for (;;) {
        const bool has_next = S.next(ui + 1, nxt);
        const char* nA = has_next ? (const char*)g.A + (size_t)nxt.pm * tstep : cA; const char* nB = has_next ? (const char*)g.Bt + (size_t)nxt.pn * tstep : cB;
        for (int t = 0; t < nt; t += 2) {
            const bool last = (t == nt - 2);
            const char* a1 = cA + (size_t)(t + 1) * kstep;
            const char* a2 = last ? nA : cA + (size_t)(t + 2) * kstep; const char* b2 = last ? nB : cB + (size_t)(t + 2) * kstep;
            const char* a3 = a2 + kstep; const char* b3 = b2 + kstep;
            if (last && has_next) S.a_ready(nxt);
            if constexpr (SP2) {
            PG8_LDB(B0, 0, 0); PG8_LDB(B1, 0, 1); PG8_SCHED; PG8_LDA(At, 0, 0); PG8_STAGE(PG8_SA(1, 1), a1 + hstep, voffA);
            PG8_WAIT_V(8); PG8_WAIT_L(0); PG8_BAR; PG8_MMA(0, 0, At, B0); PG8_MMA(0, 1, At, B1); PG8_BAR; PG8_SCHED;
            PG8_LDA(At, 0, 1); PG8_STAGE(PG8_SB(0, 0), b2, voffB); PG8_STAGE(PG8_SB(0, 1), b2 + hstep, voffB); PG8_STAGE(PG8_SA(0, 0), a2, voffA);
            PG8_WAIT_V(8); PG8_WAIT_L(0); PG8_BAR; PG8_MMA(1, 0, At, B0); PG8_MMA(1, 1, At, B1); PG8_BAR; PG8_SCHED;
            PG8_LDB(B0, 1, 0); PG8_LDB(B1, 1, 1); PG8_SCHED; PG8_LDA(At, 1, 0); PG8_STAGE(PG8_SA(0, 1), a2 + hstep, voffA);
            PG8_WAIT_V(8); PG8_WAIT_L(0); PG8_BAR; PG8_MMA(0, 0, At, B0); PG8_MMA(0, 1, At, B1); PG8_BAR; PG8_SCHED;
            PG8_LDA(At, 1, 1); PG8_STAGE(PG8_SB(1, 0), b3, voffB); PG8_STAGE(PG8_SB(1, 1), b3 + hstep, voffB); PG8_STAGE(PG8_SA(1, 0), a3, voffA);
            PG8_WAIT_V(8); PG8_WAIT_L(0); PG8_BAR; PG8_MMA(1, 0, At, B0); PG8_MMA(1, 1, At, B1); PG8_BAR; PG8_SCHED;
            } else {
            PG8_LDB(B0, 0, 0); PG8_SCHED; PG8_LDA(At, 0, 0); PG8_STAGE(PG8_SA(1, 1), a1 + hstep, voffA);
            PG8_WAIT_L(8); PG8_BAR; PG8_WAIT_L(0); PG8_MMA(0, 0, At, B0); PG8_BAR; PG8_SCHED;
            PG8_LDB(B1, 0, 1); PG8_STAGE(PG8_SB(0, 0), b2, voffB);
            PG8_BAR; PG8_WAIT_L(0); PG8_MMA(0, 1, At, B1); PG8_BAR;
            PG8_LDA(At, 0, 1); PG8_STAGE(PG8_SA(0, 0), a2, voffA);
            PG8_BAR; PG8_WAIT_L(0); PG8_MMA(1, 0, At, B0); PG8_BAR; PG8_SCHED;
            PG8_STAGE(PG8_SB(0, 1), b2 + hstep, voffB);
            PG8_WAIT_V(6); PG8_BAR; PG8_MMA(1, 1, At, B1); PG8_BAR;
            PG8_LDB(B0, 1, 0); PG8_SCHED; PG8_LDA(At, 1, 0); PG8_STAGE(PG8_SA(0, 1), a2 + hstep, voffA);
            PG8_WAIT_L(8); PG8_BAR; PG8_WAIT_L(0); PG8_MMA(0, 0, At, B0); PG8_BAR; PG8_SCHED;
            PG8_LDB(B1, 1, 1); PG8_STAGE(PG8_SB(1, 0), b3, voffB);
            PG8_BAR; PG8_WAIT_L(0); PG8_MMA(0, 1, At, B1); PG8_BAR;
            PG8_LDA(At, 1, 1); PG8_STAGE(PG8_SA(1, 0), a3, voffA);
            PG8_BAR; PG8_WAIT_L(0); PG8_MMA(1, 0, At, B0); PG8_BAR; PG8_SCHED;
            PG8_STAGE(PG8_SB(1, 1), b3 + hstep, voffB);
            PG8_WAIT_V(6); PG8_BAR; PG8_MMA(1, 1, At, B1); PG8_BAR;
            }
        }
        if constexpr (ALIGN_EPI) { if (wr == 0) PG8_BAR; }
        if constexpr (!Epi::AFTER_DRAIN) { E(acc, cur, wr, wc, fr, fq); S.done(cur); }
        if (!has_next) break;
#pragma unroll
        for (int a = 0; a < 2; ++a)
#pragma unroll
            for (int b = 0; b < 2; ++b)
#pragma unroll
                for (int m = 0; m < 4; ++m)
#pragma unroll
                    for (int n = 0; n < 2; ++n) acc[a][b][m][n] = (f32x4){0.f, 0.f, 0.f, 0.f};
        cur = nxt; cA = nA; cB = nB; ++ui;
        if constexpr (ALIGN_EPI) { if (wr == 1) PG8_BAR; }
    }
    PG8_WAIT_V(0);
    if constexpr (!ALIGN_EPI) { if (wr == 0) PG8_BAR; }
    PG8_BAR;
    if constexpr (Epi::AFTER_DRAIN) { E.fused(acc, cur, wr, wc, fr, fq, lds, wid, lane); S.done(cur); }
#undef PG8_SA
#undef PG8_SB
#undef PG8_STAGE
#undef PG8_LDA
#undef PG8_LDB
#undef PG8_MMA
#undef PG8_WAIT_V
#undef PG8_WAIT_L
#undef PG8_BAR
#undef PG8_SCHED
}
}
#define XB_TMO      128
#define XB_XCNT(j)  (256  + 64 * (j))
#define XB_XSUB(j)  (1280 + 64 * (j))
#define XB_XGEN(j)  (2304 + 64 * (j))
#define XB_TOP      3328
#define XB_TOPGEN   3392
#define XCD_BAR_WORDS 3456
#define XB_SPIN_CAP (1u << 18)

__device__ __forceinline__ unsigned xb_ld(unsigned* p)              { return __hip_atomic_load(p, __ATOMIC_RELAXED, __HIP_MEMORY_SCOPE_AGENT); }
__device__ __forceinline__ unsigned xb_add(unsigned* p, unsigned v) { return __hip_atomic_fetch_add(p, v, __ATOMIC_RELAXED, __HIP_MEMORY_SCOPE_AGENT); }
__device__ __forceinline__ unsigned xb_xcc_id() { return (unsigned)__builtin_amdgcn_s_getreg((3 << 11) | 20) & 0xFu; }
#define XB_SPIN(cond, bar) do { unsigned _sp = 0; while (cond) { __builtin_amdgcn_s_sleep(1); \
    if ((++_sp & 255u) == 0u) { if (xb_ld(&(bar)[XB_TMO])) break; if (_sp > XB_SPIN_CAP) { atomicAdd(&(bar)[XB_TMO], 1u); break; } } } } while (0)

struct XcdBarrier {
    unsigned* bar; unsigned x;
    volatile LAS unsigned* st;
};

__device__ __forceinline__ XcdBarrier xcd_barrier_post(unsigned* bar, volatile LAS unsigned* st) {
    XcdBarrier b; b.bar = bar; b.x = xb_xcc_id(); b.st = st;
    if (threadIdx.x == 0) (void)xb_add(&bar[XB_XCNT(b.x)], 1u);
    return b;
}
__device__ __forceinline__ void xcd_barrier_complete(unsigned* bar, unsigned x, unsigned& nloc, unsigned& nx) {
    const unsigned G = gridDim.x * gridDim.y * gridDim.z;
    unsigned sum, cnt, mine, sp = 0u;
    for (;;) {
        sum = 0u; cnt = 0u; mine = 0u;
#pragma unroll
        for (unsigned j = 0; j < 16; ++j) { const unsigned c = xb_ld(&bar[XB_XCNT(j)]); sum += c; cnt += (c > 0u) ? 1u : 0u; mine = (j == x) ? c : mine; }
        if (sum == G) break;
        __builtin_amdgcn_s_sleep(1);
        if ((++sp & 255u) == 0u) { if (xb_ld(&bar[XB_TMO])) break; if (sp > XB_SPIN_CAP) { atomicAdd(&bar[XB_TMO], 1u); break; } }
    }
    nloc = mine > 0u ? mine : 1u; nx = cnt > 0u ? cnt : 1u;
}

__device__ __forceinline__ void xcd_barrier(const XcdBarrier& b) {
    asm volatile("s_waitcnt vmcnt(0)" ::: "memory");
    __syncthreads();
    if (threadIdx.x == 0) {
        unsigned* bar = b.bar;
        __builtin_amdgcn_s_waitcnt(0);
        unsigned nloc = b.st[0], nx = b.st[1];
        if (nloc == 0u) { xcd_barrier_complete(bar, b.x, nloc, nx); b.st[0] = nloc; b.st[1] = nx; }
        const unsigned old = xb_add(&bar[XB_XSUB(b.x)], 1u);
        const unsigned gen = old / nloc;
        if (old + 1u == (gen + 1u) * nloc) {
            __builtin_amdgcn_fence(__ATOMIC_RELEASE, "agent");
            asm volatile("s_waitcnt vmcnt(0)" ::: "memory");
            const unsigned og = xb_add(&bar[XB_TOP], 1u);
            const unsigned tg = og / nx;
            if (og + 1u == (tg + 1u) * nx) xb_add(&bar[XB_TOPGEN], 1u);
            else XB_SPIN(xb_ld(&bar[XB_TOPGEN]) == tg, bar);
            __builtin_amdgcn_fence(__ATOMIC_ACQUIRE, "agent");
            xb_add(&bar[XB_XGEN(b.x)], 1u);
            asm volatile("s_waitcnt vmcnt(0)" ::: "memory");
        } else {
            XB_SPIN(xb_ld(&bar[XB_XGEN(b.x)]) == gen, bar);
            __builtin_amdgcn_fence(__ATOMIC_ACQUIRE, "agent");
            asm volatile("s_waitcnt vmcnt(0)" ::: "memory");
        }
    }
    __syncthreads();
}
constexpr size_t MiB = 1u << 20;
constexpr size_t WS_CTL = 0, CTL_ZERO_BYTES = 1 * MiB;
constexpr size_t WS_WAB_IN = 1 * MiB, WS_WAB_OUT = 97 * MiB, WS_WGU0 = 129 * MiB, WS_WDN0 = 301 * MiB, WS_WCD_IN = 387 * MiB, WS_WCD_OUT = 467 * MiB, WS_WGU1 = 499 * MiB, WS_WDN1 = 671 * MiB;
constexpr size_t WS_WSMALL = 757 * MiB, WS_WRG = 758 * MiB;
constexpr size_t WS_U = 760 * MiB, WS_PROJ = 824 * MiB, WS_O = 1016 * MiB, WS_H = 1080 * MiB;
constexpr size_t WS_ACT = WS_PROJ;
constexpr size_t WS_SMALL32 = 1208 * MiB, WS_CF = 1209 * MiB, WS_QT = 1210 * MiB, WS_KDT = 1226 * MiB, WS_PM = 1242 * MiB, WS_GDEC = 1246 * MiB, WS_ORAW = 1247 * MiB, WS_SSQ = 1311 * MiB;
constexpr size_t WS_END = 1313 * MiB;
constexpr int CW_BAR = 4096, CW_SSQ = 131072;

constexpr int RING_BYTES = 131072;
constexpr int LDSCTL_OFF = RING_BYTES, MISC_OFF = LDSCTL_OFF + 320;
constexpr int LDS_BYTES = 147456;
constexpr int NWAVES = 8, NTHR = 512;

struct Params {
    const float *x, *norm_mix, *norm_ffn, *ffn_w_gate, *ffn_w_up, *ffn_w_down, *ab_w_in, *gla_w_gate_up, *gla_b_gate, *gla_norm, *fox_b_f, *ab_w_out,
                *cd_w_in, *rg_conv_w, *rg_conv_b, *rg_w_x, *rg_b_x, *rg_w_a, *rg_b_a, *rg_lambda, *cd_w_out, *final_norm;
    float* out; unsigned char* ws; int ph_lo, ph_hi;
};

struct TrDesc { const float* src; bf16_t* dst; const float* gain; int ldn, K; };
__device__ __forceinline__ void tr_load(const TrDesc& d, f32x4 (&v)[8], int lane) {
    const float* sp = d.src + (size_t)(lane >> 3) * d.ldn + 4 * (lane & 7);
#pragma unroll
    for (int i = 0; i < 8; ++i) v[i] = __builtin_nontemporal_load((const f32x4*)(sp + (size_t)(8 * i) * d.ldn));
}
__device__ __forceinline__ void tr_finish(const TrDesc& d, const f32x4 (&v)[8], LAS float* scr, int lane) {
    const int c = lane & 7;
    f32x4 g0 = {1.f, 1.f, 1.f, 1.f}, g1 = {1.f, 1.f, 1.f, 1.f};
    if (d.gain) { g0 = *(const f32x4*)(d.gain + 8 * c); g1 = *(const f32x4*)(d.gain + 8 * c + 4); }
#pragma unroll
    for (int i = 0; i < 8; ++i) { LAS float* w = scr + (8 * i + (lane >> 3)) * 33 + 4 * c; w[0] = v[i].x; w[1] = v[i].y; w[2] = v[i].z; w[3] = v[i].w; }
    LDS_WAIT(); asm volatile("" ::: "memory");
#pragma unroll
    for (int j = 0; j < 4; ++j) { const int n = (lane >> 3) + 8 * j; const LAS float* s = scr + (8 * c) * 33 + n;
        u32x4 o; o.x = cvt_pk_bf16(s[0 * 33] * g0.x, s[1 * 33] * g0.y); o.y = cvt_pk_bf16(s[2 * 33] * g0.z, s[3 * 33] * g0.w); o.z = cvt_pk_bf16(s[4 * 33] * g1.x, s[5 * 33] * g1.y); o.w = cvt_pk_bf16(s[6 * 33] * g1.z, s[7 * 33] * g1.w);
        __builtin_nontemporal_store(o, (u32x4*)(d.dst + (size_t)n * d.K + 8 * c)); }
    LDS_WAIT(); asm volatile("" ::: "memory");
}
#define TR_JOB(W_, ldn_, K_, nsrc0_, ncols_, WT_, rdst0_, gain_) { constexpr int nnb_ = (ncols_) / 32, nit_ = ((K_) / 64) * nnb_; \
    if (r < nit_) { const int kb_ = r / nnb_, nb_ = r % nnb_; const float* g_ = (gain_); \
        return TrDesc{(W_) + (size_t)(64 * kb_) * (ldn_) + (nsrc0_) + 32 * nb_, (WT_) + (size_t)((rdst0_) + 32 * nb_) * (K_) + 64 * kb_, g_ ? g_ + 64 * kb_ : nullptr, (ldn_), (K_)}; } r -= nit_; }
#define TR_JOB_GU(W_, WT_, off_, gain_) { constexpr int nnb_ = DFF / 32, nit_ = (DM / 64) * nnb_; \
    if (r < nit_) { const int kb_ = r / nnb_, nb_ = r % nnb_, c0_ = 32 * nb_; \
        return TrDesc{(W_) + (size_t)(64 * kb_) * DFF + c0_, (WT_) + (size_t)(256 * (c0_ / 128) + (c0_ % 128) + (off_)) * DM + 64 * kb_, (gain_) + 64 * kb_, DFF, DM}; } r -= nit_; }

__device__ __forceinline__ void rms_row_bf16(const float* xrow, const float* g, bf16_t* orow, int lane) {
    const f32x4* xr = (const f32x4*)xrow + lane; const f32x4* gr = (const f32x4*)g + lane;
    f32x4 v[16]; float s = 0.f;
#pragma unroll
    for (int j = 0; j < 16; ++j) { v[j] = xr[64 * j]; s += (v[j].x * v[j].x + v[j].y * v[j].y) + (v[j].z * v[j].z + v[j].w * v[j].w); }
    const float rstd = 1.0f / sqrtf(wave_sum(s) * (1.0f / DM) + EPS);
    u32x2* o8 = (u32x2*)orow + lane;
#pragma unroll
    for (int j = 0; j < 16; ++j) { const f32x4 gg = gr[64 * j]; u32x2 w; w.x = cvt_pk_bf16(v[j].x * rstd * gg.x, v[j].y * rstd * gg.y); w.y = cvt_pk_bf16(v[j].z * rstd * gg.z, v[j].w * rstd * gg.w); o8[64 * j] = w; }
}
__device__ __forceinline__ void rms_row_f32(const float* xrow, const float* g, float* orow, int lane) {
    const f32x4* xr = (const f32x4*)xrow + lane; const f32x4* gr = (const f32x4*)g + lane;
    f32x4 v[16]; float s = 0.f;
#pragma unroll
    for (int j = 0; j < 16; ++j) { v[j] = xr[64 * j]; s += (v[j].x * v[j].x + v[j].y * v[j].y) + (v[j].z * v[j].z + v[j].w * v[j].w); }
    const float rstd = 1.0f / sqrtf(wave_sum(s) * (1.0f / DM) + EPS);
    f32x4* o = (f32x4*)orow + lane;
#pragma unroll
    for (int j = 0; j < 16; ++j) { const f32x4 gg = gr[64 * j]; o[64 * j] = v[j] * rstd * gg; }
}
__device__ __forceinline__ void phase_final_norm(const bf16_t* Hb, const unsigned long long* ssq, const float* g, float* out, int gw, int ngw, int lane, float scale) {
    for (int m = gw; m < MTOK; m += ngw) { const float rstd = scale / sqrtf((float)ssq[m] * (1.0f / 16777216.0f) * (1.0f / DM) + EPS);
        const u32x4* xr = (const u32x4*)(Hb + (size_t)m * DM) + lane; f32x4* o = (f32x4*)(out + (size_t)m * DM); const f32x4* gr = (const f32x4*)g;
#pragma unroll
        for (int j = 0; j < 8; ++j) { const u32x4 r = xr[64 * j]; const int c4 = 2 * (64 * j + lane);
            const f32x4 g0 = gr[c4], g1 = gr[c4 + 1];
            o[c4] = (f32x4){bflo(r.x) * rstd * g0.x, bfhi(r.x) * rstd * g0.y, bflo(r.y) * rstd * g0.z, bfhi(r.y) * rstd * g0.w};
            o[c4 + 1] = (f32x4){bflo(r.z) * rstd * g1.x, bfhi(r.z) * rstd * g1.y, bflo(r.w) * rstd * g1.z, bfhi(r.w) * rstd * g1.w}; } }
}
__device__ __forceinline__ void phase_rms_bf16(const float* src, const float* g, bf16_t* dst, int gw, int ngw, int lane) {
    for (int m = gw; m < MTOK; m += ngw) rms_row_bf16(src + (size_t)m * DM, g, dst + (size_t)m * DM, lane);
}

constexpr int P0_I_AB = (DM / 64) * (6144 / 32), P0_I_SQ = (DM / 64) * (DM / 32), P0_I_CD = (DM / 64) * (CD_IN / 32), P0_I_GU = (DM / 64) * (DFF / 32), P0_I_DN = (DFF / 64) * (DM / 32), P0_I_RG = 16 * (256 / 64) * (256 / 32);
#ifndef TAILKB
#define TAILKB 128
#endif
constexpr int P0_I_DN1 = (DFF / 64 - TAILKB) * (DM / 32), TAIL_ITEMS = TAILKB * (DM / 32);
constexpr int P0_NITEMS = 2 * P0_I_AB + 2 * P0_I_SQ + P0_I_CD + 4 * P0_I_GU + 1 * P0_I_DN + P0_I_RG;
__device__ __forceinline__ TrDesc p0_item(const Params& p, int it) {
    unsigned char* ws = p.ws;
    bf16_t* WAB_IN = (bf16_t*)(ws + WS_WAB_IN); bf16_t* WAB_OUT = (bf16_t*)(ws + WS_WAB_OUT); bf16_t* WGU0 = (bf16_t*)(ws + WS_WGU0); bf16_t* WDN0 = (bf16_t*)(ws + WS_WDN0);
    bf16_t* WCD_IN = (bf16_t*)(ws + WS_WCD_IN); bf16_t* WGU1 = (bf16_t*)(ws + WS_WGU1);
    bf16_t* WRG = (bf16_t*)(ws + WS_WRG);
    int r = it;
    TR_JOB(p.ab_w_in, AB_IN, DM, 0, 6144, WAB_IN, 0, (const float*)nullptr)
    TR_JOB(p.ab_w_in, AB_IN, DM, 6160, 6144, WAB_IN, 6144, (const float*)nullptr)
    TR_JOB(p.ab_w_out, DM, DM, 0, DM, WAB_OUT, 0, (const float*)nullptr)
    TR_JOB_GU(p.ffn_w_gate, WGU0, 0, p.norm_ffn)
    TR_JOB_GU(p.ffn_w_up, WGU0, 128, p.norm_ffn)
    TR_JOB(p.ffn_w_down, DM, DFF, 0, DM, WDN0, 0, (const float*)nullptr)
    TR_JOB(p.cd_w_in, CD_IN, DM, 0, CD_IN, WCD_IN, 0, p.norm_mix + DM)
    TR_JOB_GU(p.ffn_w_gate + (size_t)DM * DFF, WGU1, 0, p.norm_ffn + DM)
    TR_JOB_GU(p.ffn_w_up + (size_t)DM * DFF, WGU1, 128, p.norm_ffn + DM)
    TR_JOB(p.cd_w_out, DM, DM, 0, DM, (bf16_t*)(ws + WS_WCD_OUT), 0, (const float*)nullptr)
    const int mat = r / 32, rr = r % 32, kb_ = rr / 8, nb_ = rr % 8;
    const float* W = (mat < 8 ? p.rg_w_x : p.rg_w_a) + (size_t)(mat & 7) * 65536;
    return TrDesc{W + (size_t)(64 * kb_) * 256 + 32 * nb_, WRG + (size_t)mat * 65536 + (size_t)(32 * nb_) * 256 + 64 * kb_, nullptr, 256, 256};
}
template <class F> __device__ __forceinline__ void tr_run(F item, int first, int step, int n, LAS float* scr, int lane) {
    if (first >= n) return;
    TrDesc da = item(first), db = da, dc = da; f32x4 va[8], vb[8], vc[8];
    tr_load(da, va, lane);
    if (first + step < n) { db = item(first + step); tr_load(db, vb, lane); }
    for (int it = first; it < n; it += 3 * step) {
        const bool h1 = it + step < n, h2 = it + 2 * step < n, h3 = it + 3 * step < n, h4 = it + 4 * step < n;
        if (h2) { dc = item(it + 2 * step); tr_load(dc, vc, lane); }
        tr_finish(da, va, scr, lane);
        if (h3) { da = item(it + 3 * step); tr_load(da, va, lane); }
        if (h1) tr_finish(db, vb, scr, lane);
        if (h4) { db = item(it + 4 * step); tr_load(db, vb, lane); }
        if (h2) tr_finish(dc, vc, scr, lane);
    }
}
struct TailItem { const float* W; bf16_t* WT; const float* W2; bf16_t* WT2;
    __device__ __forceinline__ TrDesc operator()(int r) const { constexpr int nnb = DM / 32;
        if (r < TAIL_ITEMS) { const int kb = r / nnb, nb = r % nnb; return TrDesc{W + (size_t)(64 * kb) * DM + 32 * nb, WT + (size_t)(32 * nb) * DFF + 64 * kb, nullptr, DM, DFF}; }
        r -= TAIL_ITEMS; const int kb = r / nnb, nb = r % nnb; return TrDesc{W2 + (size_t)(64 * kb) * DM + 32 * nb, WT2 + (size_t)(32 * nb) * DM + 64 * kb, nullptr, DM, DM}; } };
struct P0Item { const Params* p; int off; __device__ __forceinline__ TrDesc operator()(int r) const { return p0_item(*p, r + off); } };
constexpr int P0A_ITEMS = 2 * P0_I_AB;
__device__ __forceinline__ void p0b_convert(const Params& p, LAS unsigned char* lds, int tw, int ntw, int wave, int lane) {
    P0Item pi{&p, P0A_ITEMS}; tr_run(pi, tw, ntw, P0_NITEMS - P0A_ITEMS, (LAS float*)(lds + wave * 8704), lane);
}
struct Tail1Item { const float* W; bf16_t* WT;
    __device__ __forceinline__ TrDesc operator()(int r) const { constexpr int nnb = DM / 32; const int kb = TAILKB + r / nnb, nb = r % nnb;
        return TrDesc{W + (size_t)(64 * kb) * DM + 32 * nb, WT + (size_t)(32 * nb) * DFF + 64 * kb, nullptr, DM, DFF}; } };
__device__ __forceinline__ void tail1_convert(const Params& p, LAS unsigned char* lds, int tw, int ntw, int wave, int lane) {
    Tail1Item ti{p.ffn_w_down + (size_t)DFF * DM, (bf16_t*)(p.ws + WS_WDN1)};
    tr_run(ti, tw, ntw, P0_I_DN1, (LAS float*)(lds + wave * 8704), lane);
}
__device__ __forceinline__ void tail_convert(const Params& p, LAS unsigned char* lds, int tw, int ntw, int wave, int lane) {
    TailItem ti{p.ffn_w_down + (size_t)DFF * DM, (bf16_t*)(p.ws + WS_WDN1), p.cd_w_out, (bf16_t*)(p.ws + WS_WCD_OUT)};
    tr_run(ti, tw, ntw, TAIL_ITEMS, (LAS float*)(lds + wave * 8704), lane);
}
__device__ __forceinline__ void phase_p0(const Params& p, LAS unsigned char* lds, int gw, int ngw, int wave, int lane) {
    unsigned char* ws = p.ws;
    LAS float* scr = (LAS float*)(lds + wave * 8704);
    { P0Item pi{&p, 0}; tr_run(pi, gw, ngw, P0A_ITEMS, scr, lane); }
    { bf16_t* WS_ = (bf16_t*)(ws + WS_WSMALL);
      for (int i = gw * 64 + lane; i < 32 * DM; i += ngw * 64) { const int c = i & 31, k = i >> 5; const int sc = c < 16 ? 6144 + c : 12304 + (c - 16);
          WS_[(size_t)c * DM + k] = f2bf(p.ab_w_in[(size_t)k * AB_IN + sc]); } }
    phase_rms_bf16(p.x, p.norm_mix, (bf16_t*)(ws + WS_U), gw, ngw, lane);
}

__device__ __forceinline__ void phase_small32(const Params& p, LAS unsigned char* lds, int wave, int lane) {
    const bf16_t* U = (const bf16_t*)(p.ws + WS_U); const bf16_t* WS_ = (const bf16_t*)(p.ws + WS_WSMALL); float* S32 = (float*)(p.ws + WS_SMALL32);
    LAS float* red = (LAS float*)lds;
    const int h = lane >> 5, c = lane & 31;
    for (int unit = blockIdx.x; unit < MTOK / 32; unit += gridDim.x) {
        const int row0 = unit * 32, kbase = wave * 512;
        f32x16 acc; for (int i = 0; i < 16; ++i) acc[i] = 0.f;
        const bf16_t* ap = U + (size_t)(row0 + c) * DM + kbase + 8 * h; const bf16_t* bp = WS_ + (size_t)c * DM + kbase + 8 * h;
#pragma unroll 8
        for (int s = 0; s < 32; ++s) { const bf16x8 a = *(const bf16x8*)(ap + 16 * s), b = *(const bf16x8*)(bp + 16 * s); acc = MFMA32(a, b, acc); }
#pragma unroll
        for (int r = 0; r < 16; ++r) red[(wave * 32 + crow(r, h)) * 33 + c] = acc[r];
        __syncthreads();
        for (int i = threadIdx.x; i < 1024; i += NTHR) { const int t = i >> 5, cc = i & 31; float s = 0.f;
#pragma unroll
            for (int w = 0; w < 8; ++w) s += red[(w * 32 + t) * 33 + cc];
            S32[(size_t)(row0 + t) * 32 + cc] = s; }
        __syncthreads();
    }
}

__device__ __forceinline__ void phase_fox_cumsum(const Params& p, LAS unsigned char* lds, int wave, int lane) {
    const float* S32 = (const float*)(p.ws + WS_SMALL32); float* CF = (float*)(p.ws + WS_CF);
    LAS float* WT = (LAS float*)(lds + 90112);
    const int tid = threadIdx.x;
    for (int u = blockIdx.x; u < NB * 16; u += gridDim.x) { const int b = u >> 4, hd = u & 15; const float bias = p.fox_b_f[hd];
        float v[4];
#pragma unroll
        for (int i = 0; i < 4; ++i) v[i] = log_sigmoid_acc(S32[(size_t)(b * SEQ + 4 * tid + i) * 32 + 16 + hd] + bias);
        v[1] += v[0]; v[2] += v[1]; v[3] += v[2];
        const float tot = v[3]; float incl = tot;
#pragma unroll
        for (int o = 1; o < 64; o <<= 1) { const float t = __shfl_up(incl, o); if (lane >= o) incl += t; }
        if (lane == 63) WT[wave] = incl;
        __syncthreads();
        float off = incl - tot;
#pragma unroll
        for (int w = 0; w < 7; ++w) off += w < wave ? WT[w] : 0.f;
        *(f32x4*)(CF + (size_t)u * SEQ + 4 * tid) = (f32x4){v[0] + off, v[1] + off, v[2] + off, v[3] + off};
        __syncthreads();
    }
}

constexpr int GP_PITCH = 528;
__device__ __forceinline__ void phase_gla_pre(const Params& p, LAS unsigned char* lds, int wave, int lane) {
    const unsigned char* ws = p.ws;
    const bf16_t* PROJ = (const bf16_t*)(ws + WS_PROJ); const float* S32 = (const float*)(ws + WS_SMALL32);
    bf16_t* QT = (bf16_t*)(ws + WS_QT); bf16_t* KDT = (bf16_t*)(ws + WS_KDT); bf16_t* PM = (bf16_t*)(ws + WS_PM); float* GDEC = (float*)(ws + WS_GDEC);
    LAS float* G = (LAS float*)lds;
    LAS float* TOT = (LAS float*)(lds + 4096);
    LAS unsigned char* QTl = lds + 8192;
    LAS unsigned char* KTl = lds + 8192 + 64 * GP_PITCH;
    LAS unsigned char* PL = lds + 8192 + 128 * GP_PITCH;
    const int tid = threadIdx.x, k = tid & 255, th = tid >> 8, h = lane >> 5, l31 = lane & 31;
    for (int unit = blockIdx.x; unit < NB * 4 * 32; unit += gridDim.x) {
        const int b = unit >> 7, hd = (unit >> 5) & 3, c = unit & 31, R0 = b * SEQ + 64 * c;
        const bf16_t* qp = PROJ + (size_t)(R0 + 32 * th) * AB_MAIN + PJ_GQ + hd * 256 + k; const bf16_t* kp = PROJ + (size_t)(R0 + 32 * th) * AB_MAIN + PJ_GK + hd * 256 + k;
        bf16_t qraw[32], kraw[32];
#pragma unroll
        for (int tt = 0; tt < 32; ++tt) { qraw[tt] = qp[(size_t)tt * AB_MAIN]; kraw[tt] = kp[(size_t)tt * AB_MAIN]; }
        for (int i = tid; i < 1024; i += NTHR) G[i] = S32[(size_t)(R0 + (i >> 4)) * 32 + (i & 15)];
        float w[16];
#pragma unroll
        for (int r = 0; r < 16; ++r) w[r] = p.gla_w_gate_up[r * 1024 + hd * 256 + k];
        const float bias = p.gla_b_gate[hd * 256 + k];
        __syncthreads();
        float bc[32]; float run = 0.f;
#pragma unroll
        for (int tt = 0; tt < 32; ++tt) { const LAS f32x4* g4 = (const LAS f32x4*)(G + (32 * th + tt) * 16); float xx = bias;
#pragma unroll
            for (int q4 = 0; q4 < 4; ++q4) { const f32x4 gv = g4[q4]; xx += gv.x * w[4 * q4] + gv.y * w[4 * q4 + 1] + gv.z * w[4 * q4 + 2] + gv.w * w[4 * q4 + 3]; }
            run += log_sigmoid_fast(xx) * (LOG2E_F / 16.0f); bc[tt] = run; }
        TOT[th * 256 + k] = run;
        __syncthreads();
        const float t0 = TOT[k], t1 = TOT[256 + k], blast = t0 + t1, boff = th ? t0 : 0.f;
        if (th == 0) GDEC[(size_t)unit * 256 + k] = __builtin_amdgcn_exp2f(blast);
#pragma unroll
        for (int t8 = 0; t8 < 4; ++t8) { float kd[8];
#pragma unroll
            for (int i = 0; i < 8; ++i) { const int tt = 8 * t8 + i; const float bb = bc[tt] + boff;
                const float qv = bf2f(qraw[tt]), kv = bf2f(kraw[tt]);
                const float qt = qv * 0.0625f * __builtin_amdgcn_exp2f(bb), kt = kv * __builtin_amdgcn_exp2f(-bb); kd[i] = kv * __builtin_amdgcn_exp2f(blast - bb);
                const bf16_t qb = f2bf(qt);
                *(LAS bf16_t*)(QTl + (32 * th + tt) * GP_PITCH + 2 * k) = qb; *(LAS bf16_t*)(KTl + (32 * th + tt) * GP_PITCH + 2 * k) = f2bf(kt);
                }
            u32x4 o; o.x = cvt_pk_bf16(kd[0], kd[1]); o.y = cvt_pk_bf16(kd[2], kd[3]); o.z = cvt_pk_bf16(kd[4], kd[5]); o.w = cvt_pk_bf16(kd[6], kd[7]);
            *(u32x4*)(KDT + (((size_t)unit * 8 + (k >> 5)) * 4 + 2 * th + (t8 >> 1)) * 512 + ((k & 31) + 32 * (t8 & 1)) * 8) = o; }
        __syncthreads();
#pragma unroll
        for (int f = 0; f < 4; ++f) { const int ti = f >> 1, s2 = f & 1; const LAS unsigned char* qp8 = QTl + (32 * ti + l31) * GP_PITCH + (32 * wave + 16 * s2 + 4 * h) * 2;
            const s16x4 lo = *(const LAS s16x4*)qp8, hi = *(const LAS s16x4*)(qp8 + 16);
            *(bf16x8*)(QT + (((size_t)unit * 8 + wave) * 4 + f) * 512 + lane * 8) = cat4(lo, hi); }
        if (wave < 4) { const int ti = wave & 1, si = wave >> 1;
            f32x16 acc; for (int i = 0; i < 16; ++i) acc[i] = 0.f;
            const LAS unsigned char* ap = QTl + (32 * ti + (lane & 31)) * GP_PITCH + 16 * h; const LAS unsigned char* bp = KTl + (32 * si + (lane & 31)) * GP_PITCH + 16 * h;
#pragma unroll
            for (int s = 0; s < 16; ++s) { const bf16x8 a = *(const LAS bf16x8*)(ap + 32 * s), bb = *(const LAS bf16x8*)(bp + 32 * s); acc = MFMA32(a, bb, acc); }
            const int sc = 32 * si + (lane & 31);
#pragma unroll
            for (int r = 0; r < 16; ++r) { const int t = 32 * ti + crow(r, h); *(LAS bf16_t*)(PL + t * 144 + 2 * sc) = f2bf(sc <= t ? acc[r] : 0.f); }
        }
        __syncthreads();
        { const int f = tid >> 6, tip = f >> 2, ssp = f & 3;
          *(bf16x8*)(PM + ((size_t)unit * 8 + f) * 512 + lane * 8) = *(const LAS bf16x8*)(PL + (32 * tip + l31) * 144 + (16 * ssp + 8 * h) * 2); }
        __syncthreads();
    }
}

__device__ __forceinline__ void l2_touch(const void* gp, unsigned lds_addr) { asm volatile("s_mov_b32 m0, %1\n\ts_nop 0\n\tglobal_load_lds_dword %0, off" :: "v"(gp), "s"(lds_addr) : "memory", "m0"); }
constexpr int VT_PITCH = 144;
struct GlaChunk { u32x2 vraw; bf16x8 qa00, qa01, qa10, qa11, kd0, kd1, kd2, kd3, pa; float gdv; };
__device__ __forceinline__ void gla_load_chunk(GlaChunk& r, const bf16_t* PROJ, const bf16_t* QT, const bf16_t* KDT, const bf16_t* PM, const float* GDEC, int b, int hd, int v0, int c, int wave, int tid, int h, int l31) {
    const int R0 = b * SEQ + 64 * c, cu = (b * 4 + hd) * 32 + c;
    { const int s = tid >> 3, v4 = (tid & 7) * 4; r.vraw = *(const u32x2*)(PROJ + (size_t)(R0 + s) * AB_MAIN + PJ_GV + hd * 512 + v0 + v4); }
    { const bf16_t* qf = QT + (((size_t)cu * 8 + wave) * 4) * 512 + (tid & 63) * 8;
      r.qa00 = *(const bf16x8*)qf; r.qa01 = *(const bf16x8*)(qf + 512); r.qa10 = *(const bf16x8*)(qf + 1024); r.qa11 = *(const bf16x8*)(qf + 1536); }
    { const bf16_t* kf = KDT + (((size_t)cu * 8 + wave) * 4) * 512 + (tid & 63) * 8;
      r.kd0 = *(const bf16x8*)kf; r.kd1 = *(const bf16x8*)(kf + 512); r.kd2 = *(const bf16x8*)(kf + 1024); r.kd3 = *(const bf16x8*)(kf + 1536); }
    r.pa = *(const bf16x8*)(PM + ((size_t)cu * 8 + (wave & 1) * 4 + (wave >> 1)) * 512 + (tid & 63) * 8);
    r.gdv = tid < 256 ? GDEC[(size_t)cu * 256 + tid] : 0.f;
}
__device__ __forceinline__ void phase_gla_seq(const Params& p, LAS unsigned char* lds, int wave, int lane) {
    const unsigned char* ws = p.ws;
    const bf16_t* PROJ = (const bf16_t*)(ws + WS_PROJ); const bf16_t* QT = (const bf16_t*)(ws + WS_QT); const bf16_t* KDT = (const bf16_t*)(ws + WS_KDT); const bf16_t* PM = (const bf16_t*)(ws + WS_PM);
    const float* GDEC = (const float*)(ws + WS_GDEC); float* ORAW = (float*)(p.ws + WS_ORAW); float* SSQ = (float*)(p.ws + WS_SSQ);
    LAS float* RED = (LAS float*)lds;
    LAS unsigned char* VT = lds + 65536;
    LAS float* GD = (LAS float*)(lds + 65536 + 2 * 32 * VT_PITCH);
    const int tid = threadIdx.x, h = lane >> 5, l31 = lane & 31;
    for (int u0 = blockIdx.x; u0 < NB * 4 * 16; u0 += gridDim.x) {
        const int unit = xcd_swz(u0, NB * 4 * 16);
        const int b = unit >> 6, hd = (unit >> 4) & 3, vs = unit & 15, v0 = 32 * vs;
        f32x16 S; for (int i = 0; i < 16; ++i) S[i] = 0.f;
        GlaChunk cur, nxt;
        gla_load_chunk(cur, PROJ, QT, KDT, PM, GDEC, b, hd, v0, 0, wave, tid, h, l31);
        nxt = cur;
        for (int c = 0; c < 32; ++c) {
            const int R0 = b * SEQ + 64 * c;
            LAS unsigned char* vt = VT + (c & 1) * (32 * VT_PITCH);
            { const int s = tid >> 3, v4 = (tid & 7) * 4; const u32x2 raw = cur.vraw;
              *(LAS bf16_t*)(vt + (v4 + 0) * VT_PITCH + 2 * s) = (bf16_t)(raw.x & 0xffffu); *(LAS bf16_t*)(vt + (v4 + 1) * VT_PITCH + 2 * s) = (bf16_t)(raw.x >> 16);
              *(LAS bf16_t*)(vt + (v4 + 2) * VT_PITCH + 2 * s) = (bf16_t)(raw.y & 0xffffu); *(LAS bf16_t*)(vt + (v4 + 3) * VT_PITCH + 2 * s) = (bf16_t)(raw.y >> 16); }
            if (tid < 256) GD[(c & 1) * 256 + tid] = cur.gdv;
            if (c + 1 < 32) gla_load_chunk(nxt, PROJ, QT, KDT, PM, GDEC, b, hd, v0, c + 1, wave, tid, h, l31);
            if (c + 3 < 32 && wave < 2) {
                const int c3 = c + 3, cu3 = (b * 4 + hd) * 32 + c3; const char* tp;
                if (wave == 0) { const int li = vs * 37 + lane;
                    tp = li < 256 ? (const char*)QT + (size_t)cu3 * 32768 + li * 128 : li < 512 ? (const char*)KDT + (size_t)cu3 * 32768 + (li - 256) * 128
                       : li < 576 ? (const char*)PM + (size_t)cu3 * 8192 + (li - 512) * 128 : (const char*)GDEC + (size_t)cu3 * 1024 + (li - 576) * 128;
                    if (lane < 37 && li < 584) l2_touch(tp, (unsigned)(size_t)(lds + 100352)); }
                else { tp = (const char*)(PROJ + (size_t)(b * SEQ + 64 * c3 + lane) * AB_MAIN + PJ_GV + hd * 512 + v0); l2_touch(tp, (unsigned)(size_t)(lds + 100608)); } }
            LDS_BARRIER();
            const int tip = wave & 1, ssp = wave >> 1;
            f32x16 oacc[2];
#pragma unroll
            for (int ti = 0; ti < 2; ++ti) for (int i = 0; i < 16; ++i) oacc[ti][i] = 0.f;
            const bf16x8 sb0 = pack8(S[0], S[1], S[2], S[3], S[4], S[5], S[6], S[7]), sb1 = pack8(S[8], S[9], S[10], S[11], S[12], S[13], S[14], S[15]);
            oacc[0] = MFMA32(cur.qa00, sb0, oacc[0]); oacc[0] = MFMA32(cur.qa01, sb1, oacc[0]);
            oacc[1] = MFMA32(cur.qa10, sb0, oacc[1]); oacc[1] = MFMA32(cur.qa11, sb1, oacc[1]);
            bf16x8 vb[4];
#pragma unroll
            for (int ss = 0; ss < 4; ++ss) vb[ss] = *(const LAS bf16x8*)(vt + l31 * VT_PITCH + 32 * ss + 16 * h);
            { const bf16x8 vbp = ssp == 0 ? vb[0] : ssp == 1 ? vb[1] : ssp == 2 ? vb[2] : vb[3];
              if (tip == 0) oacc[0] = MFMA32(cur.pa, vbp, oacc[0]); else oacc[1] = MFMA32(cur.pa, vbp, oacc[1]); }
            { const LAS float* gp = GD + (c & 1) * 256 + 32 * wave + 4 * h; const f32x4 g0 = *(const LAS f32x4*)gp, g1 = *(const LAS f32x4*)(gp + 8), g2 = *(const LAS f32x4*)(gp + 16), g3 = *(const LAS f32x4*)(gp + 24);
#pragma unroll
              for (int i = 0; i < 4; ++i) { S[i] *= g0[i]; S[4 + i] *= g1[i]; S[8 + i] *= g2[i]; S[12 + i] *= g3[i]; } }
            S = MFMA32(cur.kd0, vb[0], S); S = MFMA32(cur.kd1, vb[1], S); S = MFMA32(cur.kd2, vb[2], S); S = MFMA32(cur.kd3, vb[3], S);
#pragma unroll
            for (int ti = 0; ti < 2; ++ti)
#pragma unroll
                for (int r = 0; r < 16; ++r) RED[(wave * 64 + 32 * ti + crow(r, h)) * 32 + l31] = oacc[ti][r];
            LDS_BARRIER();
            { const int t = tid >> 3, v4 = (tid & 7) * 4; f32x4 o = {0.f, 0.f, 0.f, 0.f};
#pragma unroll
              for (int w = 0; w < 8; ++w) o += *(const LAS f32x4*)(RED + (w * 64 + t) * 32 + v4);
              *(f32x4*)(ORAW + (size_t)(R0 + t) * 2048 + hd * 512 + v0 + v4) = o;
              float q = (o.x * o.x + o.y * o.y) + (o.z * o.z + o.w * o.w);
              q += __shfl_xor(q, 1); q += __shfl_xor(q, 2); q += __shfl_xor(q, 4);
              if ((tid & 7) == 0) SSQ[(size_t)(R0 + t) * 64 + hd * 16 + vs] = q; }
            cur = nxt;
        }
        __syncthreads();
    }
}

__device__ __forceinline__ void phase_gla_post(const Params& p, int gw, int ngw, int lane) {
    const bf16_t* PROJ = (const bf16_t*)(p.ws + WS_PROJ); const float* ORAW = (const float*)(p.ws + WS_ORAW); const float* SSQ = (const float*)(p.ws + WS_SSQ); bf16_t* O = (bf16_t*)(p.ws + WS_O);
    const f32x4 gn0 = *(const f32x4*)(p.gla_norm + 8 * lane), gn1 = *(const f32x4*)(p.gla_norm + 8 * lane + 4);
    for (int u = gw; u < MTOK * 4; u += ngw) { const int row = u >> 2, hd = u & 3;
        float ss = 0.f;
#pragma unroll
        for (int i = 0; i < 4; ++i) { const f32x4 s4 = *(const f32x4*)(SSQ + (size_t)row * 64 + hd * 16 + 4 * i); ss += (s4.x + s4.y) + (s4.z + s4.w); }
        const float rstd = 1.0f / sqrtf(ss * (1.0f / 512.0f) + EPS);
        const f32x4 o0 = *(const f32x4*)(ORAW + (size_t)row * 2048 + hd * 512 + 8 * lane), o1 = *(const f32x4*)(ORAW + (size_t)row * 2048 + hd * 512 + 8 * lane + 4);
        const u32x4 gr = *(const u32x4*)(PROJ + (size_t)row * AB_MAIN + PJ_GG + hd * 512 + 8 * lane);
        float g[8] = {bflo(gr.x), bfhi(gr.x), bflo(gr.y), bfhi(gr.y), bflo(gr.z), bfhi(gr.z), bflo(gr.w), bfhi(gr.w)};
        float o[8] = {o0.x * gn0.x, o0.y * gn0.y, o0.z * gn0.z, o0.w * gn0.w, o1.x * gn1.x, o1.y * gn1.y, o1.z * gn1.z, o1.w * gn1.w};
#pragma unroll
        for (int i = 0; i < 8; ++i) o[i] = o[i] * rstd * g[i] / (1.0f + __expf(-g[i]));
        u32x4 w; w.x = cvt_pk_bf16(o[0], o[1]); w.y = cvt_pk_bf16(o[2], o[3]); w.z = cvt_pk_bf16(o[4], o[5]); w.w = cvt_pk_bf16(o[6], o[7]);
        *(u32x4*)(O + (size_t)row * DM + hd * 512 + 8 * lane) = w; }
}

constexpr int AK_PITCH = 272, AV_PITCH = 320;
constexpr int AK_BYTES = 64 * AK_PITCH, AV_BYTES = 64 * AV_PITCH;
constexpr int A_KOFF = 0, A_VOFF = 2 * AK_BYTES, A_COFF = A_VOFF + 2 * AV_BYTES, A_FLAGS = A_COFF + 512;
constexpr float ATT_SCALE = 0.08838834764831845f;
constexpr float LOG2E = 1.4426950408889634f;

struct AttnIO { const bf16_t* Q; const bf16_t* K; const bf16_t* V; int ld; bf16_t* O; int ldo; };

__device__ __forceinline__ void attn_stage_load(const AttnIO& io, size_t rowbase, int hd, int key0, u32x4 (&kr)[2], u32x4 (&vr)[2], int tid) {
#pragma unroll
    for (int i = 0; i < 2; ++i) { const int idx = tid + NTHR * i, r = idx >> 4, ch = idx & 15; const size_t off = (rowbase + key0 + r) * (size_t)io.ld + hd * 128 + ch * 8;
        kr[i] = *(const u32x4*)(io.K + off); vr[i] = *(const u32x4*)(io.V + off); }
}
__device__ __forceinline__ void attn_stage_store(LAS unsigned char* lds, int buf, const u32x4 (&kr)[2], const u32x4 (&vr)[2], int tid) {
#pragma unroll
    for (int i = 0; i < 2; ++i) { const int idx = tid + NTHR * i, r = idx >> 4, ch = idx & 15;
        *(LAS u32x4*)(lds + A_KOFF + buf * AK_BYTES + r * AK_PITCH + ch * 16) = kr[i]; *(LAS u32x4*)(lds + A_VOFF + buf * AV_BYTES + r * AV_PITCH + ch * 16) = vr[i]; }
}
__device__ __forceinline__ void attn_qk(LAS unsigned char* lds, int buf, const bf16x8 (&qf)[8], f32x16& s0, f32x16& s1, int lane) {
    const LAS unsigned char* kp = lds + A_KOFF + buf * AK_BYTES + (lane & 31) * AK_PITCH + (lane >> 5) * 16;
    for (int i = 0; i < 16; ++i) { s0[i] = 0.f; s1[i] = 0.f; }
#pragma unroll
    for (int s = 0; s < 8; ++s) { const bf16x8 a0 = *(const LAS bf16x8*)(kp + 32 * s), a1 = *(const LAS bf16x8*)(kp + 32 * AK_PITCH + 32 * s);
        s0 = MFMA32(a0, qf[s], s0); s1 = MFMA32(a1, qf[s], s1); }
}
__device__ __forceinline__ void attn_pv(LAS unsigned char* lds, int buf, const f32x16& p0, const f32x16& p1, f32x16 (&o)[4], int lane) {
    const lds_cptr vp = (lds_cptr)(lds + A_VOFF + buf * AV_BYTES + (4 * (lane >> 5) + ((lane & 15) >> 2)) * AV_PITCH + (((lane >> 4) & 1) * 16 + (lane & 3) * 4) * 2);
    const bf16x8 pf00 = pack8(p0[0], p0[1], p0[2], p0[3], p0[4], p0[5], p0[6], p0[7]), pf01 = pack8(p0[8], p0[9], p0[10], p0[11], p0[12], p0[13], p0[14], p0[15]);
    const bf16x8 pf10 = pack8(p1[0], p1[1], p1[2], p1[3], p1[4], p1[5], p1[6], p1[7]), pf11 = pack8(p1[8], p1[9], p1[10], p1[11], p1[12], p1[13], p1[14], p1[15]);
#pragma unroll
    for (int dt = 0; dt < 4; ++dt) {
        const bf16x8 a00 = cat4(vtr(vp + (0) * AV_PITCH + dt * 64), vtr(vp + (8) * AV_PITCH + dt * 64));
        const bf16x8 a01 = cat4(vtr(vp + (16) * AV_PITCH + dt * 64), vtr(vp + (24) * AV_PITCH + dt * 64));
        const bf16x8 a10 = cat4(vtr(vp + (32) * AV_PITCH + dt * 64), vtr(vp + (40) * AV_PITCH + dt * 64));
        const bf16x8 a11 = cat4(vtr(vp + (48) * AV_PITCH + dt * 64), vtr(vp + (56) * AV_PITCH + dt * 64));
        o[dt] = MFMA32(a00, pf00, o[dt]); o[dt] = MFMA32(a01, pf01, o[dt]); o[dt] = MFMA32(a10, pf10, o[dt]); o[dt] = MFMA32(a11, pf11, o[dt]);
    }
}
__device__ __forceinline__ void attn_store_o(const AttnIO& io, size_t row, int hd, const f32x16 (&o)[4], float scl, int lane) {
    bf16_t* op = io.O + row * (size_t)io.ldo + hd * 128 + 4 * (lane >> 5);
#pragma unroll
    for (int dt = 0; dt < 4; ++dt)
#pragma unroll
        for (int g = 0; g < 4; ++g) { u32x2 w; w.x = cvt_pk_bf16(o[dt][4 * g] * scl, o[dt][4 * g + 1] * scl); w.y = cvt_pk_bf16(o[dt][4 * g + 2] * scl, o[dt][4 * g + 3] * scl);
            *(u32x2*)(op + 32 * dt + 8 * g) = w; }
}

__device__ __forceinline__ void fox_unit(const AttnIO& io, const float* CF, LAS unsigned char* lds, int b, int hd, int qb, int wave, int lane) {
    const int tid = threadIdx.x, h = lane >> 5, l31 = lane & 31;
    const size_t rowbase = (size_t)b * SEQ; const int q0w = 256 * qb + 32 * wave, qpos = q0w + l31;
    const float* cf = CF + (size_t)(b * 16 + hd) * SEQ;
    bf16x8 qf[8];
#pragma unroll
    for (int s = 0; s < 8; ++s) qf[s] = *(const bf16x8*)(io.Q + (rowbase + qpos) * (size_t)io.ld + hd * 128 + 16 * s + 8 * h);
    const float cq = cf[qpos] * LOG2E;
    f32x16 o[4];
#pragma unroll
    for (int dt = 0; dt < 4; ++dt) for (int i = 0; i < 16; ++i) o[dt][i] = 0.f;
    float m = -1e30f, l = 0.f;
    const int ntiles = 4 * qb + 4;
    u32x4 kr[2], vr[2];
    LAS float* cks = (LAS float*)(lds + A_COFF);
    attn_stage_load(io, rowbase, hd, 64 * (ntiles - 1), kr, vr, tid);
    attn_stage_store(lds, 0, kr, vr, tid);
    if (tid < 64) cks[tid] = cf[64 * (ntiles - 1) + tid] * LOG2E;
    __syncthreads();
    for (int jj = 0; jj < ntiles; ++jj) {
        const int j = ntiles - 1 - jj, buf = jj & 1; const bool more = jj + 1 < ntiles;
        float cnext = 0.f;
        if (more) { attn_stage_load(io, rowbase, hd, 64 * (j - 1), kr, vr, tid); if (tid < 64) cnext = cf[64 * (j - 1) + tid] * LOG2E; }
        if (64 * j <= q0w + 31) {
            f32x16 s0, s1; attn_qk(lds, buf, qf, s0, s1, lane);
            const LAS float* ck = cks + buf * 64;
            const bool diag = 64 * j + 63 > q0w;
            float mx = -__builtin_inff();
#pragma unroll
            for (int g = 0; g < 4; ++g) { const f32x4 c0 = *(const LAS f32x4*)(ck + 8 * g + 4 * h), c1 = *(const LAS f32x4*)(ck + 32 + 8 * g + 4 * h);
#pragma unroll
                for (int i = 0; i < 4; ++i) { const int r = 4 * g + i, key = 64 * j + 8 * g + 4 * h + i;
                    float y0 = s0[r] * (ATT_SCALE * LOG2E) + (cq - c0[i]), y1 = s1[r] * (ATT_SCALE * LOG2E) + (cq - c1[i]);
                    if (diag) { y0 = key <= qpos ? y0 : -__builtin_inff(); y1 = key + 32 <= qpos ? y1 : -__builtin_inff(); }
                    s0[r] = y0; s1[r] = y1; mx = fmaxf(mx, fmaxf(y0, y1)); } }
            mx = fmaxf(mx, __shfl_xor(mx, 32));
            if (!__all(mx - m <= 8.0f)) {
                const float mn = fmaxf(m, mx), alpha = __builtin_amdgcn_exp2f(m - mn); m = mn; l *= alpha;
#pragma unroll
                for (int dt = 0; dt < 4; ++dt) for (int i = 0; i < 16; ++i) o[dt][i] *= alpha;
            }
            float ps = 0.f;
#pragma unroll
            for (int r = 0; r < 16; ++r) { s0[r] = __builtin_amdgcn_exp2f(s0[r] - m); s1[r] = __builtin_amdgcn_exp2f(s1[r] - m); ps += s0[r] + s1[r]; }
            l += ps;
            attn_pv(lds, buf, s0, s1, o, lane);
        }
        if (more) { attn_stage_store(lds, buf ^ 1, kr, vr, tid); if (tid < 64) cks[(buf ^ 1) * 64 + tid] = cnext; }
        __syncthreads();
    }
    l += __shfl_xor(l, 32);
    attn_store_o(io, rowbase + qpos, hd, o, 1.0f / l, lane);
}

__device__ __forceinline__ void sb_subtile(f32x16& s, int keybase, int qpos, int h, float& P, bool diag) {
    float be[16], om[16];
#pragma unroll
    for (int r = 0; r < 16; ++r) { const float z2 = s[r] * (ATT_SCALE * LOG2E); const float t = __builtin_amdgcn_exp2f(-fabsf(z2)); const float rr = __builtin_amdgcn_rcpf(1.0f + t), tr = t * rr;
        const bool pos = z2 >= 0.f; be[r] = pos ? rr : tr; om[r] = pos ? tr : rr;
        if (diag) { const bool valid = keybase + crow(r, h) < qpos; be[r] = valid ? be[r] : 0.f; om[r] = valid ? om[r] : 1.0f; } }
    float T[4], Tp[4];
#pragma unroll
    for (int g = 0; g < 4; ++g) { T[g] = (om[4 * g] * om[4 * g + 1]) * (om[4 * g + 2] * om[4 * g + 3]); Tp[g] = __shfl_xor(T[g], 32); }
    float run = P;
#pragma unroll
    for (int g = 3; g >= 0; --g) {
        const float off = h ? run : run * Tp[g];
        const float sf2 = om[4 * g + 3], sf1 = sf2 * om[4 * g + 2], sf0 = sf1 * om[4 * g + 1];
        s[4 * g + 3] = be[4 * g + 3] * off; s[4 * g + 2] = be[4 * g + 2] * (off * sf2); s[4 * g + 1] = be[4 * g + 1] * (off * sf1); s[4 * g] = be[4 * g] * (off * sf0);
        run *= T[g] * Tp[g];
    }
    P = run;
}
__device__ __forceinline__ void sb_unit(const AttnIO& io, LAS unsigned char* lds, int b, int hd, int qb, int wave, int lane) {
    const int tid = threadIdx.x, h = lane >> 5, l31 = lane & 31;
    const size_t rowbase = (size_t)b * SEQ; const int qpos = 256 * qb + 32 * wave + l31;
    bf16x8 qf[8];
#pragma unroll
    for (int s = 0; s < 8; ++s) qf[s] = *(const bf16x8*)(io.Q + (rowbase + qpos) * (size_t)io.ld + hd * 128 + 16 * s + 8 * h);
    f32x16 o[4];
#pragma unroll
    for (int dt = 0; dt < 4; ++dt) for (int i = 0; i < 16; ++i) o[dt][i] = 0.f;
    float R = 1.0f;
    bool wdone = false;
    const int ntiles = 4 * qb + 4;
    u32x4 kr[2], vr[2];
    LAS unsigned* flags = (LAS unsigned*)(lds + A_FLAGS);
    attn_stage_load(io, rowbase, hd, 64 * (ntiles - 1), kr, vr, tid);
    attn_stage_store(lds, 0, kr, vr, tid);
    __syncthreads();
    for (int jj = 0; jj < ntiles; ++jj) {
        const int j = ntiles - 1 - jj, buf = jj & 1; const bool more = jj + 1 < ntiles;
        if (more) attn_stage_load(io, rowbase, hd, 64 * (j - 1), kr, vr, tid);
        if (!wdone && 64 * j < 256 * qb + 32 * wave + 31) {
            f32x16 s0, s1; attn_qk(lds, buf, qf, s0, s1, lane);
            const bool diag = 64 * j + 63 >= 256 * qb + 32 * wave;
            sb_subtile(s1, 64 * j + 32, qpos, h, R, diag);
            sb_subtile(s0, 64 * j, qpos, h, R, diag);
            attn_pv(lds, buf, s0, s1, o, lane);
            wdone = __all(R == 0.0f);
        }
        if (more) attn_stage_store(lds, buf ^ 1, kr, vr, tid);
        if (lane == 0) flags[buf * 8 + wave] = wdone ? 1u : 0u;
        __syncthreads();
        { const u32x4 f0 = *(const LAS u32x4*)(flags + buf * 8), f1 = *(const LAS u32x4*)(flags + buf * 8 + 4);
          if ((f0.x & f0.y & f0.z & f0.w & f1.x & f1.y & f1.z & f1.w) != 0u) break; }
    }
    attn_store_o(io, rowbase + qpos, hd, o, 1.0f, lane);
}

constexpr int RG_XPITCH = 528;
constexpr int RG_XC = 0, RG_GX = 128 * RG_XPITCH, RG_GA = RG_GX + 128 * 32 * 4, RG_HB = RG_GA + 128 * 32 * 4, RG_CW = RG_HB + 128 * 32 * 4, RG_SPL = RG_CW + 5 * 256 * 4, RG_SA = RG_SPL + 128, RG_SB = RG_SA + 2048, RG_HS = RG_SB + 2048, RG_HIN = RG_HS + 256;
__device__ __forceinline__ float gelu_tanh(float x) { const float u = 0.7978845608028654f * (x + 0.044715f * x * x * x); const float e = __expf(2.0f * u); const float th = 1.0f - 2.0f * __builtin_amdgcn_rcpf(e + 1.0f); return 0.5f * x * (1.0f + th); }
__device__ __forceinline__ void rg_load_raw(const bf16_t* PROJ, size_t rowb, int T0, int tg, int cb, int cc, u32x4 (&raw)[11]) {
    const bf16_t* base = PROJ + (rowb + T0 + 8 * tg) * CD_IN + PJ_RX + cb + 8 * cc;
#pragma unroll
    for (int i = 0; i < 11; ++i) { const int t = T0 + 8 * tg - 3 + i; if (t >= 0) raw[i] = *(const u32x4*)(base + (ptrdiff_t)(i - 3) * CD_IN); else raw[i] = (u32x4){0u, 0u, 0u, 0u}; }
}
__device__ __forceinline__ void phase_rg(const Params& p, LAS unsigned char* lds, int wave, int lane) {
    const unsigned char* ws = p.ws;
    const bf16_t* PROJ = (const bf16_t*)(ws + WS_PROJ); const bf16_t* WRG = (const bf16_t*)(ws + WS_WRG); bf16_t* O = (bf16_t*)(p.ws + WS_O);
    const int tid = threadIdx.x, h = lane >> 5, l31 = lane & 31;
    LAS float* GX = (LAS float*)(lds + RG_GX); LAS float* GA = (LAS float*)(lds + RG_GA); LAS float* HB = (LAS float*)(lds + RG_HB); LAS float* CW = (LAS float*)(lds + RG_CW); LAS float* SPL = (LAS float*)(lds + RG_SPL); LAS float* SA = (LAS float*)(lds + RG_SA); LAS float* SB = (LAS float*)(lds + RG_SB); LAS float* HS = (LAS float*)(lds + RG_HS); LAS float* HIN = (LAS float*)(lds + RG_HIN);
    const int cc = tid & 31, tg = tid >> 5;
    const int et = tid >> 2, ej = (tid & 3) * 8;
    for (int u0 = blockIdx.x; u0 < NB * 8 * 8; u0 += gridDim.x) {
        const int unit = xcd_swz(u0, NB * 8 * 8);
        const int b = unit >> 6, g = (unit >> 3) & 7, js = unit & 7, cb = 256 * g, c0 = cb + 32 * js;
        const size_t rowb = (size_t)b * SEQ;
        const int gate = wave >> 2, ti = wave & 3;
        bf16x8 wf[16];
        { const bf16_t* wp = WRG + ((size_t)(gate * 8 + g) * 256 + 32 * js + l31) * 256 + 8 * h;
#pragma unroll
          for (int s = 0; s < 16; ++s) wf[s] = *(const bf16x8*)(wp + 16 * s); }
        const float gbias = (gate ? p.rg_b_a : p.rg_b_x)[c0 + l31];
        for (int i = tid; i < 5 * 256; i += NTHR) { const int j = i >> 8, c = i & 255; CW[i] = j < 4 ? p.rg_conv_w[j * 2048 + cb + c] : p.rg_conv_b[cb + c]; }
        if (tid < 32) { const float lam = p.rg_lambda[c0 + tid]; SPL[tid] = -8.0f * LOG2E * (fmaxf(-lam, 0.f) + log1pf(expf(-fabsf(lam)))); }
        u32x4 raw[11];
        rg_load_raw(PROJ, rowb, 0, tg, cb, cc, raw);
        if (tid < 32) HS[tid] = 0.f;
        __syncthreads();
        for (int tt = 0; tt < SEQ / 128; ++tt) {
            const int T0 = 128 * tt; const size_t R0 = rowb + T0;
            const u32x4 ryraw = *(const u32x4*)(PROJ + (R0 + et) * CD_IN + PJ_RY + c0 + ej);
            { float w0[8], w1[8], w2[8], w3[8], bb[8];
#pragma unroll
              for (int q = 0; q < 2; ++q) { const f32x4 a0 = *(const LAS f32x4*)(CW + 0 * 256 + 8 * cc + 4 * q), a1 = *(const LAS f32x4*)(CW + 1 * 256 + 8 * cc + 4 * q), a2 = *(const LAS f32x4*)(CW + 2 * 256 + 8 * cc + 4 * q),
                                                          a3 = *(const LAS f32x4*)(CW + 3 * 256 + 8 * cc + 4 * q), a4 = *(const LAS f32x4*)(CW + 4 * 256 + 8 * cc + 4 * q);
#pragma unroll
                  for (int e = 0; e < 4; ++e) { w0[4 * q + e] = a0[e]; w1[4 * q + e] = a1[e]; w2[4 * q + e] = a2[e]; w3[4 * q + e] = a3[e]; bb[4 * q + e] = a4[e]; } }
#pragma unroll
              for (int i = 0; i < 8; ++i) { float xo[8];
#pragma unroll
                  for (int e2 = 0; e2 < 4; ++e2) { const unsigned r0 = raw[i][e2], r1 = raw[i + 1][e2], r2 = raw[i + 2][e2], r3 = raw[i + 3][e2];
                      f32x2 a2 = (f32x2){bb[2 * e2], bb[2 * e2 + 1]};
                      a2 = (f32x2){w0[2 * e2], w0[2 * e2 + 1]} * (f32x2){bflo(r0), bfhi(r0)} + a2; a2 = (f32x2){w1[2 * e2], w1[2 * e2 + 1]} * (f32x2){bflo(r1), bfhi(r1)} + a2;
                      a2 = (f32x2){w2[2 * e2], w2[2 * e2 + 1]} * (f32x2){bflo(r2), bfhi(r2)} + a2; a2 = (f32x2){w3[2 * e2], w3[2 * e2 + 1]} * (f32x2){bflo(r3), bfhi(r3)} + a2;
                      xo[2 * e2] = a2.x; xo[2 * e2 + 1] = a2.y; }
                  u32x4 o; o.x = cvt_pk_bf16(xo[0], xo[1]); o.y = cvt_pk_bf16(xo[2], xo[3]); o.z = cvt_pk_bf16(xo[4], xo[5]); o.w = cvt_pk_bf16(xo[6], xo[7]);
                  *(LAS u32x4*)(lds + RG_XC + (8 * tg + i) * RG_XPITCH + 16 * cc) = o; } }
            if (tt + 1 < SEQ / 128) rg_load_raw(PROJ, rowb, T0 + 128, tg, cb, cc, raw);
            LDS_BARRIER();
            { f32x16 acc; for (int i = 0; i < 16; ++i) acc[i] = 0.f;
              const LAS unsigned char* ap = lds + RG_XC + (32 * ti + l31) * RG_XPITCH + 16 * h;
#pragma unroll
              for (int s = 0; s < 16; ++s) { const bf16x8 a = *(const LAS bf16x8*)(ap + 32 * s); acc = MFMA32(a, wf[s], acc); }
              LAS float* gout = gate ? GA : GX;
#pragma unroll
              for (int r = 0; r < 16; ++r) { const float v = acc[r] + gbias; gout[(32 * ti + crow(r, h)) * 32 + l31] = __builtin_amdgcn_rcpf(1.0f + __expf(-v)); } }
            LDS_BARRIER();
            { const u32x4 xr = *(const LAS u32x4*)(lds + RG_XC + et * RG_XPITCH + 2 * (32 * js + ej));
              const float xc[8] = {bflo(xr.x), bfhi(xr.x), bflo(xr.y), bfhi(xr.y), bflo(xr.z), bfhi(xr.z), bflo(xr.w), bfhi(xr.w)};
#pragma unroll
              for (int q = 0; q < 2; ++q) { f32x4 ga = *(const LAS f32x4*)(GA + et * 32 + ej + 4 * q), gx = *(const LAS f32x4*)(GX + et * 32 + ej + 4 * q); const f32x4 sp = *(const LAS f32x4*)(SPL + ej + 4 * q);
#pragma unroll
                  for (int e = 0; e < 4; ++e) { const float a = __builtin_amdgcn_exp2f(ga[e] * sp[e]); const float mult = sqrtf(fmaxf(1.0f - a * a, 0.f)); ga[e] = a; gx[e] = mult * gx[e] * xc[4 * q + e]; }
                  *(LAS f32x4*)(GA + et * 32 + ej + 4 * q) = ga; *(LAS f32x4*)(GX + et * 32 + ej + 4 * q) = gx; } }
            LDS_BARRIER();
            { int tq = tid; asm volatile("" : "+v"(tq));
              const int sg = tq >> 5, sc = tq & 31; float A = 1.0f, Bv = 0.f;
              { float av[8], uv[8];
#pragma unroll
                for (int i = 0; i < 8; ++i) { av[i] = GA[(8 * sg + i) * 32 + sc]; uv[i] = GX[(8 * sg + i) * 32 + sc]; }
#pragma unroll
                for (int i = 0; i < 8; ++i) { Bv = av[i] * Bv + uv[i]; A *= av[i]; } }
              SA[sg * 32 + sc] = A; SB[sg * 32 + sc] = Bv;
              LDS_BARRIER();
              if (tq < 32) {
                  float ga[16], gb[16]; float hc = HS[(tt & 1) * 32 + tq];
#pragma unroll
                  for (int gg = 0; gg < 16; ++gg) { ga[gg] = SA[gg * 32 + tq]; gb[gg] = SB[gg * 32 + tq]; }
#pragma unroll
                  for (int gg = 0; gg < 16; ++gg) { const float t = hc; hc = ga[gg] * hc + gb[gg]; ga[gg] = t; }
#pragma unroll
                  for (int gg = 0; gg < 16; ++gg) HIN[gg * 32 + tq] = ga[gg];
                  HS[((tt + 1) & 1) * 32 + tq] = hc; }
              LDS_BARRIER();
              float hin = HIN[sg * 32 + sc];
              { float av[8], uv[8];
#pragma unroll
                for (int i = 0; i < 8; ++i) { av[i] = GA[(8 * sg + i) * 32 + sc]; uv[i] = GX[(8 * sg + i) * 32 + sc]; }
#pragma unroll
                for (int i = 0; i < 8; ++i) { hin = av[i] * hin + uv[i]; av[i] = hin; }
#pragma unroll
                for (int i = 0; i < 8; ++i) HB[(8 * sg + i) * 32 + sc] = av[i]; }
            }
            LDS_BARRIER();
            { const float ry[8] = {bflo(ryraw.x), bfhi(ryraw.x), bflo(ryraw.y), bfhi(ryraw.y), bflo(ryraw.z), bfhi(ryraw.z), bflo(ryraw.w), bfhi(ryraw.w)};
              const f32x4 h0 = *(const LAS f32x4*)(HB + et * 32 + ej), h1 = *(const LAS f32x4*)(HB + et * 32 + ej + 4);
              u32x4 o; o.x = cvt_pk_bf16(h0.x * gelu_tanh(ry[0]), h0.y * gelu_tanh(ry[1])); o.y = cvt_pk_bf16(h0.z * gelu_tanh(ry[2]), h0.w * gelu_tanh(ry[3]));
              o.z = cvt_pk_bf16(h1.x * gelu_tanh(ry[4]), h1.y * gelu_tanh(ry[5])); o.w = cvt_pk_bf16(h1.z * gelu_tanh(ry[6]), h1.w * gelu_tanh(ry[7]));
              *(u32x4*)(O + (R0 + et) * DM + c0 + ej) = o; }
        }
        __syncthreads();
    }
}

#ifndef REP_P0
#define REP_P0 1
#endif
#ifndef REP_GEMM
#define REP_GEMM 1
#endif
#ifndef REP_MIX0
#define REP_MIX0 1
#endif
#ifndef REP_MIX1
#define REP_MIX1 1
#endif
#ifndef REP_RES
#define REP_RES 1
#endif
#ifndef REP_RMS
#define REP_RMS 1
#endif
#ifndef MK_N_LAUNCHES
#define MK_N_LAUNCHES 1
#endif
constexpr int N_PHASES = 16;
struct Args { Params p; int li, pad; };

__device__ __forceinline__ void attn_phase_fox(const Params& p, LAS unsigned char* lds, int wave, int lane) {
    const bf16_t* PROJ = (const bf16_t*)(p.ws + WS_PROJ);
    const AttnIO io{PROJ + PJ_FQ, PROJ + PJ_FK, PROJ + PJ_FV, AB_MAIN, (bf16_t*)(p.ws + WS_O) + 2048, DM};
    const float* CF = (const float*)(p.ws + WS_CF);
    for (int p0 = blockIdx.x; p0 < 256; p0 += gridDim.x) { const int pr = xcd_swz(p0, 256), b = pr >> 6, hd = (pr >> 2) & 15, x = pr & 3;
        fox_unit(io, CF, lds, b, hd, 7 - x, wave, lane);
        fox_unit(io, CF, lds, b, hd, x, wave, lane); }
}
__device__ __forceinline__ void attn_phase_sb(const Params& p, LAS unsigned char* lds, int wave, int lane) {
    const bf16_t* PROJ = (const bf16_t*)(p.ws + WS_PROJ);
    const AttnIO io{PROJ + PJ_SQ, PROJ + PJ_SK, PROJ + PJ_SV, CD_IN, (bf16_t*)(p.ws + WS_O) + 2048, DM};
    for (int p0 = blockIdx.x; p0 < 256; p0 += gridDim.x) { const int pr = xcd_swz(p0, 256), b = pr >> 6, hd = (pr >> 2) & 15, x = pr & 3;
        sb_unit(io, lds, b, hd, 7 - x, wave, lane);
        sb_unit(io, lds, b, hd, x, wave, lane); }
}

template <int layer>
__device__ __forceinline__ void layer_phases(const Params& p, LAS unsigned char* lds, const XcdBarrier& bar, int lo, int hi, int G, int gw, int ngw, int wave, int lane) {
    unsigned char* ws = p.ws;
    bf16_t* U = (bf16_t*)(ws + WS_U); bf16_t* PROJ = (bf16_t*)(ws + WS_PROJ); bf16_t* O = (bf16_t*)(ws + WS_O); bf16_t* ACT = (bf16_t*)(ws + WS_ACT); pg8::ssq_t* SSQ = (pg8::ssq_t*)((unsigned*)(ws + WS_CTL) + CW_SSQ);
#define IN(k) (lo <= (k) && (k) < hi)
#ifdef PROBE_SEL
#define SEAM(k) do { if ((k) + 1 < hi) { unsigned long long t0_ = 0; if (threadIdx.x == 0) { t0_ = __builtin_amdgcn_s_memrealtime(); if (blockIdx.x == 0) ((unsigned long long*)(p.ws + WS_CTL + 786432))[2 * (k) + 1] = t0_; } \
    xcd_barrier(bar); if (threadIdx.x == 0) { const unsigned long long t1_ = __builtin_amdgcn_s_memrealtime(); atomicAdd((unsigned*)(p.ws + WS_CTL + 790528) + (k), (unsigned)(t1_ - t0_)); if (blockIdx.x == 0) ((unsigned long long*)(p.ws + WS_CTL + 786432))[2 * (k) + 2] = t1_; } } } while (0)
#else
#define SEAM(k) do { if ((k) + 1 < hi) xcd_barrier(bar); } while (0)
#endif
        constexpr int kb = 1 + 7 * layer;
        if (IN(kb)) {
            if (layer == 0) {
                constexpr int NG = 192;
                pg8::Gemm g{U, (const bf16_t*)(ws + WS_WAB_IN), MTOK, AB_MAIN, DM}; pg8::EpiBf16<false> E{PROJ, AB_MAIN, nullptr};
                if (G == 256) {
                    if ((int)blockIdx.x < NG) { pg8::StaticOrder S; S.init(MTOK, AB_MAIN, NG, (int)blockIdx.x); pg8::gemm_phase<pg8::EpiBf16<false>, pg8::StaticOrder, true, true>(lds, g, S, E); }
                    else p0b_convert(p, lds, ((int)blockIdx.x - NG) * NWAVES + wave, (G - NG) * NWAVES, wave, lane);
                } else {
                    p0b_convert(p, lds, gw, ngw, wave, lane); __syncthreads();
                    pg8::StaticOrder S; S.init(MTOK, AB_MAIN, G, (int)blockIdx.x); pg8::gemm_phase<pg8::EpiBf16<false>, pg8::StaticOrder, true, true>(lds, g, S, E);
                }
                __syncthreads();
                phase_small32(p, lds, wave, lane);
            } else {
                pg8::Gemm g{U, (const bf16_t*)(ws + WS_WCD_IN), MTOK, CD_IN, DM}; pg8::StaticOrder S; S.init(MTOK, CD_IN, G, (int)blockIdx.x);
                pg8::EpiBf16<true> E{PROJ, CD_IN, SSQ + 1 * MTOK};
                for (int rep = 0; rep < REP_GEMM; ++rep) { pg8::gemm_phase<pg8::EpiBf16<true>, pg8::StaticOrder, true, true>(lds, g, S, E); __syncthreads(); }
            }
            SEAM(kb);
        }
        if (layer == 0 && IN(kb + 1)) { for (int rep = 0; rep < (REP_MIX0 == 5 ? 2 : 1); ++rep) { phase_fox_cumsum(p, lds, wave, lane); phase_gla_pre(p, lds, wave, lane); } SEAM(kb + 1); }
        if (IN(kb + 2)) {
            if (layer == 0) { phase_gla_seq(p, lds, wave, lane); __syncthreads();
#ifdef PROBE_SEL
                if (blockIdx.x == 0 && threadIdx.x == 0) ((unsigned long long*)(p.ws + WS_CTL + 786432))[41] = __builtin_amdgcn_s_memrealtime();
#endif
                attn_phase_fox(p, lds, wave, lane); __syncthreads();
#if REP_MIX0 == 3
 attn_phase_fox(p, lds, wave, lane); __syncthreads();
#endif
#if REP_MIX0 == 4
 phase_gla_seq(p, lds, wave, lane); __syncthreads();
#endif
 }
            else { phase_rg(p, lds, wave, lane); __syncthreads();
#ifdef PROBE_SEL
                if (blockIdx.x == 0 && threadIdx.x == 0) ((unsigned long long*)(p.ws + WS_CTL + 786432))[40] = __builtin_amdgcn_s_memrealtime();
#endif
                attn_phase_sb(p, lds, wave, lane); __syncthreads();
#if REP_MIX1 == 2
 phase_rg(p, lds, wave, lane); __syncthreads(); attn_phase_sb(p, lds, wave, lane); __syncthreads();
#endif
#if REP_MIX1 == 3
 phase_rg(p, lds, wave, lane); __syncthreads();
#endif
 }
            SEAM(kb + 2);
        }
        if (layer == 0 && IN(kb + 3)) { for (int rep = 0; rep < (REP_MIX0 == 6 ? 2 : 1); ++rep) phase_gla_post(p, gw, ngw, lane); SEAM(kb + 3); }
        if (IN(kb + 4)) {
            pg8::Gemm g{O, (const bf16_t*)(ws + (layer ? WS_WCD_OUT : WS_WAB_OUT)), MTOK, DM, DM}; pg8::StaticOrder S; S.init(MTOK, DM, G, (int)blockIdx.x);
#if REP_RES == 2
            { pg8::EpiRes<false> E{U, (bf16_t*)(ws + WS_ORAW), DM, (pg8::ssq_t*)(ws + WS_SSQ)}; pg8::gemm_phase<pg8::EpiRes<false>, pg8::StaticOrder, true, true>(lds, g, S, E); __syncthreads(); }
#endif
            if (layer == 0) { pg8::EpiRes<true> E{p.x, U, DM, SSQ + (2 * layer) * MTOK}; pg8::gemm_phase<pg8::EpiRes<true>, pg8::StaticOrder, true, true>(lds, g, S, E); }
            else { pg8::EpiRes<false> E{U, U, DM, SSQ + (2 * layer) * MTOK}; pg8::gemm_phase<pg8::EpiRes<false>, pg8::StaticOrder, true, true>(lds, g, S, E); }
            SEAM(kb + 4);
        }
        if (IN(kb + 5)) {
            pg8::Gemm g{U, (const bf16_t*)(ws + (layer ? WS_WGU1 : WS_WGU0)), MTOK, 2 * DFF, DM}; pg8::StaticOrder S; S.init(MTOK, 2 * DFF, G, (int)blockIdx.x);
            pg8::EpiSwiGLU E{ACT, DFF, SSQ + (2 * layer) * MTOK};
            for (int rep = 0; rep < REP_GEMM; ++rep) { pg8::gemm_phase<pg8::EpiSwiGLU, pg8::StaticOrder, true, true>(lds, g, S, E); __syncthreads(); }
            if (layer == 0) { const int rem = (MTOK / 256) * (2 * DFF / 256) % G, c = (int)blockIdx.x;
                if (rem == 0) tail_convert(p, lds, c * NWAVES + wave, G * NWAVES, wave, lane); else if (c >= rem) tail_convert(p, lds, (c - rem) * NWAVES + wave, (G - rem) * NWAVES, wave, lane); }
            else { const int rem = (MTOK / 256) * (2 * DFF / 256) % G, c = (int)blockIdx.x;
                if (rem == 0) tail1_convert(p, lds, c * NWAVES + wave, G * NWAVES, wave, lane); else if (c >= rem) tail1_convert(p, lds, (c - rem) * NWAVES + wave, (G - rem) * NWAVES, wave, lane); }
            SEAM(kb + 5);
        }
        if (IN(kb + 6)) {
            pg8::Gemm g{ACT, (const bf16_t*)(ws + (layer ? WS_WDN1 : WS_WDN0)), MTOK, DM, DFF}; pg8::StaticOrder S; S.init(MTOK, DM, G, (int)blockIdx.x);
#if REP_RES == 2
            { pg8::EpiRes<false> E{U, (bf16_t*)(ws + WS_ORAW), DM, (pg8::ssq_t*)(ws + WS_SSQ)}; pg8::gemm_phase<pg8::EpiRes<false>, pg8::StaticOrder, true, true>(lds, g, S, E); __syncthreads(); }
#endif
            pg8::EpiRes<false> E{U, U, DM, SSQ + (2 * layer + 1) * MTOK};
            pg8::gemm_phase<pg8::EpiRes<false>, pg8::StaticOrder, true, true>(lds, g, S, E);
            SEAM(kb + 6);
        }
#undef IN
#undef SEAM
}

__global__ void __launch_bounds__(NTHR, 2) hybrid_fwd(Args args) {
    extern __shared__ __attribute__((aligned(16))) unsigned char lds_raw[];
    LAS unsigned char* lds = (LAS unsigned char*)lds_raw;
    const Params& p = args.p;
    const int tid = threadIdx.x, lane = tid & 63, wave = __builtin_amdgcn_readfirstlane(tid >> 6);
    const int G = gridDim.x, gw = blockIdx.x * NWAVES + wave, ngw = G * NWAVES;
    for (int u = tid; u < (LDS_BYTES - LDSCTL_OFF) / 4; u += NTHR) ((LAS unsigned*)(lds + LDSCTL_OFF))[u] = 0u;
    __syncthreads();
    unsigned* ctl = (unsigned*)(p.ws + WS_CTL);
    XcdBarrier bar = xcd_barrier_post(ctl + CW_BAR + args.li * XCD_BAR_WORDS, (volatile LAS unsigned*)(lds + MISC_OFF) + 8);
    const int lo = p.ph_lo, hi = p.ph_hi;
#define IN(k) (lo <= (k) && (k) < hi)
#ifdef PROBE_SEL
#define SEAM(k) do { if ((k) + 1 < hi) { unsigned long long t0_ = 0; if (threadIdx.x == 0) { t0_ = __builtin_amdgcn_s_memrealtime(); if (blockIdx.x == 0) ((unsigned long long*)(p.ws + WS_CTL + 786432))[2 * (k) + 1] = t0_; } \
    xcd_barrier(bar); if (threadIdx.x == 0) { const unsigned long long t1_ = __builtin_amdgcn_s_memrealtime(); atomicAdd((unsigned*)(p.ws + WS_CTL + 790528) + (k), (unsigned)(t1_ - t0_)); if (blockIdx.x == 0) ((unsigned long long*)(p.ws + WS_CTL + 786432))[2 * (k) + 2] = t1_; } } } while (0)
#else
#define SEAM(k) do { if ((k) + 1 < hi) xcd_barrier(bar); } while (0)
#endif
    if (IN(0)) { for (int rep = 0; rep < REP_P0; ++rep) { phase_p0(p, lds, gw, ngw, wave, lane); __syncthreads(); } SEAM(0); }

    layer_phases<0>(p, lds, bar, lo, hi, G, gw, ngw, wave, lane);
    layer_phases<1>(p, lds, bar, lo, hi, G, gw, ngw, wave, lane);
#ifdef PROBE_SEL
    float probe_eps = 0.f;
    if (IN(15)) { const unsigned long long* ts = (const unsigned long long*)(p.ws + WS_CTL + 786432); const unsigned* wsum = (const unsigned*)(p.ws + WS_CTL + 790528); float val_us;
        if (PROBE_SEL < 100) val_us = (float)wsum[PROBE_SEL] * (0.01f / 256.0f);
        else if (PROBE_SEL == 100) { unsigned s = 0; for (int i = 0; i < 15; ++i) s += wsum[i]; val_us = (float)s * (0.01f / 256.0f); }
        else if (PROBE_SEL == 101) { const unsigned s = wsum[1] + wsum[5] + wsum[6] + wsum[7] + wsum[8] + wsum[12] + wsum[13] + wsum[14]; val_us = (float)s * (0.01f / 256.0f); }
        else if (PROBE_SEL == 400) val_us = (float)(ts[40] - ts[18]) * 0.01f;
        else if (PROBE_SEL == 401) val_us = (float)(ts[41] - ts[6]) * 0.01f;
        else if (PROBE_SEL >= 300) val_us = (float)(ts[2 * (PROBE_SEL - 300) + 2] - ts[2 * (PROBE_SEL - 300) + 1]) * 0.01f;
        else { unsigned long long st = ts[2 * (PROBE_SEL - 200)]; if (st == 0ull) st = ts[2 * (PROBE_SEL - 200) - 2]; val_us = (float)(ts[2 * (PROBE_SEL - 200) + 1] - st) * 0.01f; }
        probe_eps = sqrtf(val_us * PROBE_SCALE); }
#define FINAL_SCALE (1.0f + probe_eps)
#else
#define FINAL_SCALE 1.0f
#endif
    if (IN(15)) phase_final_norm((const bf16_t*)(p.ws + WS_U), (const unsigned long long*)((const unsigned*)(p.ws + WS_CTL) + CW_SSQ) + 3 * MTOK, p.final_norm, p.out, gw, ngw, lane, FINAL_SCALE);
#undef IN
#undef SEAM
}

extern "C" void kernel_launch(void* const* d_in, const int* in_sizes, int n_in, void* d_out, int out_size, void* d_ws, size_t ws_size, hipStream_t stream) {
    static int grid = 0;
    if (grid == 0) {
        if (n_in != 22 || in_sizes[0] != MTOK * DM || out_size != MTOK * DM || ws_size < WS_END) {
            fprintf(stderr, "kernel_launch: unexpected problem (n_in %d, in0 %d, out %d, ws %zu, need %zu); nothing launched\n", n_in, n_in > 0 ? in_sizes[0] : -1, out_size, ws_size, (size_t)WS_END); grid = -1; return; }
        int dev = 0, cus = 0, per_cu = 0;
        if (hipGetDevice(&dev) != hipSuccess || hipDeviceGetAttribute(&cus, hipDeviceAttributeMultiprocessorCount, dev) != hipSuccess) { fprintf(stderr, "kernel_launch: device query failed\n"); grid = -1; return; }
        if (hipFuncSetAttribute((const void*)hybrid_fwd, hipFuncAttributeMaxDynamicSharedMemorySize, LDS_BYTES) != hipSuccess) { fprintf(stderr, "kernel_launch: hipFuncSetAttribute failed\n"); grid = -1; return; }
        if (hipOccupancyMaxActiveBlocksPerMultiprocessor(&per_cu, (const void*)hybrid_fwd, NTHR, LDS_BYTES) != hipSuccess || per_cu < 1) {
            fprintf(stderr, "kernel_launch: occupancy query reports %d workgroups per CU; nothing launched\n", per_cu); (void)hipGetLastError(); grid = -1; return; }
        grid = cus;
    }
    if (grid < 0) return;
    if (hipMemsetAsync((char*)d_ws + WS_CTL, 0, CTL_ZERO_BYTES, stream) != hipSuccess) { fprintf(stderr, "kernel_launch: memset failed\n"); return; }
    Args a{};
    const float** pp = (const float**)&a.p;
    for (int i = 0; i < 22; ++i) pp[i] = (const float*)d_in[i];
    a.p.out = (float*)d_out; a.p.ws = (unsigned char*)d_ws;
#if MK_N_LAUNCHES == 1
    a.p.ph_lo = 0; a.p.ph_hi = N_PHASES; a.li = 0; a.pad = 0;
    hipLaunchKernelGGL(hybrid_fwd, dim3(grid), dim3(NTHR), LDS_BYTES, stream, a);
    { const hipError_t le = hipPeekAtLastError(); if (le != hipSuccess) fprintf(stderr, "kernel_launch: launch failed: %s\n", hipGetErrorName(le)); }
#else
    for (int k = 0; k < N_PHASES; ++k) { a.p.ph_lo = k; a.p.ph_hi = k + 1; a.li = k; a.pad = 0;
        hipLaunchKernelGGL(hybrid_fwd, dim3(grid), dim3(NTHR), LDS_BYTES, stream, a);
        const hipError_t le = hipPeekAtLastError(); if (le != hipSuccess) { fprintf(stderr, "kernel_launch: launch %d failed: %s\n", k, hipGetErrorName(le)); break; } }
#endif
}
```

```cpp
#include <hip/hip_runtime.h>
#include <cstdio>
#include <cstdint>

#define LAS __attribute__((address_space(3)))
#define GAS __attribute__((address_space(1)))
typedef unsigned short bf16_t;
typedef short bf16x8 __attribute__((ext_vector_type(8)));
typedef short s16x4 __attribute__((ext_vector_type(4)));
typedef float f32x4 __attribute__((ext_vector_type(4)));
typedef float f32x2 __attribute__((ext_vector_type(2)));
typedef float f32x16 __attribute__((ext_vector_type(16)));
typedef unsigned u32x4 __attribute__((ext_vector_type(4)));
typedef unsigned u32x2 __attribute__((ext_vector_type(2)));

constexpr int DM = 4096, NB = 4, SEQ = 2048, MTOK = NB * SEQ;
constexpr int DFF = 11008;
constexpr int AB_MAIN = 12288;
constexpr int AB_IN = 12320, CD_IN = 10240;
constexpr int PJ_GQ = 0, PJ_GK = 1024, PJ_GV = 2048, PJ_GG = 4096, PJ_FQ = 6144, PJ_FK = 8192, PJ_FV = 10240;
constexpr int PJ_RY = 0, PJ_RX = 2048, PJ_SQ = 4096, PJ_SK = 6144, PJ_SV = 8192;
constexpr float EPS = 1e-6f, LOG2E_F = 1.4426950408889634f;

__device__ __forceinline__ unsigned cvt_pk_bf16(float lo, float hi) { unsigned r; asm volatile("v_cvt_pk_bf16_f32 %0, %1, %2" : "=v"(r) : "v"(lo), "v"(hi)); return r; }
__device__ __forceinline__ float bf2f(bf16_t v) { return __uint_as_float(((unsigned)v) << 16); }
__device__ __forceinline__ float bflo(unsigned w) { return __uint_as_float(w << 16); }
__device__ __forceinline__ float bfhi(unsigned w) { return __uint_as_float(w & 0xffff0000u); }
__device__ __forceinline__ bf16_t f2bf(float f) { return (bf16_t)(cvt_pk_bf16(f, 0.f) & 0xffffu); }
__device__ __forceinline__ int crow(int r, int hi) { return (r & 3) + 8 * (r >> 2) + 4 * hi; }
__device__ __forceinline__ bf16x8 pack8(float a0, float a1, float a2, float a3, float a4, float a5, float a6, float a7) {
    u32x4 w = {cvt_pk_bf16(a0, a1), cvt_pk_bf16(a2, a3), cvt_pk_bf16(a4, a5), cvt_pk_bf16(a6, a7)}; return __builtin_bit_cast(bf16x8, w); }
__device__ __forceinline__ float wave_sum(float v) {
#pragma unroll
    for (int o = 1; o < 64; o <<= 1) v += __shfl_xor(v, o);
    return v; }
__device__ __forceinline__ float log_sigmoid_acc(float x) { return fminf(x, 0.f) - log1pf(expf(-fabsf(x))); }
__device__ __forceinline__ float log_sigmoid_fast(float x) { return fminf(x, 0.f) - __logf(1.0f + __expf(-fabsf(x))); }
#define LDS_WAIT() asm volatile("s_waitcnt lgkmcnt(0)" ::: "memory")
#define VM_WAIT() asm volatile("s_waitcnt vmcnt(0)" ::: "memory")
#define LDS_BARRIER() do { asm volatile("s_waitcnt lgkmcnt(0)" ::: "memory"); __builtin_amdgcn_s_barrier(); asm volatile("" ::: "memory"); } while (0)
#define MFMA32(a, b, c) __builtin_amdgcn_mfma_f32_32x32x16_bf16((a), (b), (c), 0, 0, 0)
__device__ __forceinline__ int xcd_swz(int i, int n) { return (n % 8 == 0) ? (i & 7) * (n / 8) + (i >> 3) : i; }
typedef LAS const char* lds_cptr;
__device__ __forceinline__ s16x4 vtr(lds_cptr p) { return __builtin_bit_cast(s16x4, __builtin_amdgcn_ds_read_tr16_b64_v4i16((LAS s16x4*)p)); }
__device__ __forceinline__ bf16x8 cat4(s16x4 lo, s16x4 hi) { bf16x8 r; r[0] = lo[0]; r[1] = lo[1]; r[2] = lo[2]; r[3] = lo[3]; r[4] = hi[0]; r[5] = hi[1]; r[6] = hi[2]; r[7] = hi[3]; return r; }

namespace pg8 {
#define PG8_LAS __attribute__((address_space(3)))
typedef unsigned short bf16_t;
typedef short bf16x8 __attribute__((ext_vector_type(8)));
typedef float f32x4 __attribute__((ext_vector_type(4)));
typedef unsigned u32x4 __attribute__((ext_vector_type(4)));
typedef double d64x2 __attribute__((ext_vector_type(2)));
constexpr int BM = 256, BK = 64, HALF = 128, HTB = HALF * BK * 2  , STAGE_BYTES = 8 * HTB, NXCD = 8, WGM = 8;

__host__ __device__ __forceinline__ int lds_byte(int r, int c) { const int st = (r >> 4) * 2 + (c >> 5), rr = r & 15, cc = c & 31, ob = rr * 64 + cc * 2; return st * 1024 + (ob ^ (((ob >> 9) & 1) << 5)); }
__host__ __device__ __forceinline__ void stage_rc(int b, int& R, int& C) { const int st = b / 1024, sb = b % 1024, swz = sb ^ (((sb >> 9) & 1) << 5); R = (st >> 1) * 16 + swz / 64; C = (st & 1) * 32 + (swz % 64) / 2; }
__host__ __device__ __forceinline__ int perm32(int rho) { const int n = rho >> 4, i = rho & 15; return 8 * (i >> 2) + 4 * n + (i & 3); }

struct Unit { int pm, pn; };
struct Gemm { const bf16_t* A; const bf16_t* Bt; int M, N, K; };

struct StaticOrder {
    int nM, nN, nwg, G, c;
    __host__ __device__ void init(int M, int N, int G_, int c_) { nM = M / BM; nN = N / BM; nwg = nM * nN; G = G_; c = c_; }
    __host__ __device__ bool next(int i, Unit& u) const {
        const long L = (long)i * G + c; if (L >= nwg) return false;
        int wgid = (int)L; { const int q = nwg / NXCD, r = nwg % NXCD, xcd = wgid % NXCD, off = wgid / NXCD; wgid = (xcd < r ? xcd * (q + 1) : r * (q + 1) + (xcd - r) * q) + off; }
        const int nig = WGM * nN, gid = wgid / nig, fm = gid * WGM, gsz = (nM - fm) < WGM ? (nM - fm) : WGM;
        u.pm = fm + ((wgid % nig) % gsz); u.pn = (wgid % nig) / gsz; return true;
    }
    __device__ __forceinline__ void a_ready(const Unit&) const {}
    __device__ __forceinline__ void done(const Unit&) const {}
};
__device__ __forceinline__ unsigned cvt_pk_bf16(float lo, float hi) { unsigned r; asm volatile("v_cvt_pk_bf16_f32 %0, %1, %2" : "=v"(r) : "v"(lo), "v"(hi)); return r; }
constexpr float RMS_EPS = 1e-6f, RMS_INV_D = 1.0f / 4096.0f, SSQ_FIX = 16777216.0f, SSQ_UNFIX = 1.0f / 16777216.0f;
typedef unsigned long long ssq_t;
__device__ __forceinline__ float ssq_rstd(const ssq_t* ssq, int row) { return __builtin_amdgcn_rsqf((float)ssq[row] * (SSQ_UNFIX * RMS_INV_D) + RMS_EPS); }

template <bool SCALE> struct EpiBf16 {
    static constexpr bool PERM = true, AFTER_DRAIN = false;
    bf16_t* O; int ldc; const ssq_t* ssq;
    __device__ __forceinline__ void operator()(const f32x4 (&acc)[2][2][4][2], const Unit& u, int wr, int wc, int fr, int fq) const {
        const int row0 = u.pm * BM + wr * 64 + fr, col0 = u.pn * BM + wc * 32 + 8 * fq;
        float rs[2][4];
#pragma unroll
        for (int ai = 0; ai < 2; ++ai)
#pragma unroll
            for (int m = 0; m < 4; ++m) rs[ai][m] = SCALE ? ssq_rstd(ssq, row0 + ai * HALF + m * 16) : 1.0f;
#pragma unroll
        for (int ai = 0; ai < 2; ++ai)
#pragma unroll
            for (int m = 0; m < 4; ++m) { const int row = row0 + ai * HALF + m * 16; bf16_t* rowp = O + (size_t)row * ldc + col0;
#pragma unroll
                for (int bj = 0; bj < 2; ++bj) { const f32x2 r2 = {rs[ai][m], rs[ai][m]}; const f32x4 a0 = acc[ai][bj][m][0], a1 = acc[ai][bj][m][1];
                    const f32x2 p0 = (f32x2){a0[0], a0[1]} * r2, p1 = (f32x2){a0[2], a0[3]} * r2, p2 = (f32x2){a1[0], a1[1]} * r2, p3 = (f32x2){a1[2], a1[3]} * r2;
                    u32x4 w; w.x = cvt_pk_bf16(p0.x, p0.y); w.y = cvt_pk_bf16(p1.x, p1.y); w.z = cvt_pk_bf16(p2.x, p2.y); w.w = cvt_pk_bf16(p3.x, p3.y);
                    *(u32x4*)(rowp + bj * HALF) = w; } }
    }
};
template <bool BASE_F32> struct EpiRes {
    static constexpr bool PERM = true, AFTER_DRAIN = false;
    const void* base; bf16_t* out; int ldc; ssq_t* ssq;
    __device__ __forceinline__ void operator()(const f32x4 (&acc)[2][2][4][2], const Unit& u, int wr, int wc, int fr, int fq) const {
        const int row0 = u.pm * BM + wr * 64 + fr, col0 = u.pn * BM + wc * 32 + 8 * fq;
#pragma unroll
        for (int ai = 0; ai < 2; ++ai) {
            f32x4 b0[4][2], b1[4][2];
#pragma unroll
            for (int m = 0; m < 4; ++m)
#pragma unroll
                for (int bj = 0; bj < 2; ++bj) { const size_t off = (size_t)(row0 + ai * HALF + m * 16) * ldc + col0 + bj * HALF;
                    if (BASE_F32) { const float* bp = (const float*)base + off; b0[m][bj] = *(const f32x4*)bp; b1[m][bj] = *(const f32x4*)(bp + 4); }
                    else { const u32x4 r = *(const u32x4*)((const bf16_t*)base + off);
                        b0[m][bj] = (f32x4){__uint_as_float(r.x << 16), __uint_as_float(r.x & 0xffff0000u), __uint_as_float(r.y << 16), __uint_as_float(r.y & 0xffff0000u)};
                        b1[m][bj] = (f32x4){__uint_as_float(r.z << 16), __uint_as_float(r.z & 0xffff0000u), __uint_as_float(r.w << 16), __uint_as_float(r.w & 0xffff0000u)}; } }
#pragma unroll
            for (int m = 0; m < 4; ++m) { const int row = row0 + ai * HALF + m * 16; const size_t off = (size_t)row * ldc + col0; f32x2 q2 = {0.f, 0.f};
#pragma unroll
                for (int bj = 0; bj < 2; ++bj) { const f32x4 v0 = acc[ai][bj][m][0] + b0[m][bj], v1 = acc[ai][bj][m][1] + b1[m][bj];
                    { const f32x2 e0 = {v0[0], v0[1]}, e1 = {v0[2], v0[3]}, e2 = {v1[0], v1[1]}, e3 = {v1[2], v1[3]}; q2 = e0 * e0 + q2; q2 = e1 * e1 + q2; q2 = e2 * e2 + q2; q2 = e3 * e3 + q2; }
                    u32x4 w; w.x = cvt_pk_bf16(v0[0], v0[1]); w.y = cvt_pk_bf16(v0[2], v0[3]); w.z = cvt_pk_bf16(v1[0], v1[1]); w.w = cvt_pk_bf16(v1[2], v1[3]);
                    *(u32x4*)(out + off + bj * HALF) = w; }
                float q = q2.x + q2.y; q += __shfl_xor(q, 16); q += __shfl_xor(q, 32);
                if (fq == 0) atomicAdd(ssq + row, (ssq_t)(q * SSQ_FIX + 0.5f)); }
        }
    }
};
struct EpiSwiGLU {
    static constexpr bool PERM = true, AFTER_DRAIN = false;
    bf16_t* O; int ldc; const ssq_t* ssq;
    __device__ __forceinline__ void operator()(const f32x4 (&acc)[2][2][4][2], const Unit& u, int wr, int wc, int fr, int fq) const {
        const int row0 = u.pm * BM + wr * 64 + fr, col0 = u.pn * HALF + wc * 32 + 8 * fq;
        float rs[2][4];
#pragma unroll
        for (int ai = 0; ai < 2; ++ai)
#pragma unroll
            for (int m = 0; m < 4; ++m) rs[ai][m] = ssq_rstd(ssq, row0 + ai * HALF + m * 16);
#pragma unroll
        for (int ai = 0; ai < 2; ++ai)
#pragma unroll
            for (int m = 0; m < 4; ++m) { const int row = row0 + ai * HALF + m * 16; bf16_t* rowp = O + (size_t)row * ldc + col0; float a[8];
#pragma unroll
                for (int n = 0; n < 2; ++n)
#pragma unroll
                    for (int i = 0; i < 4; i += 2) {
                        const f32x2 r2 = {rs[ai][m], rs[ai][m]};
                        const f32x2 g = (f32x2){acc[ai][0][m][n][i], acc[ai][0][m][n][i + 1]} * r2, up = (f32x2){acc[ai][1][m][n][i], acc[ai][1][m][n][i + 1]} * r2;
                        const f32x2 t = g * (f32x2){-1.4426950408889634f, -1.4426950408889634f};
                        const f32x2 d = (f32x2){__builtin_amdgcn_exp2f(t.x), __builtin_amdgcn_exp2f(t.y)} + (f32x2){1.0f, 1.0f};
                        const f32x2 o2 = (g * up) * (f32x2){__builtin_amdgcn_rcpf(d.x), __builtin_amdgcn_rcpf(d.y)};
                        a[4 * n + i] = o2.x; a[4 * n + i + 1] = o2.y; }
                u32x4 w; w.x = cvt_pk_bf16(a[0], a[1]); w.y = cvt_pk_bf16(a[2], a[3]); w.z = cvt_pk_bf16(a[4], a[5]); w.w = cvt_pk_bf16(a[6], a[7]);
                *(u32x4*)rowp = w; }
    }
};

template <class Epi, class Sched, bool ALIGN_EPI = false, bool SP2 = false>
__device__ __forceinline__ void gemm_phase(PG8_LAS unsigned char* lds, const Gemm g, const Sched& S, const Epi& E) {
    const int tid = threadIdx.x, wid = __builtin_amdgcn_readfirstlane(tid >> 6), lane = tid & 63, wr = wid >> 2, wc = wid & 3, fr = lane & 15, fq = lane >> 4;
    const int K = g.K, nt = K / BK;
    unsigned voffA[2], voffB[2];
#pragma unroll
    for (int i = 0; i < 2; ++i) { int R, C; stage_rc(tid * 16 + i * 8192, R, C); const int Rb = Epi::PERM ? ((R & ~31) + perm32(R & 31)) : R;
        voffA[i] = (unsigned)(R * K + C) * 2u; voffB[i] = (unsigned)(Rb * K + C) * 2u; }
    const size_t kstep = (size_t)(BK * 2);
    const size_t hstep = (size_t)HALF * K * 2;
    const size_t tstep = 2 * hstep;
    const unsigned ldsw = (unsigned)wid * 1024u;
    const int aoff = lds_byte(wr * 64 + fr, fq * 8), boff = lds_byte(wc * 32 + fr, fq * 8);
#define PG8_SA(b, h) (((b) * 2 + (h)) * HTB)
#define PG8_SB(b, h) ((4 + (b) * 2 + (h)) * HTB)
#define PG8_STAGE(bufoff, gbase, voff) do { _Pragma("unroll") for (int _i = 0; _i < 2; ++_i) \
        __builtin_amdgcn_global_load_lds((const unsigned*)((const char*)(gbase) + (voff)[_i]), (PG8_LAS unsigned*)(lds + (bufoff) + ldsw + _i * 8192), 16, 0, 0); } while (0)
#define PG8_LDA(dst, b, h) do { _Pragma("unroll") for (int m = 0; m < 4; ++m) _Pragma("unroll") for (int k = 0; k < 2; ++k) dst[m][k] = *(const PG8_LAS bf16x8*)(lds + PG8_SA(b, h) + aoff + m * 2048 + k * 1024); } while (0)
#define PG8_LDB(dst, b, h) do { _Pragma("unroll") for (int n = 0; n < 2; ++n) _Pragma("unroll") for (int k = 0; k < 2; ++k) dst[n][k] = *(const PG8_LAS bf16x8*)(lds + PG8_SB(b, h) + boff + n * 2048 + k * 1024); } while (0)
#define PG8_MMA(ai, bj, At, Bt) do { __builtin_amdgcn_s_setprio(1); _Pragma("unroll") for (int m = 0; m < 4; ++m) _Pragma("unroll") for (int n = 0; n < 2; ++n) _Pragma("unroll") for (int k = 0; k < 2; ++k) \
        acc[ai][bj][m][n] = __builtin_amdgcn_mfma_f32_16x16x32_bf16(Bt[n][k], At[m][k], acc[ai][bj][m][n], 0, 0, 0); __builtin_amdgcn_s_setprio(0); } while (0)
#define PG8_WAIT_V(n) asm volatile("s_waitcnt vmcnt(" #n ")" ::: "memory")
#define PG8_WAIT_L(n) asm volatile("s_waitcnt lgkmcnt(" #n ")" ::: "memory")
#define PG8_BAR __builtin_amdgcn_s_barrier()
#define PG8_SCHED __builtin_amdgcn_sched_barrier(0)
    Unit cur, nxt; int ui = 0;
    if (!S.next(0, cur)) return;
    f32x4 acc[2][2][4][2];
#pragma unroll
    for (int a = 0; a < 2; ++a)
#pragma unroll
        for (int b = 0; b < 2; ++b)
#pragma unroll
            for (int m = 0; m < 4; ++m)
#pragma unroll
                for (int n = 0; n < 2; ++n) { d64x2 z_; asm volatile("v_mov_b64 %0, 0\n\tv_mov_b64 %1, 0" : "=v"(z_.x), "=v"(z_.y)); acc[a][b][m][n] = __builtin_bit_cast(f32x4, z_); }
    bf16x8 At[4][2], B0[2][2], B1[2][2];
    const char* cA = (const char*)g.A + (size_t)cur.pm * tstep; const char* cB = (const char*)g.Bt + (size_t)cur.pn * tstep;
    S.a_ready(cur);
    if constexpr (SP2) {
        PG8_STAGE(PG8_SB(0, 0), cB, voffB); PG8_STAGE(PG8_SB(0, 1), cB + hstep, voffB); PG8_STAGE(PG8_SA(0, 0), cA, voffA); PG8_STAGE(PG8_SA(0, 1), cA + hstep, voffA);
        if (wr == 1) PG8_BAR;
        PG8_WAIT_V(2); PG8_BAR;
        PG8_STAGE(PG8_SB(1, 0), cB + kstep, voffB); PG8_STAGE(PG8_SA(1, 0), cA + kstep, voffA); PG8_STAGE(PG8_SB(1, 1), cB + hstep + kstep, voffB);
        PG8_WAIT_V(6); PG8_BAR;
    } else {
        PG8_STAGE(PG8_SB(0, 0), cB, voffB); PG8_STAGE(PG8_SA(0, 0), cA, voffA); PG8_STAGE(PG8_SB(0, 1), cB + hstep, voffB); PG8_STAGE(PG8_SA(0, 1), cA + hstep, voffA);
        if (wr == 1) PG8_BAR;
        PG8_WAIT_V(4); PG8_BAR;
        PG8_STAGE(PG8_SB(1, 0), cB + kstep, voffB); PG8_STAGE(PG8_SA(1, 0), cA + kstep, voffA); PG8_STAGE(PG8_SB(1, 1), cB + hstep + kstep, voffB);
        PG8_WAIT_V(6); PG8_BAR;
    }
    for (;;) {
        const bool has_next = S.next(ui + 1, nxt);
        const char* nA = has_next ? (const char*)g.A + (size_t)nxt.pm * tstep : cA; const char* nB = has_next ? (const char*)g.Bt + (size_t)nxt.pn * tstep : cB;
        for (int t = 0; t < nt; t += 2) {
            const bool last = (t == nt - 2);
            const char* a1 = cA + (size_t)(t + 1) * kstep;
            const char* a2 = last ? nA : cA + (size_t)(t + 2) * kstep; const char* b2 = last ? nB : cB + (size_t)(t + 2) * kstep;
            const char* a3 = a2 + kstep; const char* b3 = b2 + kstep;
            if (last && has_next) S.a_ready(nxt);
            if constexpr (SP2) {
            PG8_LDB(B0, 0, 0); PG8_LDB(B1, 0, 1); PG8_SCHED; PG8_LDA(At, 0, 0); PG8_STAGE(PG8_SA(1, 1), a1 + hstep, voffA);
            PG8_WAIT_V(8); PG8_WAIT_L(0); PG8_BAR; PG8_MMA(0, 0, At, B0); PG8_MMA(0, 1, At, B1); PG8_BAR; PG8_SCHED;
            PG8_LDA(At, 0, 1); PG8_STAGE(PG8_SB(0, 0), b2, voffB); PG8_STAGE(PG8_SB(0, 1), b2 + hstep, voffB); PG8_STAGE(PG8_SA(0, 0), a2, voffA);
            PG8_WAIT_V(8); PG8_WAIT_L(0); PG8_BAR; PG8_MMA(1, 0, At, B0); PG8_MMA(1, 1, At, B1); PG8_BAR; PG8_SCHED;
            PG8_LDB(B0, 1, 0); PG8_LDB(B1, 1, 1); PG8_SCHED; PG8_LDA(At, 1, 0); PG8_STAGE(PG8_SA(0, 1), a2 + hstep, voffA);
            PG8_WAIT_V(8); PG8_WAIT_L(0); PG8_BAR; PG8_MMA(0, 0, At, B0); PG8_MMA(0, 1, At, B1); PG8_BAR; PG8_SCHED;
            PG8_LDA(At, 1, 1); PG8_STAGE(PG8_SB(1, 0), b3, voffB); PG8_STAGE(PG8_SB(1, 1), b3 + hstep, voffB); PG8_STAGE(PG8_SA(1, 0), a3, voffA);
            PG8_WAIT_V(8); PG8_WAIT_L(0); PG8_BAR; PG8_MMA(1, 0, At, B0); PG8_MMA(1, 1, At, B1); PG8_BAR; PG8_SCHED;
            } else {
            PG8_LDB(B0, 0, 0); PG8_SCHED; PG8_LDA(At, 0, 0); PG8_STAGE(PG8_SA(1, 1), a1 + hstep, voffA);
            PG8_WAIT_L(8); PG8_BAR; PG8_WAIT_L(0); PG8_MMA(0, 0, At, B0); PG8_BAR; PG8_SCHED;
            PG8_LDB(B1, 0, 1); PG8_STAGE(PG8_SB(0, 0), b2, voffB);
            PG8_BAR; PG8_WAIT_L(0); PG8_MMA(0, 1, At, B1); PG8_BAR;
            PG8_LDA(At, 0, 1); PG8_STAGE(PG8_SA(0, 0), a2, voffA);
            PG8_BAR; PG8_WAIT_L(0); PG8_MMA(1, 0, At, B0); PG8_BAR; PG8_SCHED;
            PG8_STAGE(PG8_SB(0, 1), b2 + hstep, voffB);
            PG8_WAIT_V(6); PG8_BAR; PG8_MMA(1, 1, At, B1); PG8_BAR;
            PG8_LDB(B0, 1, 0); PG8_SCHED; PG8_LDA(At, 1, 0); PG8_STAGE(PG8_SA(0, 1), a2 + hstep, voffA);
            PG8_WAIT_L(8); PG8_BAR; PG8_WAIT_L(0); PG8_MMA(0, 0, At, B0); PG8_BAR; PG8_SCHED;
            PG8_LDB(B1, 1, 1); PG8_STAGE(PG8_SB(1, 0), b3, voffB);
            PG8_BAR; PG8_WAIT_L(0); PG8_MMA(0, 1, At, B1); PG8_BAR;
            PG8_LDA(At, 1, 1); PG8_STAGE(PG8_SA(1, 0), a3, voffA);
            PG8_BAR; PG8_WAIT_L(0); PG8_MMA(1, 0, At, B0); PG8_BAR; PG8_SCHED;
            PG8_STAGE(PG8_SB(1, 1), b3 + hstep, voffB);
            PG8_WAIT_V(6); PG8_BAR; PG8_MMA(1, 1, At, B1); PG8_BAR;
            }
        }
        if constexpr (ALIGN_EPI) { if (wr == 0) PG8_BAR; }
        if constexpr (!Epi::AFTER_DRAIN) { E(acc, cur, wr, wc, fr, fq); S.done(cur); }
        if (!has_next) break;
#pragma unroll
        for (int a = 0; a < 2; ++a)
#pragma unroll
            for (int b = 0; b < 2; ++b)
#pragma unroll
                for (int m = 0; m < 4; ++m)
#pragma unroll
                    for (int n = 0; n < 2; ++n) { d64x2 z_; asm volatile("v_mov_b64 %0, 0\n\tv_mov_b64 %1, 0" : "=v"(z_.x), "=v"(z_.y)); acc[a][b][m][n] = __builtin_bit_cast(f32x4, z_); }
        cur = nxt; cA = nA; cB = nB; ++ui;
        if constexpr (ALIGN_EPI) { if (wr == 1) PG8_BAR; }
    }
    PG8_WAIT_V(0);
    if constexpr (!ALIGN_EPI) { if (wr == 0) PG8_BAR; }
    PG8_BAR;
    if constexpr (Epi::AFTER_DRAIN) { E.fused(acc, cur, wr, wc, fr, fq, lds, wid, lane); S.done(cur); }
#undef PG8_SA
#undef PG8_SB
#undef PG8_STAGE
#undef PG8_LDA
#undef PG8_LDB
#undef PG8_MMA
#undef PG8_WAIT_V
#undef PG8_WAIT_L
#undef PG8_BAR
#undef PG8_SCHED
}
}
#define XB_TMO      128
#define XB_XCNT(j)  (256  + 64 * (j))
#define XB_XSUB(j)  (1280 + 64 * (j))
#define XB_XGEN(j)  (2304 + 64 * (j))
#define XB_TOP      3328
#define XB_TOPGEN   3392
#define XCD_BAR_WORDS 3456
#define XB_SPIN_CAP (1u << 18)

__device__ __forceinline__ unsigned xb_ld(unsigned* p)              { return __hip_atomic_load(p, __ATOMIC_RELAXED, __HIP_MEMORY_SCOPE_AGENT); }
__device__ __forceinline__ unsigned xb_add(unsigned* p, unsigned v) { return __hip_atomic_fetch_add(p, v, __ATOMIC_RELAXED, __HIP_MEMORY_SCOPE_AGENT); }
__device__ __forceinline__ unsigned xb_xcc_id() { return (unsigned)__builtin_amdgcn_s_getreg((3 << 11) | 20) & 0xFu; }
#define XB_SPIN(cond, bar) do { unsigned _sp = 0; while (cond) { __builtin_amdgcn_s_sleep(1); \
    if ((++_sp & 255u) == 0u) { if (xb_ld(&(bar)[XB_TMO])) break; if (_sp > XB_SPIN_CAP) { atomicAdd(&(bar)[XB_TMO], 1u); break; } } } } while (0)

struct XcdBarrier {
    unsigned* bar; unsigned x;
    volatile LAS unsigned* st;
};

__device__ __forceinline__ XcdBarrier xcd_barrier_post(unsigned* bar, volatile LAS unsigned* st) {
    XcdBarrier b; b.bar = bar; b.x = xb_xcc_id(); b.st = st;
    if (threadIdx.x == 0) (void)xb_add(&bar[XB_XCNT(b.x)], 1u);
    return b;
}
__device__ __forceinline__ void xcd_barrier_complete(unsigned* bar, unsigned x, unsigned& nloc, unsigned& nx) {
    const unsigned G = gridDim.x * gridDim.y * gridDim.z;
    unsigned sum, cnt, mine, sp = 0u;
    for (;;) {
        sum = 0u; cnt = 0u; mine = 0u;
#pragma unroll
        for (unsigned j = 0; j < 16; ++j) { const unsigned c = xb_ld(&bar[XB_XCNT(j)]); sum += c; cnt += (c > 0u) ? 1u : 0u; mine = (j == x) ? c : mine; }
        if (sum == G) break;
        __builtin_amdgcn_s_sleep(1);
        if ((++sp & 255u) == 0u) { if (xb_ld(&bar[XB_TMO])) break; if (sp > XB_SPIN_CAP) { atomicAdd(&bar[XB_TMO], 1u); break; } }
    }
    nloc = mine > 0u ? mine : 1u; nx = cnt > 0u ? cnt : 1u;
}

__device__ __forceinline__ void xcd_barrier(const XcdBarrier& b) {
    asm volatile("s_waitcnt vmcnt(0)" ::: "memory");
    __syncthreads();
    if (threadIdx.x == 0) {
        unsigned* bar = b.bar;
        __builtin_amdgcn_s_waitcnt(0);
        unsigned nloc = b.st[0], nx = b.st[1];
        if (nloc == 0u) { xcd_barrier_complete(bar, b.x, nloc, nx); b.st[0] = nloc; b.st[1] = nx; }
        const unsigned old = xb_add(&bar[XB_XSUB(b.x)], 1u);
        const unsigned gen = old / nloc;
        if (old + 1u == (gen + 1u) * nloc) {
            __builtin_amdgcn_fence(__ATOMIC_RELEASE, "agent");
            asm volatile("s_waitcnt vmcnt(0)" ::: "memory");
            const unsigned og = xb_add(&bar[XB_TOP], 1u);
            const unsigned tg = og / nx;
            if (og + 1u == (tg + 1u) * nx) xb_add(&bar[XB_TOPGEN], 1u);
            else XB_SPIN(xb_ld(&bar[XB_TOPGEN]) == tg, bar);
            __builtin_amdgcn_fence(__ATOMIC_ACQUIRE, "agent");
            xb_add(&bar[XB_XGEN(b.x)], 1u);
            asm volatile("s_waitcnt vmcnt(0)" ::: "memory");
        } else {
            XB_SPIN(xb_ld(&bar[XB_XGEN(b.x)]) == gen, bar);
            __builtin_amdgcn_fence(__ATOMIC_ACQUIRE, "agent");
            asm volatile("s_waitcnt vmcnt(0)" ::: "memory");
        }
    }
    __syncthreads();
}
constexpr size_t MiB = 1u << 20;
constexpr size_t WS_CTL = 0, CTL_ZERO_BYTES = 1 * MiB;
constexpr size_t WS_WAB_IN = 1 * MiB, WS_WAB_OUT = 97 * MiB, WS_WGU0 = 129 * MiB, WS_WDN0 = 301 * MiB, WS_WCD_IN = 387 * MiB, WS_WCD_OUT = 467 * MiB, WS_WGU1 = 499 * MiB, WS_WDN1 = 671 * MiB;
constexpr size_t WS_WSMALL = 757 * MiB, WS_WRG = 758 * MiB;
constexpr size_t WS_U = 760 * MiB, WS_PROJ = 824 * MiB, WS_O = 1016 * MiB, WS_H = 1080 * MiB;
constexpr size_t WS_ACT = WS_PROJ;
constexpr size_t WS_SMALL32 = 1208 * MiB, WS_CF = 1209 * MiB, WS_QT = 1210 * MiB, WS_KDT = 1226 * MiB, WS_PM = 1242 * MiB, WS_GDEC = 1246 * MiB, WS_ORAW = 1247 * MiB, WS_SSQ = 1311 * MiB;
constexpr size_t WS_END = 1313 * MiB;
constexpr size_t SSQ0_BYTE_OFF = 851968;
constexpr int CW_BAR = 4096, CW_SSQ = 131072;

constexpr int RING_BYTES = 131072;
constexpr int LDSCTL_OFF = RING_BYTES, MISC_OFF = LDSCTL_OFF + 320;
constexpr int LDS_BYTES = 147456;
constexpr int NWAVES = 8, NTHR = 512;

struct Params {
    const float *x, *norm_mix, *norm_ffn, *ffn_w_gate, *ffn_w_up, *ffn_w_down, *ab_w_in, *gla_w_gate_up, *gla_b_gate, *gla_norm, *fox_b_f, *ab_w_out,
                *cd_w_in, *rg_conv_w, *rg_conv_b, *rg_w_x, *rg_b_x, *rg_w_a, *rg_b_a, *rg_lambda, *cd_w_out, *final_norm;
    float* out; unsigned char* ws; int ph_lo, ph_hi;
};

struct TrDesc { const float* src; bf16_t* dst; const float* gain; int ldn, K; };
template <bool NT = true> __device__ __forceinline__ void tr_load(const TrDesc& d, f32x4 (&v)[8], int lane) {
    const float* sp = d.src + (size_t)(lane >> 3) * d.ldn + 4 * (lane & 7);
#pragma unroll
    for (int i = 0; i < 8; ++i) v[i] = NT ? __builtin_nontemporal_load((const f32x4*)(sp + (size_t)(8 * i) * d.ldn)) : *(const f32x4*)(sp + (size_t)(8 * i) * d.ldn);
}
template <bool NT = true> __device__ __forceinline__ void tr_finish(const TrDesc& d, const f32x4 (&v)[8], LAS float* scr, int lane) {
    const int c = lane & 7;
    f32x4 g0 = {1.f, 1.f, 1.f, 1.f}, g1 = {1.f, 1.f, 1.f, 1.f};
    if (d.gain) { g0 = *(const f32x4*)(d.gain + 8 * c); g1 = *(const f32x4*)(d.gain + 8 * c + 4); }
#pragma unroll
    for (int i = 0; i < 8; ++i) { LAS float* w = scr + (8 * i + (lane >> 3)) * 33 + 4 * c; w[0] = v[i].x; w[1] = v[i].y; w[2] = v[i].z; w[3] = v[i].w; }
    LDS_WAIT(); asm volatile("" ::: "memory");
#pragma unroll
    for (int j = 0; j < 4; ++j) { const int n = (lane >> 3) + 8 * j; const LAS float* s = scr + (8 * c) * 33 + n;
        u32x4 o; o.x = cvt_pk_bf16(s[0 * 33] * g0.x, s[1 * 33] * g0.y); o.y = cvt_pk_bf16(s[2 * 33] * g0.z, s[3 * 33] * g0.w); o.z = cvt_pk_bf16(s[4 * 33] * g1.x, s[5 * 33] * g1.y); o.w = cvt_pk_bf16(s[6 * 33] * g1.z, s[7 * 33] * g1.w);
        if (NT) __builtin_nontemporal_store(o, (u32x4*)(d.dst + (size_t)n * d.K + 8 * c)); else *(u32x4*)(d.dst + (size_t)n * d.K + 8 * c) = o; }
    LDS_WAIT(); asm volatile("" ::: "memory");
}
#define TR_JOB(W_, ldn_, K_, nsrc0_, ncols_, WT_, rdst0_, gain_) { constexpr int nnb_ = (ncols_) / 32, nit_ = ((K_) / 64) * nnb_; \
    if (r < nit_) { const int kb_ = r / nnb_, nb_ = r % nnb_; const float* g_ = (gain_); \
        return TrDesc{(W_) + (size_t)(64 * kb_) * (ldn_) + (nsrc0_) + 32 * nb_, (WT_) + (size_t)((rdst0_) + 32 * nb_) * (K_) + 64 * kb_, g_ ? g_ + 64 * kb_ : nullptr, (ldn_), (K_)}; } r -= nit_; }
#define TR_JOB_GU(W_, WT_, off_, gain_) { constexpr int nnb_ = DFF / 32, nit_ = (DM / 64) * nnb_; \
    if (r < nit_) { const int kb_ = r / nnb_, nb_ = r % nnb_, c0_ = 32 * nb_; \
        return TrDesc{(W_) + (size_t)(64 * kb_) * DFF + c0_, (WT_) + (size_t)(256 * (c0_ / 128) + (c0_ % 128) + (off_)) * DM + 64 * kb_, (gain_) + 64 * kb_, DFF, DM}; } r -= nit_; }

__device__ __forceinline__ void rms_row_bf16(const float* xrow, const float* g, bf16_t* orow, int lane) {
    const f32x4* xr = (const f32x4*)xrow + lane; const f32x4* gr = (const f32x4*)g + lane;
    f32x4 v[16]; float s = 0.f;
#pragma unroll
    for (int j = 0; j < 16; ++j) { v[j] = xr[64 * j]; s += (v[j].x * v[j].x + v[j].y * v[j].y) + (v[j].z * v[j].z + v[j].w * v[j].w); }
    const float rstd = 1.0f / sqrtf(wave_sum(s) * (1.0f / DM) + EPS);
    u32x2* o8 = (u32x2*)orow + lane;
#pragma unroll
    for (int j = 0; j < 16; ++j) { const f32x4 gg = gr[64 * j]; u32x2 w; w.x = cvt_pk_bf16(v[j].x * rstd * gg.x, v[j].y * rstd * gg.y); w.y = cvt_pk_bf16(v[j].z * rstd * gg.z, v[j].w * rstd * gg.w); o8[64 * j] = w; }
}
__device__ __forceinline__ void x_row_bf16(const float* xrow, bf16_t* orow, unsigned long long* ssq, int lane) {
    const f32x4* xr = (const f32x4*)xrow + lane;
    f32x4 v[16]; float s = 0.f;
#pragma unroll
    for (int j = 0; j < 16; ++j) { v[j] = xr[64 * j]; s += (v[j].x * v[j].x + v[j].y * v[j].y) + (v[j].z * v[j].z + v[j].w * v[j].w); }
    s = wave_sum(s);
    u32x2* o8 = (u32x2*)orow + lane;
#pragma unroll
    for (int j = 0; j < 16; ++j) { u32x2 w; w.x = cvt_pk_bf16(v[j].x, v[j].y); w.y = cvt_pk_bf16(v[j].z, v[j].w); o8[64 * j] = w; }
    if (lane == 0) *ssq = (unsigned long long)(s * 16777216.0f + 0.5f);
}
__device__ __forceinline__ void rms_row_f32(const float* xrow, const float* g, float* orow, int lane) {
    const f32x4* xr = (const f32x4*)xrow + lane; const f32x4* gr = (const f32x4*)g + lane;
    f32x4 v[16]; float s = 0.f;
#pragma unroll
    for (int j = 0; j < 16; ++j) { v[j] = xr[64 * j]; s += (v[j].x * v[j].x + v[j].y * v[j].y) + (v[j].z * v[j].z + v[j].w * v[j].w); }
    const float rstd = 1.0f / sqrtf(wave_sum(s) * (1.0f / DM) + EPS);
    f32x4* o = (f32x4*)orow + lane;
#pragma unroll
    for (int j = 0; j < 16; ++j) { const f32x4 gg = gr[64 * j]; o[64 * j] = v[j] * rstd * gg; }
}
__device__ __forceinline__ void phase_final_norm(const bf16_t* Hb, const unsigned long long* ssq, const float* g, float* out, int gw, int ngw, int lane, float scale) {
    for (int m = gw; m < MTOK; m += ngw) { const float rstd = scale / sqrtf((float)ssq[m] * (1.0f / 16777216.0f) * (1.0f / DM) + EPS);
        const u32x4* xr = (const u32x4*)(Hb + (size_t)m * DM) + lane; f32x4* o = (f32x4*)(out + (size_t)m * DM); const f32x4* gr = (const f32x4*)g;
#pragma unroll
        for (int j = 0; j < 8; ++j) { const u32x4 r = xr[64 * j]; const int c4 = 2 * (64 * j + lane);
            const f32x4 g0 = gr[c4], g1 = gr[c4 + 1];
            o[c4] = (f32x4){bflo(r.x) * rstd * g0.x, bfhi(r.x) * rstd * g0.y, bflo(r.y) * rstd * g0.z, bfhi(r.y) * rstd * g0.w};
            o[c4 + 1] = (f32x4){bflo(r.z) * rstd * g1.x, bfhi(r.z) * rstd * g1.y, bflo(r.w) * rstd * g1.z, bfhi(r.w) * rstd * g1.w}; } }
}
__device__ __forceinline__ void phase_rms_bf16(const float* src, const float* g, bf16_t* dst, int gw, int ngw, int lane) {
    for (int m = gw; m < MTOK; m += ngw) rms_row_bf16(src + (size_t)m * DM, g, dst + (size_t)m * DM, lane);
}

constexpr int P0_I_AB = (DM / 64) * (6144 / 32), P0_I_SQ = (DM / 64) * (DM / 32), P0_I_CD = (DM / 64) * (CD_IN / 32), P0_I_GU = (DM / 64) * (DFF / 32), P0_I_DN = (DFF / 64) * (DM / 32), P0_I_RG = 16 * (256 / 64) * (256 / 32);
#ifndef TAILKB
#define TAILKB 128
#endif
constexpr int P0_I_DN1 = (DFF / 64 - TAILKB) * (DM / 32), TAIL_ITEMS = TAILKB * (DM / 32);
constexpr int P0_NITEMS = 2 * P0_I_AB + 2 * P0_I_SQ + P0_I_CD + 4 * P0_I_GU + 1 * P0_I_DN + P0_I_RG;
__device__ __forceinline__ TrDesc p0_item(const Params& p, int it) {
    unsigned char* ws = p.ws;
    bf16_t* WAB_IN = (bf16_t*)(ws + WS_WAB_IN); bf16_t* WAB_OUT = (bf16_t*)(ws + WS_WAB_OUT); bf16_t* WGU0 = (bf16_t*)(ws + WS_WGU0); bf16_t* WDN0 = (bf16_t*)(ws + WS_WDN0);
    bf16_t* WCD_IN = (bf16_t*)(ws + WS_WCD_IN); bf16_t* WGU1 = (bf16_t*)(ws + WS_WGU1);
    bf16_t* WRG = (bf16_t*)(ws + WS_WRG);
    int r = it;
    TR_JOB(p.ab_w_in, AB_IN, DM, 0, 6144, WAB_IN, 0, p.norm_mix)
    TR_JOB(p.ab_w_in, AB_IN, DM, 6160, 6144, WAB_IN, 6144, p.norm_mix)
    TR_JOB(p.ab_w_out, DM, DM, 0, DM, WAB_OUT, 0, (const float*)nullptr)
    TR_JOB_GU(p.ffn_w_gate, WGU0, 0, p.norm_ffn)
    TR_JOB_GU(p.ffn_w_up, WGU0, 128, p.norm_ffn)
    TR_JOB(p.ffn_w_down, DM, DFF, 0, DM, WDN0, 0, (const float*)nullptr)
    TR_JOB(p.cd_w_in, CD_IN, DM, 0, CD_IN, WCD_IN, 0, p.norm_mix + DM)
    TR_JOB_GU(p.ffn_w_gate + (size_t)DM * DFF, WGU1, 0, p.norm_ffn + DM)
    TR_JOB_GU(p.ffn_w_up + (size_t)DM * DFF, WGU1, 128, p.norm_ffn + DM)
    TR_JOB(p.cd_w_out, DM, DM, 0, DM, (bf16_t*)(ws + WS_WCD_OUT), 0, (const float*)nullptr)
    const int mat = r / 32, rr = r % 32, kb_ = rr / 8, nb_ = rr % 8;
    const float* W = (mat < 8 ? p.rg_w_x : p.rg_w_a) + (size_t)(mat & 7) * 65536;
    return TrDesc{W + (size_t)(64 * kb_) * 256 + 32 * nb_, WRG + (size_t)mat * 65536 + (size_t)(32 * nb_) * 256 + 64 * kb_, nullptr, 256, 256};
}
template <class F, bool NT = true> __device__ __forceinline__ void tr_run(F item, int first, int step, int n, LAS float* scr, int lane) {
    if (first >= n) return;
    TrDesc da = item(first), db = da, dc = da; f32x4 va[8], vb[8], vc[8];
    tr_load<NT>(da, va, lane);
    if (first + step < n) { db = item(first + step); tr_load<NT>(db, vb, lane); }
    for (int it = first; it < n; it += 3 * step) {
        const bool h1 = it + step < n, h2 = it + 2 * step < n, h3 = it + 3 * step < n, h4 = it + 4 * step < n;
        if (h2) { dc = item(it + 2 * step); tr_load<NT>(dc, vc, lane); }
        tr_finish<NT>(da, va, scr, lane);
        if (h3) { da = item(it + 3 * step); tr_load<NT>(da, va, lane); }
        if (h1) tr_finish<NT>(db, vb, scr, lane);
        if (h4) { db = item(it + 4 * step); tr_load<NT>(db, vb, lane); }
        if (h2) tr_finish<NT>(dc, vc, scr, lane);
    }
}
struct TailItem { const float* W; bf16_t* WT; const float* W2; bf16_t* WT2;
    __device__ __forceinline__ TrDesc operator()(int r) const { constexpr int nnb = DM / 32;
        if (r < TAIL_ITEMS) { const int kb = r / nnb, nb = r % nnb; return TrDesc{W + (size_t)(64 * kb) * DM + 32 * nb, WT + (size_t)(32 * nb) * DFF + 64 * kb, nullptr, DM, DFF}; }
        r -= TAIL_ITEMS; const int kb = r / nnb, nb = r % nnb; return TrDesc{W2 + (size_t)(64 * kb) * DM + 32 * nb, WT2 + (size_t)(32 * nb) * DM + 64 * kb, nullptr, DM, DM}; } };
struct P0Item { const Params* p; int off; __device__ __forceinline__ TrDesc operator()(int r) const { return p0_item(*p, r + off); } };
constexpr int P0A_ITEMS = 2 * P0_I_AB;
__device__ __forceinline__ void p0b_convert(const Params& p, LAS unsigned char* lds, int tw, int ntw, int wave, int lane) {
    P0Item pi{&p, P0A_ITEMS}; tr_run(pi, tw, ntw, P0_NITEMS - P0A_ITEMS, (LAS float*)(lds + wave * 8704), lane);
}
struct Tail1Item { const float* W; bf16_t* WT;
    __device__ __forceinline__ TrDesc operator()(int r) const { constexpr int nnb = DM / 32; const int kb = TAILKB + r / nnb, nb = r % nnb;
        return TrDesc{W + (size_t)(64 * kb) * DM + 32 * nb, WT + (size_t)(32 * nb) * DFF + 64 * kb, nullptr, DM, DFF}; } };
__device__ __forceinline__ void tail1_convert(const Params& p, LAS unsigned char* lds, int tw, int ntw, int wave, int lane) {
    Tail1Item ti{p.ffn_w_down + (size_t)DFF * DM, (bf16_t*)(p.ws + WS_WDN1)};
    tr_run(ti, tw, ntw, P0_I_DN1, (LAS float*)(lds + wave * 8704), lane);
}
__device__ __forceinline__ void tail_convert(const Params& p, LAS unsigned char* lds, int tw, int ntw, int wave, int lane) {
    TailItem ti{p.ffn_w_down + (size_t)DFF * DM, (bf16_t*)(p.ws + WS_WDN1), p.cd_w_out, (bf16_t*)(p.ws + WS_WCD_OUT)};
    tr_run(ti, tw, ntw, TAIL_ITEMS, (LAS float*)(lds + wave * 8704), lane);
}
__device__ __forceinline__ void phase_p0(const Params& p, LAS unsigned char* lds, int gw, int ngw, int wave, int lane) {
    unsigned char* ws = p.ws;
    LAS float* scr = (LAS float*)(lds + wave * 8704);
    { P0Item pi{&p, 0}; tr_run<P0Item, false>(pi, gw, ngw, P0A_ITEMS, scr, lane); }
    { bf16_t* WS_ = (bf16_t*)(ws + WS_WSMALL);
      for (int i = gw * 64 + lane; i < 32 * DM; i += ngw * 64) { const int c = i & 31, k = i >> 5; const int sc = c < 16 ? 6144 + c : 12304 + (c - 16);
          WS_[(size_t)c * DM + k] = f2bf(p.ab_w_in[(size_t)k * AB_IN + sc] * p.norm_mix[k]); } }
    { unsigned long long* ssq0 = (unsigned long long*)(ws + WS_CTL + SSQ0_BYTE_OFF); bf16_t* U = (bf16_t*)(ws + WS_U);
      for (int m = gw; m < MTOK; m += ngw) x_row_bf16(p.x + (size_t)m * DM, U + (size_t)m * DM, ssq0 + m, lane); }
}

__device__ __forceinline__ void phase_small32(const Params& p, LAS unsigned char* lds, int wave, int lane) {
    const bf16_t* U = (const bf16_t*)(p.ws + WS_U); const bf16_t* WS_ = (const bf16_t*)(p.ws + WS_WSMALL); float* S32 = (float*)(p.ws + WS_SMALL32);
    LAS float* red = (LAS float*)lds;
    const int h = lane >> 5, c = lane & 31;
    for (int unit = blockIdx.x; unit < MTOK / 32; unit += gridDim.x) {
        const int row0 = unit * 32, kbase = wave * 512;
        f32x4 acc[2][2];
#pragma unroll
        for (int i = 0; i < 2; ++i) for (int j = 0; j < 2; ++j) acc[i][j] = (f32x4){0.f, 0.f, 0.f, 0.f};
        const int r15 = lane & 15, kq = lane >> 4;
        const bf16_t* ap = U + (size_t)(row0 + r15) * DM + kbase + 8 * kq; const bf16_t* bp = WS_ + (size_t)r15 * DM + kbase + 8 * kq;
#pragma unroll 8
        for (int s = 0; s < 16; ++s) { const bf16x8 a0 = *(const bf16x8*)(ap + 32 * s), a1 = *(const bf16x8*)(ap + (size_t)16 * DM + 32 * s), b0 = *(const bf16x8*)(bp + 32 * s), b1 = *(const bf16x8*)(bp + (size_t)16 * DM + 32 * s);
            acc[0][0] = __builtin_amdgcn_mfma_f32_16x16x32_bf16(a0, b0, acc[0][0], 0, 0, 0); acc[0][1] = __builtin_amdgcn_mfma_f32_16x16x32_bf16(a0, b1, acc[0][1], 0, 0, 0);
            acc[1][0] = __builtin_amdgcn_mfma_f32_16x16x32_bf16(a1, b0, acc[1][0], 0, 0, 0); acc[1][1] = __builtin_amdgcn_mfma_f32_16x16x32_bf16(a1, b1, acc[1][1], 0, 0, 0); }
#pragma unroll
        for (int i = 0; i < 2; ++i)
#pragma unroll
            for (int j = 0; j < 2; ++j)
#pragma unroll
                for (int e = 0; e < 4; ++e) red[(wave * 32 + 16 * i + 4 * kq + e) * 33 + 16 * j + r15] = acc[i][j][e];
        LDS_BARRIER();
        for (int i = threadIdx.x; i < 1024; i += NTHR) { const int t = i >> 5, cc = i & 31; float s = 0.f;
#pragma unroll
            for (int w = 0; w < 8; ++w) s += red[(w * 32 + t) * 33 + cc];
            S32[(size_t)(row0 + t) * 32 + cc] = s * pg8::ssq_rstd((const pg8::ssq_t*)(p.ws + WS_CTL + SSQ0_BYTE_OFF), row0 + t); }
        LDS_BARRIER();
    }
}

__device__ __forceinline__ void phase_fox_cumsum(const Params& p, LAS unsigned char* lds, int wave, int lane) {
    const float* S32 = (const float*)(p.ws + WS_SMALL32); float* CF = (float*)(p.ws + WS_CF);
    LAS float* WT = (LAS float*)(lds + 90112);
    const int tid = threadIdx.x;
    for (int u = blockIdx.x; u < NB * 16; u += gridDim.x) { const int b = u >> 4, hd = u & 15; const float bias = p.fox_b_f[hd];
        float v[4];
#pragma unroll
        for (int i = 0; i < 4; ++i) v[i] = log_sigmoid_acc(S32[(size_t)(b * SEQ + 4 * tid + i) * 32 + 16 + hd] + bias);
        v[1] += v[0]; v[2] += v[1]; v[3] += v[2];
        const float tot = v[3]; float incl = tot;
#pragma unroll
        for (int o = 1; o < 64; o <<= 1) { const float t = __shfl_up(incl, o); if (lane >= o) incl += t; }
        if (lane == 63) WT[wave] = incl;
        __syncthreads();
        float off = incl - tot;
#pragma unroll
        for (int w = 0; w < 7; ++w) off += w < wave ? WT[w] : 0.f;
        *(f32x4*)(CF + (size_t)u * SEQ + 4 * tid) = (f32x4){v[0] + off, v[1] + off, v[2] + off, v[3] + off};
        __syncthreads();
    }
}

constexpr int GP_PITCH = 528;
__device__ __forceinline__ void phase_gla_pre(const Params& p, LAS unsigned char* lds, int wave, int lane) {
    const unsigned char* ws = p.ws;
    const bf16_t* PROJ = (const bf16_t*)(ws + WS_PROJ); const float* S32 = (const float*)(ws + WS_SMALL32);
    bf16_t* QT = (bf16_t*)(ws + WS_QT); bf16_t* KDT = (bf16_t*)(ws + WS_KDT); bf16_t* PM = (bf16_t*)(ws + WS_PM); float* GDEC = (float*)(ws + WS_GDEC);
    LAS float* G = (LAS float*)lds;
    LAS float* TOT = (LAS float*)(lds + 4096);
    LAS unsigned char* QTl = lds + 8192;
    LAS unsigned char* KTl = lds + 8192 + 64 * GP_PITCH;
    LAS unsigned char* PL = lds + 8192 + 128 * GP_PITCH;
    const int tid = threadIdx.x, k = tid & 255, th = tid >> 8, h = lane >> 5, l31 = lane & 31;
    for (int unit = blockIdx.x; unit < NB * 4 * 32; unit += gridDim.x) {
        const int b = unit >> 7, hd = (unit >> 5) & 3, c = unit & 31, R0 = b * SEQ + 64 * c;
        const bf16_t* qp = PROJ + (size_t)(R0 + 32 * th) * AB_MAIN + PJ_GQ + hd * 256 + k; const bf16_t* kp = PROJ + (size_t)(R0 + 32 * th) * AB_MAIN + PJ_GK + hd * 256 + k;
        bf16_t qraw[32], kraw[32];
#pragma unroll
        for (int tt = 0; tt < 32; ++tt) { qraw[tt] = qp[(size_t)tt * AB_MAIN]; kraw[tt] = kp[(size_t)tt * AB_MAIN]; }
        for (int i = tid; i < 1024; i += NTHR) G[i] = S32[(size_t)(R0 + (i >> 4)) * 32 + (i & 15)];
        float w[16];
#pragma unroll
        for (int r = 0; r < 16; ++r) w[r] = p.gla_w_gate_up[r * 1024 + hd * 256 + k];
        const float bias = p.gla_b_gate[hd * 256 + k];
        LDS_BARRIER();
        float bc[32]; float run = 0.f;
#pragma unroll
        for (int tt = 0; tt < 32; ++tt) { const LAS f32x4* g4 = (const LAS f32x4*)(G + (32 * th + tt) * 16); f32x2 x2 = {bias, 0.f};
#pragma unroll
            for (int q4 = 0; q4 < 4; ++q4) { const f32x4 gv = g4[q4]; x2 = (f32x2){gv.x, gv.y} * (f32x2){w[4 * q4], w[4 * q4 + 1]} + x2; x2 = (f32x2){gv.z, gv.w} * (f32x2){w[4 * q4 + 2], w[4 * q4 + 3]} + x2; }
            const float xx = x2.x + x2.y;
            run += log_sigmoid_fast(xx) * (LOG2E_F / 16.0f); bc[tt] = run; }
        TOT[th * 256 + k] = run;
        LDS_BARRIER();
        const float t0 = TOT[k], t1 = TOT[256 + k], blast = t0 + t1, boff = th ? t0 : 0.f;
        const float elast = __builtin_amdgcn_exp2f(blast);
        if (th == 0) GDEC[(size_t)unit * 256 + k] = elast;
#pragma unroll
        for (int t8 = 0; t8 < 4; ++t8) { float kd[8];
#pragma unroll
            for (int i = 0; i < 8; ++i) { const int tt = 8 * t8 + i; const float bb = bc[tt] + boff;
                const float qv = bf2f(qraw[tt]), kv = bf2f(kraw[tt]);
                const float qt = qv * 0.0625f * __builtin_amdgcn_exp2f(bb), kt = kv * __builtin_amdgcn_exp2f(-bb); kd[i] = kt * elast;
                const bf16_t qb = f2bf(qt);
                *(LAS bf16_t*)(QTl + (32 * th + tt) * GP_PITCH + 2 * k) = qb; *(LAS bf16_t*)(KTl + (32 * th + tt) * GP_PITCH + 2 * k) = f2bf(kt);
                }
            u32x4 o; o.x = cvt_pk_bf16(kd[0], kd[1]); o.y = cvt_pk_bf16(kd[2], kd[3]); o.z = cvt_pk_bf16(kd[4], kd[5]); o.w = cvt_pk_bf16(kd[6], kd[7]);
            *(u32x4*)(KDT + (((size_t)unit * 8 + (k >> 5)) * 4 + 2 * th + (t8 >> 1)) * 512 + ((k & 31) + 32 * (t8 & 1)) * 8) = o; }
        LDS_BARRIER();
#pragma unroll
        for (int f = 0; f < 4; ++f) { const int ti = f >> 1, s2 = f & 1; const LAS unsigned char* qp8 = QTl + (32 * ti + l31) * GP_PITCH + (32 * wave + 16 * s2 + 4 * h) * 2;
            const s16x4 lo = *(const LAS s16x4*)qp8, hi = *(const LAS s16x4*)(qp8 + 16);
            *(bf16x8*)(QT + (((size_t)unit * 8 + wave) * 4 + f) * 512 + lane * 8) = cat4(lo, hi); }
        if (wave < 4) { const int ti = wave & 1, si = wave >> 1;
            f32x16 acc; for (int i = 0; i < 16; ++i) acc[i] = 0.f;
            const LAS unsigned char* ap = QTl + (32 * ti + (lane & 31)) * GP_PITCH + 16 * h; const LAS unsigned char* bp = KTl + (32 * si + (lane & 31)) * GP_PITCH + 16 * h;
#pragma unroll
            for (int s = 0; s < 16; ++s) { const bf16x8 a = *(const LAS bf16x8*)(ap + 32 * s), bb = *(const LAS bf16x8*)(bp + 32 * s); acc = MFMA32(a, bb, acc); }
            const int sc = 32 * si + (lane & 31);
#pragma unroll
            for (int r = 0; r < 16; ++r) { const int t = 32 * ti + crow(r, h); *(LAS bf16_t*)(PL + t * 144 + 2 * sc) = f2bf(sc <= t ? acc[r] : 0.f); }
        }
        LDS_BARRIER();
        { const int f = tid >> 6, tip = f >> 2, ssp = f & 3;
          *(bf16x8*)(PM + ((size_t)unit * 8 + f) * 512 + lane * 8) = *(const LAS bf16x8*)(PL + (32 * tip + l31) * 144 + (16 * ssp + 8 * h) * 2); }
        LDS_BARRIER();
    }
}

__device__ __forceinline__ void l2_touch(const void* gp, unsigned lds_addr) { asm volatile("s_mov_b32 m0, %1\n\ts_nop 0\n\tglobal_load_lds_dword %0, off" :: "v"(gp), "s"(lds_addr) : "memory", "m0"); }
constexpr int VT_PITCH = 144;
struct GlaChunk { u32x2 vraw; bf16x8 qa00, qa01, qa10, qa11, kd0, kd1, kd2, kd3, pa; float gdv; };
__device__ __forceinline__ void gla_load_chunk(GlaChunk& r, const bf16_t* PROJ, const bf16_t* QT, const bf16_t* KDT, const bf16_t* PM, const float* GDEC, int b, int hd, int v0, int c, int wave, int tid, int h, int l31) {
    const int R0 = b * SEQ + 64 * c, cu = (b * 4 + hd) * 32 + c;
    { const int s = tid >> 3, v4 = (tid & 7) * 4; r.vraw = *(const u32x2*)(PROJ + (size_t)(R0 + s) * AB_MAIN + PJ_GV + hd * 512 + v0 + v4); }
    { const bf16_t* qf = QT + (((size_t)cu * 8 + wave) * 4) * 512 + (tid & 63) * 8;
      r.qa00 = *(const bf16x8*)qf; r.qa01 = *(const bf16x8*)(qf + 512); r.qa10 = *(const bf16x8*)(qf + 1024); r.qa11 = *(const bf16x8*)(qf + 1536); }
    { const bf16_t* kf = KDT + (((size_t)cu * 8 + wave) * 4) * 512 + (tid & 63) * 8;
      r.kd0 = *(const bf16x8*)kf; r.kd1 = *(const bf16x8*)(kf + 512); r.kd2 = *(const bf16x8*)(kf + 1024); r.kd3 = *(const bf16x8*)(kf + 1536); }
    r.pa = *(const bf16x8*)(PM + ((size_t)cu * 8 + (wave & 1) * 4 + (wave >> 1)) * 512 + (tid & 63) * 8);
    r.gdv = tid < 256 ? GDEC[(size_t)cu * 256 + tid] : 0.f;
}
__device__ __forceinline__ void phase_gla_seq(const Params& p, LAS unsigned char* lds, int wave, int lane) {
    const unsigned char* ws = p.ws;
    const bf16_t* PROJ = (const bf16_t*)(ws + WS_PROJ); const bf16_t* QT = (const bf16_t*)(ws + WS_QT); const bf16_t* KDT = (const bf16_t*)(ws + WS_KDT); const bf16_t* PM = (const bf16_t*)(ws + WS_PM);
    const float* GDEC = (const float*)(ws + WS_GDEC); float* ORAW = (float*)(p.ws + WS_ORAW); float* SSQ = (float*)(p.ws + WS_SSQ);
    LAS float* RED = (LAS float*)lds;
    LAS unsigned char* VT = lds + 65536;
    LAS float* GD = (LAS float*)(lds + 65536 + 2 * 32 * VT_PITCH);
    const int tid = threadIdx.x, h = lane >> 5, l31 = lane & 31;
    for (int u0 = blockIdx.x; u0 < NB * 4 * 16; u0 += gridDim.x) {
        const int unit = xcd_swz(u0, NB * 4 * 16);
        const int b = unit >> 6, hd = (unit >> 4) & 3, vs = unit & 15, v0 = 32 * vs;
        f32x16 S; for (int i = 0; i < 16; ++i) S[i] = 0.f;
        GlaChunk cur, nxt;
        gla_load_chunk(cur, PROJ, QT, KDT, PM, GDEC, b, hd, v0, 0, wave, tid, h, l31);
        nxt = cur;
        for (int c = 0; c < 32; ++c) {
            const int R0 = b * SEQ + 64 * c;
            LAS unsigned char* vt = VT + (c & 1) * (32 * VT_PITCH);
            { const int s = tid >> 3, v4 = (tid & 7) * 4; const u32x2 raw = cur.vraw;
              *(LAS bf16_t*)(vt + (v4 + 0) * VT_PITCH + 2 * s) = (bf16_t)(raw.x & 0xffffu); *(LAS bf16_t*)(vt + (v4 + 1) * VT_PITCH + 2 * s) = (bf16_t)(raw.x >> 16);
              *(LAS bf16_t*)(vt + (v4 + 2) * VT_PITCH + 2 * s) = (bf16_t)(raw.y & 0xffffu); *(LAS bf16_t*)(vt + (v4 + 3) * VT_PITCH + 2 * s) = (bf16_t)(raw.y >> 16); }
            if (tid < 256) GD[(c & 1) * 256 + tid] = cur.gdv;
            if (c + 1 < 32) gla_load_chunk(nxt, PROJ, QT, KDT, PM, GDEC, b, hd, v0, c + 1, wave, tid, h, l31);
            if (c + 3 < 32 && wave < 2) {
                const int c3 = c + 3, cu3 = (b * 4 + hd) * 32 + c3; const char* tp;
                if (wave == 0) { const int li = vs * 37 + lane;
                    tp = li < 256 ? (const char*)QT + (size_t)cu3 * 32768 + li * 128 : li < 512 ? (const char*)KDT + (size_t)cu3 * 32768 + (li - 256) * 128
                       : li < 576 ? (const char*)PM + (size_t)cu3 * 8192 + (li - 512) * 128 : (const char*)GDEC + (size_t)cu3 * 1024 + (li - 576) * 128;
                    if (lane < 37 && li < 584) l2_touch(tp, (unsigned)(size_t)(lds + 100352)); }
                else { tp = (const char*)(PROJ + (size_t)(b * SEQ + 64 * c3 + lane) * AB_MAIN + PJ_GV + hd * 512 + v0); l2_touch(tp, (unsigned)(size_t)(lds + 100608)); } }
            LDS_BARRIER();
            const int tip = wave & 1, ssp = wave >> 1;
            f32x16 oacc[2];
#pragma unroll
            for (int ti = 0; ti < 2; ++ti) for (int i = 0; i < 16; ++i) oacc[ti][i] = 0.f;
            const bf16x8 sb0 = pack8(S[0], S[1], S[2], S[3], S[4], S[5], S[6], S[7]), sb1 = pack8(S[8], S[9], S[10], S[11], S[12], S[13], S[14], S[15]);
            oacc[0] = MFMA32(cur.qa00, sb0, oacc[0]); oacc[0] = MFMA32(cur.qa01, sb1, oacc[0]);
            oacc[1] = MFMA32(cur.qa10, sb0, oacc[1]); oacc[1] = MFMA32(cur.qa11, sb1, oacc[1]);
            bf16x8 vb[4];
#pragma unroll
            for (int ss = 0; ss < 4; ++ss) vb[ss] = *(const LAS bf16x8*)(vt + l31 * VT_PITCH + 32 * ss + 16 * h);
            { const bf16x8 vbp = ssp == 0 ? vb[0] : ssp == 1 ? vb[1] : ssp == 2 ? vb[2] : vb[3];
              if (tip == 0) oacc[0] = MFMA32(cur.pa, vbp, oacc[0]); else oacc[1] = MFMA32(cur.pa, vbp, oacc[1]); }
            { const LAS float* gp = GD + (c & 1) * 256 + 32 * wave + 4 * h; const f32x4 g0 = *(const LAS f32x4*)gp, g1 = *(const LAS f32x4*)(gp + 8), g2 = *(const LAS f32x4*)(gp + 16), g3 = *(const LAS f32x4*)(gp + 24);
#pragma unroll
              for (int i = 0; i < 4; ++i) { S[i] *= g0[i]; S[4 + i] *= g1[i]; S[8 + i] *= g2[i]; S[12 + i] *= g3[i]; } }
            S = MFMA32(cur.kd0, vb[0], S); S = MFMA32(cur.kd1, vb[1], S); S = MFMA32(cur.kd2, vb[2], S); S = MFMA32(cur.kd3, vb[3], S);
#pragma unroll
            for (int ti = 0; ti < 2; ++ti)
#pragma unroll
                for (int r = 0; r < 16; ++r) RED[(wave * 64 + 32 * ti + crow(r, h)) * 32 + l31] = oacc[ti][r];
            LDS_BARRIER();
            { const int t = tid >> 3, v4 = (tid & 7) * 4; f32x4 o = {0.f, 0.f, 0.f, 0.f};
#pragma unroll
              for (int w = 0; w < 8; ++w) o += *(const LAS f32x4*)(RED + (w * 64 + t) * 32 + v4);
              *(f32x4*)(ORAW + (size_t)(R0 + t) * 2048 + hd * 512 + v0 + v4) = o;
              float q = (o.x * o.x + o.y * o.y) + (o.z * o.z + o.w * o.w);
              q += __shfl_xor(q, 1); q += __shfl_xor(q, 2); q += __shfl_xor(q, 4);
              if ((tid & 7) == 0) SSQ[(size_t)(R0 + t) * 64 + hd * 16 + vs] = q; }
            cur = nxt;
        }
        __syncthreads();
    }
}

__device__ __forceinline__ void phase_gla_post(const Params& p, int gw, int ngw, int lane) {
    const bf16_t* PROJ = (const bf16_t*)(p.ws + WS_PROJ); const float* ORAW = (const float*)(p.ws + WS_ORAW); const float* SSQ = (const float*)(p.ws + WS_SSQ); bf16_t* O = (bf16_t*)(p.ws + WS_O);
    const f32x4 gn0 = *(const f32x4*)(p.gla_norm + 8 * lane), gn1 = *(const f32x4*)(p.gla_norm + 8 * lane + 4);
    for (int u = gw; u < MTOK * 4; u += ngw) { const int row = u >> 2, hd = u & 3;
        float ss = 0.f;
#pragma unroll
        for (int i = 0; i < 4; ++i) { const f32x4 s4 = *(const f32x4*)(SSQ + (size_t)row * 64 + hd * 16 + 4 * i); ss += (s4.x + s4.y) + (s4.z + s4.w); }
        const float rstd = 1.0f / sqrtf(ss * (1.0f / 512.0f) + EPS);
        const f32x4 o0 = *(const f32x4*)(ORAW + (size_t)row * 2048 + hd * 512 + 8 * lane), o1 = *(const f32x4*)(ORAW + (size_t)row * 2048 + hd * 512 + 8 * lane + 4);
        const u32x4 gr = *(const u32x4*)(PROJ + (size_t)row * AB_MAIN + PJ_GG + hd * 512 + 8 * lane);
        float g[8] = {bflo(gr.x), bfhi(gr.x), bflo(gr.y), bfhi(gr.y), bflo(gr.z), bfhi(gr.z), bflo(gr.w), bfhi(gr.w)};
        float o[8] = {o0.x * gn0.x, o0.y * gn0.y, o0.z * gn0.z, o0.w * gn0.w, o1.x * gn1.x, o1.y * gn1.y, o1.z * gn1.z, o1.w * gn1.w};
#pragma unroll
        for (int i = 0; i < 8; ++i) o[i] = o[i] * rstd * g[i] * __builtin_amdgcn_rcpf(1.0f + __expf(-g[i]));
        u32x4 w; w.x = cvt_pk_bf16(o[0], o[1]); w.y = cvt_pk_bf16(o[2], o[3]); w.z = cvt_pk_bf16(o[4], o[5]); w.w = cvt_pk_bf16(o[6], o[7]);
        *(u32x4*)(O + (size_t)row * DM + hd * 512 + 8 * lane) = w; }
}

constexpr int AK_PITCH = 272, AV_PITCH = 320;
constexpr int AK_BYTES = 64 * AK_PITCH, AV_BYTES = 64 * AV_PITCH;
constexpr int A_KOFF = 0, A_VOFF = 2 * AK_BYTES, A_COFF = A_VOFF + 2 * AV_BYTES, A_FLAGS = A_COFF + 512;
constexpr float ATT_SCALE = 0.08838834764831845f;
constexpr float LOG2E = 1.4426950408889634f;

struct AttnIO { const bf16_t* Q; const bf16_t* K; const bf16_t* V; int ld; bf16_t* O; int ldo; };

__device__ __forceinline__ void attn_stage_load(const AttnIO& io, size_t rowbase, int hd, int key0, u32x4 (&kr)[2], u32x4 (&vr)[2], int tid) {
#pragma unroll
    for (int i = 0; i < 2; ++i) { const int idx = tid + NTHR * i, r = idx >> 4, ch = idx & 15; const size_t off = (rowbase + key0 + r) * (size_t)io.ld + hd * 128 + ch * 8;
        kr[i] = *(const u32x4*)(io.K + off); vr[i] = *(const u32x4*)(io.V + off); }
}
__device__ __forceinline__ void attn_stage_store(LAS unsigned char* lds, int buf, const u32x4 (&kr)[2], const u32x4 (&vr)[2], int tid) {
#pragma unroll
    for (int i = 0; i < 2; ++i) { const int idx = tid + NTHR * i, r = idx >> 4, ch = idx & 15;
        *(LAS u32x4*)(lds + A_KOFF + buf * AK_BYTES + r * AK_PITCH + ch * 16) = kr[i]; *(LAS u32x4*)(lds + A_VOFF + buf * AV_BYTES + r * AV_PITCH + ch * 16) = vr[i]; }
}
__device__ __forceinline__ void attn_qk(LAS unsigned char* lds, int buf, const bf16x8 (&qf)[8], f32x16& s0, f32x16& s1, int lane) {
    const LAS unsigned char* kp = lds + A_KOFF + buf * AK_BYTES + (lane & 31) * AK_PITCH + (lane >> 5) * 16;
    for (int i = 0; i < 16; ++i) { s0[i] = 0.f; s1[i] = 0.f; }
#pragma unroll
    for (int s = 0; s < 8; ++s) { const bf16x8 a0 = *(const LAS bf16x8*)(kp + 32 * s), a1 = *(const LAS bf16x8*)(kp + 32 * AK_PITCH + 32 * s);
        s0 = MFMA32(a0, qf[s], s0); s1 = MFMA32(a1, qf[s], s1); }
}
__device__ __forceinline__ void attn_pv(LAS unsigned char* lds, int buf, const f32x16& p0, const f32x16& p1, f32x16 (&o)[4], int lane) {
    const lds_cptr vp = (lds_cptr)(lds + A_VOFF + buf * AV_BYTES + (4 * (lane >> 5) + ((lane & 15) >> 2)) * AV_PITCH + (((lane >> 4) & 1) * 16 + (lane & 3) * 4) * 2);
    const bf16x8 pf00 = pack8(p0[0], p0[1], p0[2], p0[3], p0[4], p0[5], p0[6], p0[7]), pf01 = pack8(p0[8], p0[9], p0[10], p0[11], p0[12], p0[13], p0[14], p0[15]);
    const bf16x8 pf10 = pack8(p1[0], p1[1], p1[2], p1[3], p1[4], p1[5], p1[6], p1[7]), pf11 = pack8(p1[8], p1[9], p1[10], p1[11], p1[12], p1[13], p1[14], p1[15]);
#pragma unroll
    for (int dt = 0; dt < 4; ++dt) {
        const bf16x8 a00 = cat4(vtr(vp + (0) * AV_PITCH + dt * 64), vtr(vp + (8) * AV_PITCH + dt * 64));
        const bf16x8 a01 = cat4(vtr(vp + (16) * AV_PITCH + dt * 64), vtr(vp + (24) * AV_PITCH + dt * 64));
        const bf16x8 a10 = cat4(vtr(vp + (32) * AV_PITCH + dt * 64), vtr(vp + (40) * AV_PITCH + dt * 64));
        const bf16x8 a11 = cat4(vtr(vp + (48) * AV_PITCH + dt * 64), vtr(vp + (56) * AV_PITCH + dt * 64));
        o[dt] = MFMA32(a00, pf00, o[dt]); o[dt] = MFMA32(a01, pf01, o[dt]); o[dt] = MFMA32(a10, pf10, o[dt]); o[dt] = MFMA32(a11, pf11, o[dt]);
    }
}
__device__ __forceinline__ void attn_store_o(const AttnIO& io, size_t row, int hd, const f32x16 (&o)[4], float scl, int lane) {
    bf16_t* op = io.O + row * (size_t)io.ldo + hd * 128 + 4 * (lane >> 5);
#pragma unroll
    for (int dt = 0; dt < 4; ++dt)
#pragma unroll
        for (int g = 0; g < 4; ++g) { u32x2 w; w.x = cvt_pk_bf16(o[dt][4 * g] * scl, o[dt][4 * g + 1] * scl); w.y = cvt_pk_bf16(o[dt][4 * g + 2] * scl, o[dt][4 * g + 3] * scl);
            *(u32x2*)(op + 32 * dt + 8 * g) = w; }
}

__device__ __forceinline__ void fox_unit(const AttnIO& io, const float* CF, LAS unsigned char* lds, int b, int hd, int qb, int wave, int lane) {
    const int tid = threadIdx.x, h = lane >> 5, l31 = lane & 31;
    const size_t rowbase = (size_t)b * SEQ; const int q0w = 256 * qb + 32 * wave, qpos = q0w + l31;
    const float* cf = CF + (size_t)(b * 16 + hd) * SEQ;
    bf16x8 qf[8];
#pragma unroll
    for (int s = 0; s < 8; ++s) qf[s] = *(const bf16x8*)(io.Q + (rowbase + qpos) * (size_t)io.ld + hd * 128 + 16 * s + 8 * h);
    const float cq = cf[qpos] * LOG2E;
    f32x16 o[4];
#pragma unroll
    for (int dt = 0; dt < 4; ++dt) for (int i = 0; i < 16; ++i) o[dt][i] = 0.f;
    float m = -1e30f, l = 0.f;
    const int ntiles = 4 * qb + 4;
    u32x4 kr[2], vr[2];
    LAS float* cks = (LAS float*)(lds + A_COFF);
    attn_stage_load(io, rowbase, hd, 64 * (ntiles - 1), kr, vr, tid);
    attn_stage_store(lds, 0, kr, vr, tid);
    if (tid < 64) cks[tid] = cf[64 * (ntiles - 1) + tid] * LOG2E;
    __syncthreads();
    for (int jj = 0; jj < ntiles; ++jj) {
        const int j = ntiles - 1 - jj, buf = jj & 1; const bool more = jj + 1 < ntiles;
        float cnext = 0.f;
        if (more) { attn_stage_load(io, rowbase, hd, 64 * (j - 1), kr, vr, tid); if (tid < 64) cnext = cf[64 * (j - 1) + tid] * LOG2E; }
        if (64 * j <= q0w + 31) {
            f32x16 s0, s1; attn_qk(lds, buf, qf, s0, s1, lane);
            const LAS float* ck = cks + buf * 64;
            const bool diag = 64 * j + 63 > q0w;
            float mx = -__builtin_inff();
#pragma unroll
            for (int g = 0; g < 4; ++g) { const f32x4 c0 = *(const LAS f32x4*)(ck + 8 * g + 4 * h), c1 = *(const LAS f32x4*)(ck + 32 + 8 * g + 4 * h);
#pragma unroll
                for (int i = 0; i < 4; ++i) { const int r = 4 * g + i, key = 64 * j + 8 * g + 4 * h + i;
                    float y0 = s0[r] * (ATT_SCALE * LOG2E) + (cq - c0[i]), y1 = s1[r] * (ATT_SCALE * LOG2E) + (cq - c1[i]);
                    if (diag) { y0 = key <= qpos ? y0 : -__builtin_inff(); y1 = key + 32 <= qpos ? y1 : -__builtin_inff(); }
                    s0[r] = y0; s1[r] = y1; mx = fmaxf(mx, fmaxf(y0, y1)); } }
            mx = fmaxf(mx, __shfl_xor(mx, 32));
            if (!__all(mx - m <= 8.0f)) {
                const float mn = fmaxf(m, mx), alpha = __builtin_amdgcn_exp2f(m - mn); m = mn; l *= alpha;
#pragma unroll
                for (int dt = 0; dt < 4; ++dt) for (int i = 0; i < 16; ++i) o[dt][i] *= alpha;
            }
            float ps = 0.f;
#pragma unroll
            for (int r = 0; r < 16; ++r) { s0[r] = __builtin_amdgcn_exp2f(s0[r] - m); s1[r] = __builtin_amdgcn_exp2f(s1[r] - m); ps += s0[r] + s1[r]; }
            l += ps;
            attn_pv(lds, buf, s0, s1, o, lane);
        }
        if (more) { attn_stage_store(lds, buf ^ 1, kr, vr, tid); if (tid < 64) cks[(buf ^ 1) * 64 + tid] = cnext; }
        __syncthreads();
    }
    l += __shfl_xor(l, 32);
    attn_store_o(io, rowbase + qpos, hd, o, 1.0f / l, lane);
}

__device__ __forceinline__ void sb_subtile(f32x16& s, int keybase, int qpos, int h, float& P, bool diag) {
    float be[16], om[16];
#pragma unroll
    for (int r = 0; r < 16; r += 2) {
        const float za = s[r] * (ATT_SCALE * LOG2E), zb = s[r + 1] * (ATT_SCALE * LOG2E); const float ta = __builtin_amdgcn_exp2f(-fabsf(za)), tb = __builtin_amdgcn_exp2f(-fabsf(zb));
        const float da = 1.0f + ta, db = 1.0f + tb, R2 = __builtin_amdgcn_rcpf(da * db); const float rra = db * R2, rrb = da * R2, tra = ta * rra, trb = tb * rrb;
        const bool pa = za >= 0.f, pb = zb >= 0.f; be[r] = pa ? rra : tra; om[r] = pa ? tra : rra; be[r + 1] = pb ? rrb : trb; om[r + 1] = pb ? trb : rrb;
        if (diag) { const bool va = keybase + crow(r, h) < qpos, vb = keybase + crow(r + 1, h) < qpos; be[r] = va ? be[r] : 0.f; om[r] = va ? om[r] : 1.0f; be[r + 1] = vb ? be[r + 1] : 0.f; om[r + 1] = vb ? om[r + 1] : 1.0f; } }
    float T[4], Tp[4];
#pragma unroll
    for (int g = 0; g < 4; ++g) { T[g] = (om[4 * g] * om[4 * g + 1]) * (om[4 * g + 2] * om[4 * g + 3]); Tp[g] = __shfl_xor(T[g], 32); }
    float run = P;
#pragma unroll
    for (int g = 3; g >= 0; --g) {
        const float off = h ? run : run * Tp[g];
        const float sf2 = om[4 * g + 3], sf1 = sf2 * om[4 * g + 2], sf0 = sf1 * om[4 * g + 1];
        s[4 * g + 3] = be[4 * g + 3] * off; s[4 * g + 2] = be[4 * g + 2] * (off * sf2); s[4 * g + 1] = be[4 * g + 1] * (off * sf1); s[4 * g] = be[4 * g] * (off * sf0);
        run *= T[g] * Tp[g];
    }
    P = run;
}
__device__ __forceinline__ void sb_unit(const AttnIO& io, LAS unsigned char* lds, int b, int hd, int qb, int wave, int lane) {
    const int tid = threadIdx.x, h = lane >> 5, l31 = lane & 31;
    const size_t rowbase = (size_t)b * SEQ; const int qpos = 256 * qb + 32 * wave + l31;
    bf16x8 qf[8];
#pragma unroll
    for (int s = 0; s < 8; ++s) qf[s] = *(const bf16x8*)(io.Q + (rowbase + qpos) * (size_t)io.ld + hd * 128 + 16 * s + 8 * h);
    f32x16 o[4];
#pragma unroll
    for (int dt = 0; dt < 4; ++dt) for (int i = 0; i < 16; ++i) o[dt][i] = 0.f;
    float R = 1.0f;
    bool wdone = false;
    const int ntiles = 4 * qb + 4;
    u32x4 kr[2], vr[2];
    LAS unsigned* flags = (LAS unsigned*)(lds + A_FLAGS);
    attn_stage_load(io, rowbase, hd, 64 * (ntiles - 1), kr, vr, tid);
    attn_stage_store(lds, 0, kr, vr, tid);
    if (ntiles > 1) attn_stage_load(io, rowbase, hd, 64 * (ntiles - 2), kr, vr, tid);
    __syncthreads();
    for (int jj = 0; jj < ntiles; ++jj) {
        const int j = ntiles - 1 - jj, buf = jj & 1;
        if (jj + 1 < ntiles) attn_stage_store(lds, buf ^ 1, kr, vr, tid);
        if (jj + 2 < ntiles) attn_stage_load(io, rowbase, hd, 64 * (j - 2), kr, vr, tid);
        if (!wdone && 64 * j < 256 * qb + 32 * wave + 31) {
            f32x16 s0, s1; attn_qk(lds, buf, qf, s0, s1, lane);
            const bool diag = 64 * j + 63 >= 256 * qb + 32 * wave;
            if (64 * j + 32 < 256 * qb + 32 * wave + 31) sb_subtile(s1, 64 * j + 32, qpos, h, R, diag);
            else { for (int i = 0; i < 16; ++i) s1[i] = 0.f; }
            sb_subtile(s0, 64 * j, qpos, h, R, diag);
            attn_pv(lds, buf, s0, s1, o, lane);
            wdone = __all(R == 0.0f);
        }
        if (lane == 0) flags[buf * 8 + wave] = wdone ? 1u : 0u;
        __syncthreads();
        { const u32x4 f0 = *(const LAS u32x4*)(flags + buf * 8), f1 = *(const LAS u32x4*)(flags + buf * 8 + 4);
          if ((f0.x & f0.y & f0.z & f0.w & f1.x & f1.y & f1.z & f1.w) != 0u) break; }
    }
    attn_store_o(io, rowbase + qpos, hd, o, 1.0f, lane);
}

constexpr int RG_XPITCH = 528;
constexpr int RG_XC = 0, RG_GX = 128 * RG_XPITCH, RG_GA = RG_GX + 128 * 32 * 4, RG_HB = RG_GA + 128 * 32 * 4, RG_CW = RG_HB + 128 * 32 * 4, RG_SPL = RG_CW + 5 * 256 * 4, RG_SA = RG_SPL + 128, RG_SB = RG_SA + 2048, RG_HS = RG_SB + 2048, RG_HIN = RG_HS + 256;
__device__ __forceinline__ float gelu_tanh(float x) { const float u = 0.7978845608028654f * (x + 0.044715f * x * x * x); const float e = __expf(2.0f * u); const float th = 1.0f - 2.0f * __builtin_amdgcn_rcpf(e + 1.0f); return 0.5f * x * (1.0f + th); }
__device__ __forceinline__ void rg_load_raw(const bf16_t* PROJ, size_t rowb, int T0, int tg, int cb, int cc, u32x4 (&raw)[11]) {
    const bf16_t* base = PROJ + (rowb + T0 + 8 * tg) * CD_IN + PJ_RX + cb + 8 * cc;
#pragma unroll
    for (int i = 0; i < 11; ++i) { const int t = T0 + 8 * tg - 3 + i; if (t >= 0) raw[i] = *(const u32x4*)(base + (ptrdiff_t)(i - 3) * CD_IN); else raw[i] = (u32x4){0u, 0u, 0u, 0u}; }
}
__device__ __forceinline__ void phase_rg(const Params& p, LAS unsigned char* lds, int wave, int lane) {
    const unsigned char* ws = p.ws;
    const bf16_t* PROJ = (const bf16_t*)(ws + WS_PROJ); const bf16_t* WRG = (const bf16_t*)(ws + WS_WRG); bf16_t* O = (bf16_t*)(p.ws + WS_O);
    const int tid = threadIdx.x, h = lane >> 5, l31 = lane & 31;
    LAS float* GX = (LAS float*)(lds + RG_GX); LAS float* GA = (LAS float*)(lds + RG_GA); LAS float* HB = (LAS float*)(lds + RG_HB); LAS float* CW = (LAS float*)(lds + RG_CW); LAS float* SPL = (LAS float*)(lds + RG_SPL); LAS float* SA = (LAS float*)(lds + RG_SA); LAS float* SB = (LAS float*)(lds + RG_SB); LAS float* HS = (LAS float*)(lds + RG_HS); LAS float* HIN = (LAS float*)(lds + RG_HIN);
    const int cc = tid & 31, tg = tid >> 5;
    const int et = tid >> 2, ej = (tid & 3) * 8;
    for (int u0 = blockIdx.x; u0 < NB * 8 * 8; u0 += gridDim.x) {
        const int unit = xcd_swz(u0, NB * 8 * 8);
        const int b = unit >> 6, g = (unit >> 3) & 7, js = unit & 7, cb = 256 * g, c0 = cb + 32 * js;
        const size_t rowb = (size_t)b * SEQ;
        const int gate = wave >> 2, ti = wave & 3;
        bf16x8 wf[16];
        { const bf16_t* wp = WRG + ((size_t)(gate * 8 + g) * 256 + 32 * js + l31) * 256 + 8 * h;
#pragma unroll
          for (int s = 0; s < 16; ++s) wf[s] = *(const bf16x8*)(wp + 16 * s); }
        const float gbias = (gate ? p.rg_b_a : p.rg_b_x)[c0 + l31];
        for (int i = tid; i < 5 * 256; i += NTHR) { const int j = i >> 8, c = i & 255; CW[i] = j < 4 ? p.rg_conv_w[j * 2048 + cb + c] : p.rg_conv_b[cb + c]; }
        if (tid < 32) { const float lam = p.rg_lambda[c0 + tid]; SPL[tid] = -8.0f * LOG2E * (fmaxf(-lam, 0.f) + log1pf(expf(-fabsf(lam)))); }
        u32x4 raw[11];
        rg_load_raw(PROJ, rowb, 0, tg, cb, cc, raw);
        if (tid < 32) HS[tid] = 0.f;
        __syncthreads();
        for (int tt = 0; tt < SEQ / 128; ++tt) {
            const int T0 = 128 * tt; const size_t R0 = rowb + T0;
            const u32x4 ryraw = *(const u32x4*)(PROJ + (R0 + et) * CD_IN + PJ_RY + c0 + ej);
            { float w0[8], w1[8], w2[8], w3[8], bb[8];
#pragma unroll
              for (int q = 0; q < 2; ++q) { const f32x4 a0 = *(const LAS f32x4*)(CW + 0 * 256 + 8 * cc + 4 * q), a1 = *(const LAS f32x4*)(CW + 1 * 256 + 8 * cc + 4 * q), a2 = *(const LAS f32x4*)(CW + 2 * 256 + 8 * cc + 4 * q),
                                                          a3 = *(const LAS f32x4*)(CW + 3 * 256 + 8 * cc + 4 * q), a4 = *(const LAS f32x4*)(CW + 4 * 256 + 8 * cc + 4 * q);
#pragma unroll
                  for (int e = 0; e < 4; ++e) { w0[4 * q + e] = a0[e]; w1[4 * q + e] = a1[e]; w2[4 * q + e] = a2[e]; w3[4 * q + e] = a3[e]; bb[4 * q + e] = a4[e]; } }
#pragma unroll
              for (int i = 0; i < 8; ++i) { float xo[8];
#pragma unroll
                  for (int e2 = 0; e2 < 4; ++e2) { const unsigned r0 = raw[i][e2], r1 = raw[i + 1][e2], r2 = raw[i + 2][e2], r3 = raw[i + 3][e2];
                      f32x2 a2 = (f32x2){bb[2 * e2], bb[2 * e2 + 1]};
                      a2 = (f32x2){w0[2 * e2], w0[2 * e2 + 1]} * (f32x2){bflo(r0), bfhi(r0)} + a2; a2 = (f32x2){w1[2 * e2], w1[2 * e2 + 1]} * (f32x2){bflo(r1), bfhi(r1)} + a2;
                      a2 = (f32x2){w2[2 * e2], w2[2 * e2 + 1]} * (f32x2){bflo(r2), bfhi(r2)} + a2; a2 = (f32x2){w3[2 * e2], w3[2 * e2 + 1]} * (f32x2){bflo(r3), bfhi(r3)} + a2;
                      xo[2 * e2] = a2.x; xo[2 * e2 + 1] = a2.y; }
                  u32x4 o; o.x = cvt_pk_bf16(xo[0], xo[1]); o.y = cvt_pk_bf16(xo[2], xo[3]); o.z = cvt_pk_bf16(xo[4], xo[5]); o.w = cvt_pk_bf16(xo[6], xo[7]);
                  *(LAS u32x4*)(lds + RG_XC + (8 * tg + i) * RG_XPITCH + 16 * cc) = o; } }
            if (tt + 1 < SEQ / 128) rg_load_raw(PROJ, rowb, T0 + 128, tg, cb, cc, raw);
            LDS_BARRIER();
            { f32x16 acc; for (int i = 0; i < 16; ++i) acc[i] = 0.f;
              const LAS unsigned char* ap = lds + RG_XC + (32 * ti + l31) * RG_XPITCH + 16 * h;
#pragma unroll
              for (int s = 0; s < 16; ++s) { const bf16x8 a = *(const LAS bf16x8*)(ap + 32 * s); acc = MFMA32(a, wf[s], acc); }
              LAS float* gout = gate ? GA : GX;
#pragma unroll
              for (int r = 0; r < 16; ++r) { const float v = acc[r] + gbias; gout[(32 * ti + crow(r, h)) * 32 + l31] = __builtin_amdgcn_rcpf(1.0f + __expf(-v)); } }
            LDS_BARRIER();
            { const u32x4 xr = *(const LAS u32x4*)(lds + RG_XC + et * RG_XPITCH + 2 * (32 * js + ej));
              const float xc[8] = {bflo(xr.x), bfhi(xr.x), bflo(xr.y), bfhi(xr.y), bflo(xr.z), bfhi(xr.z), bflo(xr.w), bfhi(xr.w)};
#pragma unroll
              for (int q = 0; q < 2; ++q) { f32x4 ga = *(const LAS f32x4*)(GA + et * 32 + ej + 4 * q), gx = *(const LAS f32x4*)(GX + et * 32 + ej + 4 * q); const f32x4 sp = *(const LAS f32x4*)(SPL + ej + 4 * q);
#pragma unroll
                  for (int e = 0; e < 4; ++e) { const float a = __builtin_amdgcn_exp2f(ga[e] * sp[e]); const float mult = sqrtf(fmaxf(1.0f - a * a, 0.f)); ga[e] = a; gx[e] = mult * gx[e] * xc[4 * q + e]; }
                  *(LAS f32x4*)(GA + et * 32 + ej + 4 * q) = ga; *(LAS f32x4*)(GX + et * 32 + ej + 4 * q) = gx; } }
            LDS_BARRIER();
            { int tq = tid; asm volatile("" : "+v"(tq));
              const int sg = tq >> 5, sc = tq & 31; float A = 1.0f, Bv = 0.f;
              { float av[8], uv[8];
#pragma unroll
                for (int i = 0; i < 8; ++i) { av[i] = GA[(8 * sg + i) * 32 + sc]; uv[i] = GX[(8 * sg + i) * 32 + sc]; }
#pragma unroll
                for (int i = 0; i < 8; ++i) { Bv = av[i] * Bv + uv[i]; A *= av[i]; } }
              SA[sg * 32 + sc] = A; SB[sg * 32 + sc] = Bv;
              LDS_BARRIER();
              if (tq < 32) {
                  float ga[16], gb[16]; float hc = HS[(tt & 1) * 32 + tq];
#pragma unroll
                  for (int gg = 0; gg < 16; ++gg) { ga[gg] = SA[gg * 32 + tq]; gb[gg] = SB[gg * 32 + tq]; }
#pragma unroll
                  for (int gg = 0; gg < 16; ++gg) { const float t = hc; hc = ga[gg] * hc + gb[gg]; ga[gg] = t; }
#pragma unroll
                  for (int gg = 0; gg < 16; ++gg) HIN[gg * 32 + tq] = ga[gg];
                  HS[((tt + 1) & 1) * 32 + tq] = hc; }
              LDS_BARRIER();
              float hin = HIN[sg * 32 + sc];
              { float av[8], uv[8];
#pragma unroll
                for (int i = 0; i < 8; ++i) { av[i] = GA[(8 * sg + i) * 32 + sc]; uv[i] = GX[(8 * sg + i) * 32 + sc]; }
#pragma unroll
                for (int i = 0; i < 8; ++i) { hin = av[i] * hin + uv[i]; av[i] = hin; }
#pragma unroll
                for (int i = 0; i < 8; ++i) HB[(8 * sg + i) * 32 + sc] = av[i]; }
            }
            LDS_BARRIER();
            { const float ry[8] = {bflo(ryraw.x), bfhi(ryraw.x), bflo(ryraw.y), bfhi(ryraw.y), bflo(ryraw.z), bfhi(ryraw.z), bflo(ryraw.w), bfhi(ryraw.w)};
              const f32x4 h0 = *(const LAS f32x4*)(HB + et * 32 + ej), h1 = *(const LAS f32x4*)(HB + et * 32 + ej + 4);
              u32x4 o; o.x = cvt_pk_bf16(h0.x * gelu_tanh(ry[0]), h0.y * gelu_tanh(ry[1])); o.y = cvt_pk_bf16(h0.z * gelu_tanh(ry[2]), h0.w * gelu_tanh(ry[3]));
              o.z = cvt_pk_bf16(h1.x * gelu_tanh(ry[4]), h1.y * gelu_tanh(ry[5])); o.w = cvt_pk_bf16(h1.z * gelu_tanh(ry[6]), h1.w * gelu_tanh(ry[7]));
              *(u32x4*)(O + (R0 + et) * DM + c0 + ej) = o; }
        }
        __syncthreads();
    }
}

#ifndef REP_P0
#define REP_P0 1
#endif
#ifndef REP_GEMM
#define REP_GEMM 1
#endif
#ifndef REP_MIX0
#define REP_MIX0 1
#endif
#ifndef REP_MIX1
#define REP_MIX1 1
#endif
#ifndef REP_RES
#define REP_RES 1
#endif
#ifndef REP_RMS
#define REP_RMS 1
#endif
#ifndef MK_N_LAUNCHES
#define MK_N_LAUNCHES 1
#endif
constexpr int N_PHASES = 16;
struct Args { Params p; int li, pad; };

__device__ __forceinline__ void attn_phase_fox(const Params& p, LAS unsigned char* lds, int wave, int lane) {
    const bf16_t* PROJ = (const bf16_t*)(p.ws + WS_PROJ);
    const AttnIO io{PROJ + PJ_FQ, PROJ + PJ_FK, PROJ + PJ_FV, AB_MAIN, (bf16_t*)(p.ws + WS_O) + 2048, DM};
    const float* CF = (const float*)(p.ws + WS_CF);
    for (int p0 = blockIdx.x; p0 < 256; p0 += gridDim.x) { const int pr = xcd_swz(p0, 256), b = pr >> 6, hd = (pr >> 2) & 15, x = pr & 3;
        fox_unit(io, CF, lds, b, hd, 7 - x, wave, lane);
        fox_unit(io, CF, lds, b, hd, x, wave, lane); }
}
__device__ __forceinline__ void attn_phase_sb(const Params& p, LAS unsigned char* lds, int wave, int lane) {
    const bf16_t* PROJ = (const bf16_t*)(p.ws + WS_PROJ);
    const AttnIO io{PROJ + PJ_SQ, PROJ + PJ_SK, PROJ + PJ_SV, CD_IN, (bf16_t*)(p.ws + WS_O) + 2048, DM};
    for (int p0 = blockIdx.x; p0 < 256; p0 += gridDim.x) { const int pr = xcd_swz(p0, 256), b = pr >> 6, hd = (pr >> 2) & 15, x = pr & 3;
        sb_unit(io, lds, b, hd, 7 - x, wave, lane);
        sb_unit(io, lds, b, hd, x, wave, lane); }
}

template <int layer>
__device__ __forceinline__ void layer_phases(const Params& p, LAS unsigned char* lds, const XcdBarrier& bar, int lo, int hi, int G, int gw, int ngw, int wave, int lane) {
    unsigned char* ws = p.ws;
    bf16_t* U = (bf16_t*)(ws + WS_U); bf16_t* PROJ = (bf16_t*)(ws + WS_PROJ); bf16_t* O = (bf16_t*)(ws + WS_O); bf16_t* ACT = (bf16_t*)(ws + WS_ACT); pg8::ssq_t* SSQ = (pg8::ssq_t*)((unsigned*)(ws + WS_CTL) + CW_SSQ);
#define IN(k) (lo <= (k) && (k) < hi)
#ifdef PROBE_SEL
#define SEAM(k) do { if ((k) + 1 < hi) { unsigned long long t0_ = 0; if (threadIdx.x == 0) { t0_ = __builtin_amdgcn_s_memrealtime(); if (blockIdx.x == 0) ((unsigned long long*)(p.ws + WS_CTL + 786432))[2 * (k) + 1] = t0_; } \
    xcd_barrier(bar); if (threadIdx.x == 0) { const unsigned long long t1_ = __builtin_amdgcn_s_memrealtime(); atomicAdd((unsigned*)(p.ws + WS_CTL + 790528) + (k), (unsigned)(t1_ - t0_)); if (blockIdx.x == 0) ((unsigned long long*)(p.ws + WS_CTL + 786432))[2 * (k) + 2] = t1_; } } } while (0)
#else
#define SEAM(k) do { if ((k) + 1 < hi) xcd_barrier(bar); } while (0)
#endif
        constexpr int kb = 1 + 7 * layer;
        if (IN(kb)) {
            if (layer == 0) {
                constexpr int NG = 192;
                pg8::Gemm g{U, (const bf16_t*)(ws + WS_WAB_IN), MTOK, AB_MAIN, DM}; pg8::EpiBf16<true> E{PROJ, AB_MAIN, (const pg8::ssq_t*)(ws + WS_CTL + SSQ0_BYTE_OFF)};
                phase_small32(p, lds, wave, lane); __syncthreads();
                if (G == 256) {
                    if ((int)blockIdx.x < NG) { pg8::StaticOrder S; S.init(MTOK, AB_MAIN, NG, (int)blockIdx.x); pg8::gemm_phase<pg8::EpiBf16<true>, pg8::StaticOrder, true, true>(lds, g, S, E); }
                    else p0b_convert(p, lds, ((int)blockIdx.x - NG) * NWAVES + wave, (G - NG) * NWAVES, wave, lane);
                } else {
                    p0b_convert(p, lds, gw, ngw, wave, lane); __syncthreads();
                    pg8::StaticOrder S; S.init(MTOK, AB_MAIN, G, (int)blockIdx.x); pg8::gemm_phase<pg8::EpiBf16<true>, pg8::StaticOrder, true, true>(lds, g, S, E);
                }
            } else {
                pg8::Gemm g{U, (const bf16_t*)(ws + WS_WCD_IN), MTOK, CD_IN, DM}; pg8::StaticOrder S; S.init(MTOK, CD_IN, G, (int)blockIdx.x);
                pg8::EpiBf16<true> E{PROJ, CD_IN, SSQ + 1 * MTOK};
                for (int rep = 0; rep < REP_GEMM; ++rep) { pg8::gemm_phase<pg8::EpiBf16<true>, pg8::StaticOrder, true, true>(lds, g, S, E); __syncthreads(); }
            }
            SEAM(kb);
        }
        if (layer == 0 && IN(kb + 1)) { for (int rep = 0; rep < (REP_MIX0 == 5 ? 2 : 1); ++rep) { phase_fox_cumsum(p, lds, wave, lane); phase_gla_pre(p, lds, wave, lane); } SEAM(kb + 1); }
        if (IN(kb + 2)) {
            if (layer == 0) { phase_gla_seq(p, lds, wave, lane); __syncthreads();
#ifdef PROBE_SEL
                if (blockIdx.x == 0 && threadIdx.x == 0) ((unsigned long long*)(p.ws + WS_CTL + 786432))[41] = __builtin_amdgcn_s_memrealtime();
#endif
                attn_phase_fox(p, lds, wave, lane); __syncthreads();
#if REP_MIX0 == 3
 attn_phase_fox(p, lds, wave, lane); __syncthreads();
#endif
#if REP_MIX0 == 4
 phase_gla_seq(p, lds, wave, lane); __syncthreads();
#endif
 }
            else { phase_rg(p, lds, wave, lane); __syncthreads();
#ifdef PROBE_SEL
                if (blockIdx.x == 0 && threadIdx.x == 0) ((unsigned long long*)(p.ws + WS_CTL + 786432))[40] = __builtin_amdgcn_s_memrealtime();
#endif
                attn_phase_sb(p, lds, wave, lane); __syncthreads();
#if REP_MIX1 == 2
 phase_rg(p, lds, wave, lane); __syncthreads(); attn_phase_sb(p, lds, wave, lane); __syncthreads();
#endif
#if REP_MIX1 == 3
 phase_rg(p, lds, wave, lane); __syncthreads();
#endif
 }
            SEAM(kb + 2);
        }
        if (layer == 0 && IN(kb + 3)) { for (int rep = 0; rep < (REP_MIX0 == 6 ? 2 : 1); ++rep) phase_gla_post(p, gw, ngw, lane); SEAM(kb + 3); }
        if (IN(kb + 4)) {
            pg8::Gemm g{O, (const bf16_t*)(ws + (layer ? WS_WCD_OUT : WS_WAB_OUT)), MTOK, DM, DM}; pg8::StaticOrder S; S.init(MTOK, DM, G, (int)blockIdx.x);
#if REP_RES == 2
            { pg8::EpiRes<false> E{U, (bf16_t*)(ws + WS_ORAW), DM, (pg8::ssq_t*)(ws + WS_SSQ)}; pg8::gemm_phase<pg8::EpiRes<false>, pg8::StaticOrder, true, true>(lds, g, S, E); __syncthreads(); }
#endif
            { pg8::EpiRes<false> E{U, U, DM, SSQ + (2 * layer) * MTOK}; pg8::gemm_phase<pg8::EpiRes<false>, pg8::StaticOrder, true, true>(lds, g, S, E); }
            SEAM(kb + 4);
        }
        if (IN(kb + 5)) {
            pg8::Gemm g{U, (const bf16_t*)(ws + (layer ? WS_WGU1 : WS_WGU0)), MTOK, 2 * DFF, DM}; pg8::StaticOrder S; S.init(MTOK, 2 * DFF, G, (int)blockIdx.x);
            pg8::EpiSwiGLU E{ACT, DFF, SSQ + (2 * layer) * MTOK};
            for (int rep = 0; rep < REP_GEMM; ++rep) { pg8::gemm_phase<pg8::EpiSwiGLU, pg8::StaticOrder, true, true>(lds, g, S, E); __syncthreads(); }
            if (layer == 0) { const int rem = (MTOK / 256) * (2 * DFF / 256) % G, c = (int)blockIdx.x;
                if (rem == 0) tail_convert(p, lds, c * NWAVES + wave, G * NWAVES, wave, lane); else if (c >= rem) tail_convert(p, lds, (c - rem) * NWAVES + wave, (G - rem) * NWAVES, wave, lane); }
            else { const int rem = (MTOK / 256) * (2 * DFF / 256) % G, c = (int)blockIdx.x;
                if (rem == 0) tail1_convert(p, lds, c * NWAVES + wave, G * NWAVES, wave, lane); else if (c >= rem) tail1_convert(p, lds, (c - rem) * NWAVES + wave, (G - rem) * NWAVES, wave, lane); }
            SEAM(kb + 5);
        }
        if (IN(kb + 6)) {
            pg8::Gemm g{ACT, (const bf16_t*)(ws + (layer ? WS_WDN1 : WS_WDN0)), MTOK, DM, DFF}; pg8::StaticOrder S; S.init(MTOK, DM, G, (int)blockIdx.x);
#if REP_RES == 2
            { pg8::EpiRes<false> E{U, (bf16_t*)(ws + WS_ORAW), DM, (pg8::ssq_t*)(ws + WS_SSQ)}; pg8::gemm_phase<pg8::EpiRes<false>, pg8::StaticOrder, true, true>(lds, g, S, E); __syncthreads(); }
#endif
            pg8::EpiRes<false> E{U, U, DM, SSQ + (2 * layer + 1) * MTOK};
            pg8::gemm_phase<pg8::EpiRes<false>, pg8::StaticOrder, true, true>(lds, g, S, E);
            SEAM(kb + 6);
        }
#undef IN
#undef SEAM
}

__global__ void __launch_bounds__(NTHR, 2) hybrid_fwd(Args args) {
    extern __shared__ __attribute__((aligned(16))) unsigned char lds_raw[];
    LAS unsigned char* lds = (LAS unsigned char*)lds_raw;
    const Params& p = args.p;
    const int tid = threadIdx.x, lane = tid & 63, wave = __builtin_amdgcn_readfirstlane(tid >> 6);
    const int G = gridDim.x, gw = blockIdx.x * NWAVES + wave, ngw = G * NWAVES;
    for (int u = tid; u < (LDS_BYTES - LDSCTL_OFF) / 4; u += NTHR) ((LAS unsigned*)(lds + LDSCTL_OFF))[u] = 0u;
    __syncthreads();
    unsigned* ctl = (unsigned*)(p.ws + WS_CTL);
    XcdBarrier bar = xcd_barrier_post(ctl + CW_BAR + args.li * XCD_BAR_WORDS, (volatile LAS unsigned*)(lds + MISC_OFF) + 8);
    const int lo = p.ph_lo, hi = p.ph_hi;
#define IN(k) (lo <= (k) && (k) < hi)
#ifdef PROBE_SEL
#define SEAM(k) do { if ((k) + 1 < hi) { unsigned long long t0_ = 0; if (threadIdx.x == 0) { t0_ = __builtin_amdgcn_s_memrealtime(); if (blockIdx.x == 0) ((unsigned long long*)(p.ws + WS_CTL + 786432))[2 * (k) + 1] = t0_; } \
    xcd_barrier(bar); if (threadIdx.x == 0) { const unsigned long long t1_ = __builtin_amdgcn_s_memrealtime(); atomicAdd((unsigned*)(p.ws + WS_CTL + 790528) + (k), (unsigned)(t1_ - t0_)); if (blockIdx.x == 0) ((unsigned long long*)(p.ws + WS_CTL + 786432))[2 * (k) + 2] = t1_; } } } while (0)
#else
#define SEAM(k) do { if ((k) + 1 < hi) xcd_barrier(bar); } while (0)
#endif
    if (IN(0)) { for (int rep = 0; rep < REP_P0; ++rep) { phase_p0(p, lds, gw, ngw, wave, lane); __syncthreads(); } SEAM(0); }

    layer_phases<0>(p, lds, bar, lo, hi, G, gw, ngw, wave, lane);
    layer_phases<1>(p, lds, bar, lo, hi, G, gw, ngw, wave, lane);
#ifdef PROBE_SEL
    float probe_eps = 0.f;
    if (IN(15)) { const unsigned long long* ts = (const unsigned long long*)(p.ws + WS_CTL + 786432); const unsigned* wsum = (const unsigned*)(p.ws + WS_CTL + 790528); float val_us;
        if (PROBE_SEL < 100) val_us = (float)wsum[PROBE_SEL] * (0.01f / 256.0f);
        else if (PROBE_SEL == 100) { unsigned s = 0; for (int i = 0; i < 15; ++i) s += wsum[i]; val_us = (float)s * (0.01f / 256.0f); }
        else if (PROBE_SEL == 101) { const unsigned s = wsum[1] + wsum[5] + wsum[6] + wsum[7] + wsum[8] + wsum[12] + wsum[13] + wsum[14]; val_us = (float)s * (0.01f / 256.0f); }
        else if (PROBE_SEL == 400) val_us = (float)(ts[40] - ts[18]) * 0.01f;
        else if (PROBE_SEL == 401) val_us = (float)(ts[41] - ts[6]) * 0.01f;
        else if (PROBE_SEL >= 300) val_us = (float)(ts[2 * (PROBE_SEL - 300) + 2] - ts[2 * (PROBE_SEL - 300) + 1]) * 0.01f;
        else { unsigned long long st = ts[2 * (PROBE_SEL - 200)]; if (st == 0ull) st = ts[2 * (PROBE_SEL - 200) - 2]; val_us = (float)(ts[2 * (PROBE_SEL - 200) + 1] - st) * 0.01f; }
        probe_eps = sqrtf(val_us * PROBE_SCALE); }
#define FINAL_SCALE (1.0f + probe_eps)
#else
#define FINAL_SCALE 1.0f
#endif
    if (IN(15)) phase_final_norm((const bf16_t*)(p.ws + WS_U), (const unsigned long long*)((const unsigned*)(p.ws + WS_CTL) + CW_SSQ) + 3 * MTOK, p.final_norm, p.out, gw, ngw, lane, FINAL_SCALE);
#undef IN
#undef SEAM
}

extern "C" void kernel_launch(void* const* d_in, const int* in_sizes, int n_in, void* d_out, int out_size, void* d_ws, size_t ws_size, hipStream_t stream) {
    static int grid = 0;
    if (grid == 0) {
        if (n_in != 22 || in_sizes[0] != MTOK * DM || out_size != MTOK * DM || ws_size < WS_END) {
            fprintf(stderr, "kernel_launch: unexpected problem (n_in %d, in0 %d, out %d, ws %zu, need %zu); nothing launched\n", n_in, n_in > 0 ? in_sizes[0] : -1, out_size, ws_size, (size_t)WS_END); grid = -1; return; }
        int dev = 0, cus = 0, per_cu = 0;
        if (hipGetDevice(&dev) != hipSuccess || hipDeviceGetAttribute(&cus, hipDeviceAttributeMultiprocessorCount, dev) != hipSuccess) { fprintf(stderr, "kernel_launch: device query failed\n"); grid = -1; return; }
        if (hipFuncSetAttribute((const void*)hybrid_fwd, hipFuncAttributeMaxDynamicSharedMemorySize, LDS_BYTES) != hipSuccess) { fprintf(stderr, "kernel_launch: hipFuncSetAttribute failed\n"); grid = -1; return; }
        if (hipOccupancyMaxActiveBlocksPerMultiprocessor(&per_cu, (const void*)hybrid_fwd, NTHR, LDS_BYTES) != hipSuccess || per_cu < 1) {
            fprintf(stderr, "kernel_launch: occupancy query reports %d workgroups per CU; nothing launched\n", per_cu); (void)hipGetLastError(); grid = -1; return; }
        grid = cus;
    }
    if (grid < 0) return;
    if (hipMemsetAsync((char*)d_ws + WS_CTL, 0, CTL_ZERO_BYTES, stream) != hipSuccess) { fprintf(stderr, "kernel_launch: memset failed\n"); return; }
    Args a{};
    const float** pp = (const float**)&a.p;
    for (int i = 0; i < 22; ++i) pp[i] = (const float*)d_in[i];
    a.p.out = (float*)d_out; a.p.ws = (unsigned char*)d_ws;
#if MK_N_LAUNCHES == 1
    a.p.ph_lo = 0; a.p.ph_hi = N_PHASES; a.li = 0; a.pad = 0;
    hipLaunchKernelGGL(hybrid_fwd, dim3(grid), dim3(NTHR), LDS_BYTES, stream, a);
    { const hipError_t le = hipPeekAtLastError(); if (le != hipSuccess) fprintf(stderr, "kernel_launch: launch failed: %s\n", hipGetErrorName(le)); }
#else
    for (int k = 0; k < N_PHASES; ++k) { a.p.ph_lo = k; a.p.ph_hi = k + 1; a.li = k; a.pad = 0;
        hipLaunchKernelGGL(hybrid_fwd, dim3(grid), dim3(NTHR), LDS_BYTES, stream, a);
        const hipError_t le = hipPeekAtLastError(); if (le != hipSuccess) { fprintf(stderr, "kernel_launch: launch %d failed: %s\n", k, hipGetErrorName(le)); break; } }
#endif
}
```
